# Optimizing an MI355X kernel written in HIP

```python
import math
import jax, jax.numpy as jnp
from jax import lax
import numpy as np

D_MODEL = 1024
BATCH = 2
SEQ = 8192
DEPTH = 1

MEM_LEN = 256
BLOCK_Q = 128
SB_HEADS = 8
SB_HEAD_DIM = 64
DF_HEADS = 4
DF_HEAD_DIM = 64
MX_HEADS = 4
MX_HEAD_DIM = 128
SB_WIDTH = SB_HEADS * SB_HEAD_DIM
DF_WIDTH = DF_HEADS * 2 * DF_HEAD_DIM
MX_WIDTH = MX_HEADS * MX_HEAD_DIM
IN_WIDTH = 3 * SB_WIDTH + 3 * DF_WIDTH + MX_WIDTH
N_BRANCH = 3
ROPE_THETA = 500000.0
ROPE_DIM = DF_HEAD_DIM // 4
PEER_HEADS = 8
PEER_NKEYS = 128
PEER_EXPERTS = PEER_NKEYS * PEER_NKEYS
PEER_TOPK = 16
PEER_QDIM = 256
PEER_HALF = PEER_QDIM // 2
PEER_CHUNK = 128
LN_EPS = 1e-5
RMS_EPS = 1e-5
DEEPNORM_ALPHA = (2.0 * DEPTH) ** 0.25
DEEPNORM_BETA = (8.0 * DEPTH) ** -0.25

kernel_name = "hybrid_sb_diff_mem_peer_block"


def layer_norm(x, g, b):
    xf = x.astype(jnp.float32)
    mu = jnp.mean(xf, axis=-1, keepdims=True)
    var = jnp.mean(jnp.square(xf - mu), axis=-1, keepdims=True)
    return ((xf - mu) * lax.rsqrt(var + LN_EPS) * g.astype(jnp.float32) + b.astype(jnp.float32)).astype(x.dtype)


def rope_tables(positions):
    inv = ROPE_THETA ** (-jnp.arange(0, ROPE_DIM, 2, dtype=jnp.float32) / ROPE_DIM)
    ang = positions.astype(jnp.float32)[..., None] * inv
    return jnp.cos(ang), jnp.sin(ang)


def apply_partial_rotary(x, cos, sin):
    xr, xp = x[..., :ROPE_DIM], x[..., ROPE_DIM:]
    x1, x2 = xr[..., :ROPE_DIM // 2], xr[..., ROPE_DIM // 2:]
    rot = jnp.concatenate([x1 * cos - x2 * sin, x2 * cos + x1 * sin], axis=-1).astype(x.dtype)
    return jnp.concatenate([rot, xp], axis=-1)


def stick_breaking_attention(q, k, v):
    B, H, S, d = q.shape
    nb = S // BLOCK_Q
    scale = d ** -0.5
    key_pos = jnp.arange(S)
    qb = q.reshape(B, H, nb, BLOCK_Q, d).transpose(2, 0, 1, 3, 4)

    def block(args):
        q_blk, i = args
        qpos = i * BLOCK_Q + jnp.arange(BLOCK_Q)
        z = jnp.einsum('bhqd,bhkd->bhqk', q_blk, k, preferred_element_type=jnp.float32) * scale
        causal = key_pos[None, :] < qpos[:, None]
        log_beta = jax.nn.log_sigmoid(z)
        log_one_minus = jnp.where(causal, jax.nn.log_sigmoid(-z), 0.0)
        rest = lax.cumsum(log_one_minus, axis=log_one_minus.ndim - 1, reverse=True) - log_one_minus
        a = jnp.where(causal, jnp.exp(log_beta + rest), 0.0)
        return jnp.einsum('bhqk,bhkd->bhqd', a.astype(v.dtype), v)

    out = lax.map(block, (qb, jnp.arange(nb)))
    return out.transpose(1, 2, 0, 3, 4).reshape(B, H, S, d)


def differential_attention(q, k, v, lam):
    B, H, _, S, d = q.shape
    nb = S // BLOCK_Q
    scale = d ** -0.5
    key_pos = jnp.arange(S)
    qb = q.reshape(B, H, 2, nb, BLOCK_Q, d).transpose(3, 0, 1, 2, 4, 5)

    def block(args):
        q_blk, i = args
        qpos = i * BLOCK_Q + jnp.arange(BLOCK_Q)
        s = jnp.einsum('bhmqd,bhmkd->bhmqk', q_blk, k, preferred_element_type=jnp.float32) * scale
        s = jnp.where(key_pos[None, :] <= qpos[:, None], s, -jnp.inf)
        p = jax.nn.softmax(s, axis=-1)
        attn = p[:, :, 0] - lam * p[:, :, 1]
        return jnp.einsum('bhqk,bhkd->bhqd', attn.astype(v.dtype), v)

    out = lax.map(block, (qb, jnp.arange(nb)))
    return out.transpose(1, 2, 0, 3, 4).reshape(B, H, S, 2 * d)


def memory_cross_attention(q, k, v):
    scale = q.shape[-1] ** -0.5
    s = jnp.einsum('bshd,bmhd->bhsm', q, k, preferred_element_type=jnp.float32) * scale
    p = jax.nn.softmax(s, axis=-1)
    return jnp.einsum('bhsm,bmhd->bshd', p.astype(v.dtype), v)


def peer_ffn(x, w_query, sub_keys, u_tab, v_tab):
    B, S, D = x.shape
    nc = S // PEER_CHUNK
    xc = x.reshape(B, nc, PEER_CHUNK, D).transpose(1, 0, 2, 3)

    def chunk(xb):
        C = xb.shape[1]
        q = (xb @ w_query).reshape(B, C, PEER_HEADS, 2, PEER_HALF)
        s = jnp.einsum('bchpd,hpnd->bchpn', q, sub_keys, preferred_element_type=jnp.float32)
        top_s, top_i = lax.top_k(s, PEER_TOPK)
        cand_s = top_s[..., 0, :, None] + top_s[..., 1, None, :]
        cand_i = top_i[..., 0, :, None] * PEER_NKEYS + top_i[..., 1, None, :]
        cand_s = cand_s.reshape(B, C, PEER_HEADS, PEER_TOPK * PEER_TOPK)
        cand_i = cand_i.reshape(B, C, PEER_HEADS, PEER_TOPK * PEER_TOPK)
        best_s, best_pos = lax.top_k(cand_s, PEER_TOPK)
        ids = jnp.take_along_axis(cand_i, best_pos, axis=-1)
        g = jax.nn.softmax(best_s, axis=-1)
        ids = ids.reshape(B, C, PEER_HEADS * PEER_TOPK)
        g = g.reshape(B, C, PEER_HEADS * PEER_TOPK)
        u = jnp.take(u_tab, ids, axis=0)
        v = jnp.take(v_tab, ids, axis=0)
        h = jnp.einsum('bcd,bced->bce', xb, u, preferred_element_type=jnp.float32)
        a = jax.nn.gelu(h, approximate=False) * g
        return jnp.einsum('bce,bced->bcd', a.astype(v.dtype), v)

    out = lax.map(chunk, xc)
    return out.transpose(1, 0, 2, 3).reshape(B, S, D)


def setup_inputs(seed: int = 0) -> dict:
    key = jax.random.key(seed)
    ks = jax.random.split(key, 24)
    f32 = jnp.float32
    nrm = lambda k, shape, s: jax.random.normal(k, shape, f32) * s
    D = D_MODEL
    x = nrm(ks[0], (BATCH, SEQ, D), 1.0)
    mem = nrm(ks[1], (BATCH, MEM_LEN, D), 1.0)
    offset = jax.random.randint(ks[2], (BATCH, 1), 0, 1024, dtype=jnp.int32)
    positions = offset + jnp.arange(SEQ, dtype=jnp.int32)[None, :]
    return {
        "x": x,
        "mem": mem,
        "positions": positions,
        "w_in": nrm(ks[3], (DEPTH, D, IN_WIDTH), D ** -0.5),
        "w_mem_kv": nrm(ks[4], (DEPTH, D, 2 * MX_WIDTH), D ** -0.5),
        "df_lambda": nrm(ks[5], (DEPTH, 4, DF_HEAD_DIM), 0.1),
        "df_norm_g": 1.0 + nrm(ks[6], (DEPTH, 2 * DF_HEAD_DIM), 0.02),
        "w_gate": nrm(ks[7], (DEPTH, D, N_BRANCH * D), D ** -0.5),
        "b_gate": nrm(ks[8], (DEPTH, N_BRANCH * D), 0.02),
        "w_br_sb": nrm(ks[9], (DEPTH, SB_WIDTH, D), SB_WIDTH ** -0.5),
        "w_br_df": nrm(ks[10], (DEPTH, DF_WIDTH, D), DF_WIDTH ** -0.5),
        "w_br_mx": nrm(ks[11], (DEPTH, MX_WIDTH, D), MX_WIDTH ** -0.5),
        "w_out": nrm(ks[12], (DEPTH, D, D), DEEPNORM_BETA * D ** -0.5),
        "ln1_g": 1.0 + nrm(ks[13], (DEPTH, D), 0.02),
        "ln1_b": nrm(ks[14], (DEPTH, D), 0.02),
        "w_query": nrm(ks[15], (DEPTH, D, PEER_HEADS * PEER_QDIM), D ** -0.5),
        "sub_keys": nrm(ks[16], (DEPTH, PEER_HEADS, 2, PEER_NKEYS, PEER_HALF), PEER_HALF ** -0.5),
        "u_tab": nrm(ks[17], (DEPTH, PEER_EXPERTS, D), D ** -0.5),
        "v_tab": nrm(ks[18], (DEPTH, PEER_EXPERTS, D), DEEPNORM_BETA),
        "ln2_g": 1.0 + nrm(ks[19], (DEPTH, D), 0.02),
        "ln2_b": nrm(ks[20], (DEPTH, D), 0.02),
    }


def reference(x, mem, positions, w_in, w_mem_kv, df_lambda, df_norm_g, w_gate, b_gate,
              w_br_sb, w_br_df, w_br_mx, w_out, ln1_g, ln1_b, w_query, sub_keys,
              u_tab, v_tab, ln2_g, ln2_b):
    B, S, D = x.shape
    M = mem.shape[1]
    cos, sin = rope_tables(positions)
    cos = cos[:, :, None, None, :]
    sin = sin[:, :, None, None, :]
    for l in range(DEPTH):
        lambda_init = 0.8 - 0.6 * math.exp(-0.3 * l)
        h = x
        proj = h @ w_in[l]
        sb_q, sb_k, sb_v, df_q, df_k, df_v, mx_q = jnp.split(
            proj, [SB_WIDTH, 2 * SB_WIDTH, 3 * SB_WIDTH,
                   3 * SB_WIDTH + DF_WIDTH, 3 * SB_WIDTH + 2 * DF_WIDTH,
                   3 * SB_WIDTH + 3 * DF_WIDTH], axis=-1)
        to_heads = lambda t: t.reshape(B, S, SB_HEADS, SB_HEAD_DIM).transpose(0, 2, 1, 3)
        o_sb = stick_breaking_attention(to_heads(sb_q), to_heads(sb_k), to_heads(sb_v))
        o_sb = o_sb.transpose(0, 2, 1, 3).reshape(B, S, SB_WIDTH)
        df_q = apply_partial_rotary(df_q.reshape(B, S, DF_HEADS, 2, DF_HEAD_DIM), cos, sin)
        df_k = apply_partial_rotary(df_k.reshape(B, S, DF_HEADS, 2, DF_HEAD_DIM), cos, sin)
        df_v = df_v.reshape(B, S, DF_HEADS, 2 * DF_HEAD_DIM).transpose(0, 2, 1, 3)
        lam_p = df_lambda[l].astype(jnp.float32)
        lam = (jnp.exp(jnp.sum(lam_p[0] * lam_p[1])) - jnp.exp(jnp.sum(lam_p[2] * lam_p[3]))
               + lambda_init)
        o_df = differential_attention(df_q.transpose(0, 2, 3, 1, 4), df_k.transpose(0, 2, 3, 1, 4),
                                      df_v, lam)
        o_df_f = o_df.astype(jnp.float32)
        o_df_f = o_df_f * lax.rsqrt(jnp.mean(jnp.square(o_df_f), axis=-1, keepdims=True) + RMS_EPS)
        o_df = (o_df_f * df_norm_g[l].astype(jnp.float32) * (1.0 - lambda_init)).astype(x.dtype)
        o_df = o_df.transpose(0, 2, 1, 3).reshape(B, S, DF_WIDTH)
        mem_k, mem_v = jnp.split(mem @ w_mem_kv[l], 2, axis=-1)
        o_mx = memory_cross_attention(mx_q.reshape(B, S, MX_HEADS, MX_HEAD_DIM),
                                      mem_k.reshape(B, M, MX_HEADS, MX_HEAD_DIM),
                                      mem_v.reshape(B, M, MX_HEADS, MX_HEAD_DIM))
        o_mx = o_mx.reshape(B, S, MX_WIDTH)
        gates = jax.nn.sigmoid(h @ w_gate[l] + b_gate[l]).reshape(B, S, N_BRANCH, D)
        merged = (gates[:, :, 0] * (o_sb @ w_br_sb[l])
                  + gates[:, :, 1] * (o_df @ w_br_df[l])
                  + gates[:, :, 2] * (o_mx @ w_br_mx[l]))
        mix = merged @ w_out[l]
        x = layer_norm(DEEPNORM_ALPHA * x + mix, ln1_g[l], ln1_b[l])
        ffn = peer_ffn(x, w_query[l], sub_keys[l], u_tab[l], v_tab[l])
        x = layer_norm(DEEPNORM_ALPHA * x + ffn, ln2_g[l], ln2_b[l])
    return x
```

```cpp
#include <hip/hip_runtime.h>
#include <cstdint>
#include <cstdio>

typedef unsigned short bf16_t;
typedef short bf16x8 __attribute__((ext_vector_type(8)));
typedef float f32x16 __attribute__((ext_vector_type(16)));
typedef float f32x4 __attribute__((ext_vector_type(4)));
typedef unsigned u32x4 __attribute__((ext_vector_type(4)));
typedef unsigned u32x2 __attribute__((ext_vector_type(2)));

constexpr int BATCH = 2, SEQ = 8192, DM = 1024, M = BATCH * SEQ;
constexpr int MEMLEN = 256;
constexpr int INW = 3584;
constexpr int NEXP = 16384;
constexpr float LOG2E = 1.4426950408889634f;
constexpr float C2_64 = 0.125f * LOG2E;
constexpr float C2_128 = 0.08838834764831845f * LOG2E;
constexpr float ALPHA = 1.189207115002721f;
constexpr float LN_EPS = 1e-5f, RMS_EPS = 1e-5f;
constexpr float LAMBDA_INIT = 0.2f;

constexpr size_t MiB = 1u << 20;
constexpr size_t WS_CTL = 0;
constexpr size_t WS_ROPE = 1 * MiB;
constexpr size_t WS_WIN = 2 * MiB;
constexpr size_t WS_WGATE = 9 * MiB;
constexpr size_t WS_WMEMKV = 15 * MiB;
constexpr size_t WS_WBR = 17 * MiB;
constexpr size_t WS_WOUT = 20 * MiB;
constexpr size_t WS_WQUERY = 22 * MiB;
constexpr size_t WS_SUBK = 26 * MiB;
constexpr size_t WS_MEMB = 27 * MiB;
constexpr size_t WS_MEMKV = 28 * MiB;
constexpr size_t WS_XB = 32 * MiB;
constexpr size_t WS_SBQ = 64 * MiB, WS_SBK = 80 * MiB, WS_SBV = 96 * MiB;
constexpr size_t WS_DFQ = 112 * MiB, WS_DFK = 128 * MiB, WS_DFV = 144 * MiB, WS_MXQ = 160 * MiB;
constexpr size_t WS_ODF16 = 176 * MiB;
constexpr size_t WS_OSB = 208 * MiB, WS_ODF = 224 * MiB, WS_OMX = 240 * MiB;
constexpr size_t WS_GATES = 64 * MiB;
constexpr size_t WS_MERGEDB = 160 * MiB;
constexpr size_t WS_X1B = 32 * MiB;
constexpr size_t WS_QP = 64 * MiB;
constexpr size_t WS_IDS = 128 * MiB;
constexpr size_t WS_G = 136 * MiB;
constexpr size_t WS_UTB = 160 * MiB;
constexpr size_t WS_VTB = 192 * MiB;

struct Params {
    const float *x, *mem; const int* pos;
    const float *w_in, *w_memkv, *df_lambda, *df_norm_g, *w_gate, *b_gate, *w_br_sb, *w_br_df, *w_br_mx, *w_out;
    const float *ln1_g, *ln1_b, *w_query, *sub_keys, *u_tab, *v_tab, *ln2_g, *ln2_b;
    float* out; unsigned char* ws;
};

__device__ __forceinline__ float bf2f(unsigned v) { return __uint_as_float(v << 16); }
__device__ __forceinline__ unsigned f2bf(float f) { unsigned u = __float_as_uint(f); return (u + 0x7fffu + ((u >> 16) & 1u)) >> 16; }
__device__ __forceinline__ unsigned pk2(float lo, float hi) { return f2bf(lo) | (f2bf(hi) << 16); }
__device__ __forceinline__ float wave_sum(float v) {
#pragma unroll
    for (int o = 1; o < 64; o <<= 1) v += __shfl_xor(v, o);
    return v;
}
__device__ __forceinline__ float gelu_exact(float v) { return 0.5f * v * (1.0f + erff(v * 0.70710678118654752f)); }

__device__ __forceinline__ void transpose_item(const float* W, int K, int N, bf16_t* WT, float* scr, int item, int lane) {
    const int nblk = N / 32, kb = item / nblk, nb = item % nblk, k0 = 64 * kb, n0 = 32 * nb;
#pragma unroll 8
    for (int i = 0; i < 32; ++i) { const int kk = 2 * i + (lane >> 5); scr[kk * 33 + (lane & 31)] = W[(size_t)(k0 + kk) * N + n0 + (lane & 31)]; }
    asm volatile("s_waitcnt lgkmcnt(0)" ::: "memory");
    const int c = lane & 7;
#pragma unroll
    for (int j = 0; j < 4; ++j) { const int n = (lane >> 3) + 8 * j; const float* s = scr + (8 * c) * 33 + n;
        u32x4 o; o.x = pk2(s[0 * 33], s[1 * 33]); o.y = pk2(s[2 * 33], s[3 * 33]); o.z = pk2(s[4 * 33], s[5 * 33]); o.w = pk2(s[6 * 33], s[7 * 33]);
        *(u32x4*)(WT + (size_t)(n0 + n) * K + k0 + 8 * c) = o; }
    asm volatile("s_waitcnt lgkmcnt(0)" ::: "memory");
}
__device__ __forceinline__ void stage_transposes(const Params& p, float* scr, int gw, int ngw, int lane) {
    struct TJ { const float* W; int K, N; size_t off; };
    const TJ jobs[8] = {
        {p.w_in, 1024, 3584, WS_WIN}, {p.w_gate, 1024, 3072, WS_WGATE}, {p.w_memkv, 1024, 1024, WS_WMEMKV},
        {p.w_br_sb, 512, 1024, WS_WBR}, {p.w_br_df, 512, 1024, WS_WBR + 1 * MiB}, {p.w_br_mx, 512, 1024, WS_WBR + 2 * MiB},
        {p.w_out, 1024, 1024, WS_WOUT}, {p.w_query, 1024, 2048, WS_WQUERY}};
    int base = 0;
#pragma unroll
    for (int j = 0; j < 8; ++j) {
        const int items = (jobs[j].K / 64) * (jobs[j].N / 32);
        int first = ((gw - base) % ngw + ngw) % ngw;
        for (int it = first; it < items; it += ngw) transpose_item(jobs[j].W, jobs[j].K, jobs[j].N, (bf16_t*)(p.ws + jobs[j].off), scr, it, lane);
        base += items;
    }
}
__device__ __forceinline__ void convert_bf16(const float* src, bf16_t* dst, size_t n, size_t gtid, size_t gsize) {
    const size_t n4 = n / 4;
    for (size_t i = gtid; i < n4; i += gsize) { const f32x4 v = ((const f32x4*)src)[i]; u32x2 o; o.x = pk2(v.x, v.y); o.y = pk2(v.z, v.w); ((u32x2*)dst)[i] = o; }
}
__device__ __forceinline__ void stage_rope(const Params& p, size_t gtid, size_t gsize) {
    const double inv[8] = {1.0, 0.19392274474868576, 0.03760603093086393, 0.007292664737217109, 0.001414213562373095, 0.0002742481756762073, 5.318295896944988e-05, 1.031338537721246e-05};
    float2* tab = (float2*)(p.ws + WS_ROPE);
    for (size_t i = gtid; i < (size_t)M * 8; i += gsize) {
        const int row = (int)(i >> 3), j = (int)(i & 7);
        double iv = inv[0];
#pragma unroll
        for (int q = 1; q < 8; ++q) iv = (j == q) ? inv[q] : iv;
        const double a = (double)p.pos[row] * iv;
        double rev = a * 0.15915494309189535;
        rev -= floor(rev);
        const float rf = (float)rev;
        tab[i] = make_float2(__builtin_amdgcn_cosf(rf), __builtin_amdgcn_sinf(rf));
    }
}

template <class Epi>
__device__ __forceinline__ void naive_gemm(const bf16_t* A, int lda, const bf16_t* Bt, int ldb, int Mr, int N, int K, const Epi& epi, int gw, int ngw, int lane) {
    const int r = lane & 31, h = lane >> 5;
    const int tnc = N / 32, ntiles = (Mr / 32) * tnc;
    for (int t = gw; t < ntiles; t += ngw) {
        const int tm = t / tnc, tn = t % tnc;
        const bf16_t* ap = A + (size_t)(tm * 32 + r) * lda + 8 * h;
        const bf16_t* bp = Bt + (size_t)(tn * 32 + r) * ldb + 8 * h;
        f32x16 acc;
#pragma unroll
        for (int i = 0; i < 16; ++i) acc[i] = 0.f;
        for (int k = 0; k < K; k += 16) {
            const bf16x8 a = *(const bf16x8*)(ap + k); const bf16x8 b = *(const bf16x8*)(bp + k);
            acc = __builtin_amdgcn_mfma_f32_32x32x16_bf16(a, b, acc, 0, 0, 0);
        }
        epi(acc, tm * 32, tn * 32, r, h);
    }
}
#define ACC_ROW(row0, i, h) ((row0) + ((i) & 3) + 8 * ((i) >> 2) + 4 * (h))

struct EpiProj {
    unsigned char* ws;
    __device__ __forceinline__ void operator()(const f32x16& acc, int row0, int col0, int r, int h) const {
        const int region = col0 >> 9;
        const int cc = (col0 & 511) + r;
        const size_t offs[7] = {WS_SBQ, WS_SBK, WS_SBV, WS_DFQ, WS_DFK, WS_DFV, WS_MXQ};
        size_t off = offs[0];
#pragma unroll
        for (int q = 1; q < 7; ++q) off = (region == q) ? offs[q] : off;
        bf16_t* dst = (bf16_t*)(ws + off);
        const float2* rope = (const float2*)(ws + WS_ROPE);
        const float scale = (region == 0 || region == 3) ? C2_64 : (region == 6 ? C2_128 : 1.0f);
        const bool rot = (region == 3 || region == 4);
        const int d = cc & 63;
#pragma unroll
        for (int i = 0; i < 16; ++i) {
            const int row = ACC_ROW(row0, i, h);
            float v = acc[i];
            const float partner = __shfl_xor(v, 8);
            if (rot && d < 16) {
                const float2 cs = rope[(size_t)row * 8 + (d & 7)];
                v = (d < 8) ? (v * cs.x - partner * cs.y) : (v * cs.x + partner * cs.y);
            }
            dst[(size_t)row * 512 + cc] = (bf16_t)f2bf(v * scale);
        }
    }
};
struct EpiPlain {
    bf16_t* dst; int ldc;
    __device__ __forceinline__ void operator()(const f32x16& acc, int row0, int col0, int r, int h) const {
#pragma unroll
        for (int i = 0; i < 16; ++i) dst[(size_t)ACC_ROW(row0, i, h) * ldc + col0 + r] = (bf16_t)f2bf(acc[i]);
    }
};
struct EpiGate {
    bf16_t* dst; const float* bias;
    __device__ __forceinline__ void operator()(const f32x16& acc, int row0, int col0, int r, int h) const {
        const float b = bias[col0 + r];
#pragma unroll
        for (int i = 0; i < 16; ++i) { const float z = acc[i] + b; dst[(size_t)ACC_ROW(row0, i, h) * 3072 + col0 + r] = (bf16_t)f2bf(1.0f / (1.0f + __expf(-z))); }
    }
};
struct EpiBranch {
    const bf16_t* gates; int gcol; float* m32; bf16_t* mb; int mode;
    __device__ __forceinline__ void operator()(const f32x16& acc, int row0, int col0, int r, int h) const {
#pragma unroll
        for (int i = 0; i < 16; ++i) { const size_t row = ACC_ROW(row0, i, h); const int c = col0 + r;
            const float g = bf2f(gates[row * 3072 + gcol + c]); float v = g * acc[i];
            if (mode > 0) v += m32[row * 1024 + c];
            if (mode < 2) m32[row * 1024 + c] = v; else mb[row * 1024 + c] = (bf16_t)f2bf(v); }
    }
};
struct EpiOut {
    const float* x; float* y;
    __device__ __forceinline__ void operator()(const f32x16& acc, int row0, int col0, int r, int h) const {
#pragma unroll
        for (int i = 0; i < 16; ++i) { const size_t o = (size_t)ACC_ROW(row0, i, h) * 1024 + col0 + r; y[o] = ALPHA * x[o] + acc[i]; }
    }
};

__device__ __forceinline__ void naive_df_attn(const Params& p, size_t gtid, size_t gsize) {
    const bf16_t* Q = (const bf16_t*)(p.ws + WS_DFQ); const bf16_t* Kb = (const bf16_t*)(p.ws + WS_DFK); const bf16_t* Vb = (const bf16_t*)(p.ws + WS_DFV);
    bf16_t* O = (bf16_t*)(p.ws + WS_ODF16);
    for (size_t idx = gtid; idx < (size_t)16 * M; idx += gsize) {
        const int t = (int)(idx % SEQ); const int bg = (int)(idx / SEQ); const int g = bg % 16, b = bg / 16;
        const int hh = g >> 2, mm = (g >> 1) & 1, vh = g & 1;
        const int qcol = (hh * 2 + mm) * 64, vcol = (hh * 2 + vh) * 64;
        const size_t row = (size_t)b * SEQ + t;
        float q[64], o[64];
#pragma unroll
        for (int d = 0; d < 64; ++d) { q[d] = bf2f(Q[row * 512 + qcol + d]); o[d] = 0.f; }
        float mx = -1e30f, l = 0.f;
        const int tmax = __shfl(t, 63);
        for (int s = 0; s <= tmax; ++s) {
            const bf16_t* kr = Kb + ((size_t)b * SEQ + s) * 512 + qcol;
            float y = 0.f;
#pragma unroll
            for (int d8 = 0; d8 < 8; ++d8) { const u32x4 kk = *(const u32x4*)(kr + d8 * 8);
                y += q[d8 * 8 + 0] * bf2f(kk.x & 0xffffu) + q[d8 * 8 + 1] * bf2f(kk.x >> 16) + q[d8 * 8 + 2] * bf2f(kk.y & 0xffffu) + q[d8 * 8 + 3] * bf2f(kk.y >> 16)
                   + q[d8 * 8 + 4] * bf2f(kk.z & 0xffffu) + q[d8 * 8 + 5] * bf2f(kk.z >> 16) + q[d8 * 8 + 6] * bf2f(kk.w & 0xffffu) + q[d8 * 8 + 7] * bf2f(kk.w >> 16); }
            if (s > t) y = -INFINITY;
            const float mn = fmaxf(mx, y), al = exp2f(mx - mn), pp = exp2f(y - mn);
            mx = mn; l = l * al + pp;
            const bf16_t* vr = Vb + ((size_t)b * SEQ + s) * 512 + vcol;
#pragma unroll
            for (int d8 = 0; d8 < 8; ++d8) { const u32x4 vv = *(const u32x4*)(vr + d8 * 8);
                o[d8 * 8 + 0] = o[d8 * 8 + 0] * al + pp * bf2f(vv.x & 0xffffu); o[d8 * 8 + 1] = o[d8 * 8 + 1] * al + pp * bf2f(vv.x >> 16);
                o[d8 * 8 + 2] = o[d8 * 8 + 2] * al + pp * bf2f(vv.y & 0xffffu); o[d8 * 8 + 3] = o[d8 * 8 + 3] * al + pp * bf2f(vv.y >> 16);
                o[d8 * 8 + 4] = o[d8 * 8 + 4] * al + pp * bf2f(vv.z & 0xffffu); o[d8 * 8 + 5] = o[d8 * 8 + 5] * al + pp * bf2f(vv.z >> 16);
                o[d8 * 8 + 6] = o[d8 * 8 + 6] * al + pp * bf2f(vv.w & 0xffffu); o[d8 * 8 + 7] = o[d8 * 8 + 7] * al + pp * bf2f(vv.w >> 16); }
        }
        const float rl = 1.0f / l;
#pragma unroll
        for (int d = 0; d < 64; d += 2) *(unsigned*)(O + row * 1024 + g * 64 + d) = pk2(o[d] * rl, o[d + 1] * rl);
    }
}
constexpr float SB_EXIT_BITS = 48.0f;
__device__ __forceinline__ void naive_sb_attn(const Params& p, size_t gtid, size_t gsize) {
    const bf16_t* Q = (const bf16_t*)(p.ws + WS_SBQ); const bf16_t* Kb = (const bf16_t*)(p.ws + WS_SBK); const bf16_t* Vb = (const bf16_t*)(p.ws + WS_SBV);
    bf16_t* O = (bf16_t*)(p.ws + WS_OSB);
    for (size_t idx = gtid; idx < (size_t)8 * M; idx += gsize) {
        const int t = (int)(idx % SEQ); const int bh = (int)(idx / SEQ); const int hh = bh % 8, b = bh / 8;
        const int col = hh * 64;
        const size_t row = (size_t)b * SEQ + t;
        float q[64], o[64];
#pragma unroll
        for (int d = 0; d < 64; ++d) { q[d] = bf2f(Q[row * 512 + col + d]); o[d] = 0.f; }
        float R = 0.f;
        const int tmax = __shfl(t, 63);
        for (int s = tmax - 1; s >= 0; --s) {
            const bf16_t* kr = Kb + ((size_t)b * SEQ + s) * 512 + col;
            float y = 0.f;
#pragma unroll
            for (int d8 = 0; d8 < 8; ++d8) { const u32x4 kk = *(const u32x4*)(kr + d8 * 8);
                y += q[d8 * 8 + 0] * bf2f(kk.x & 0xffffu) + q[d8 * 8 + 1] * bf2f(kk.x >> 16) + q[d8 * 8 + 2] * bf2f(kk.y & 0xffffu) + q[d8 * 8 + 3] * bf2f(kk.y >> 16)
                   + q[d8 * 8 + 4] * bf2f(kk.z & 0xffffu) + q[d8 * 8 + 5] * bf2f(kk.z >> 16) + q[d8 * 8 + 6] * bf2f(kk.w & 0xffffu) + q[d8 * 8 + 7] * bf2f(kk.w >> 16); }
            const bool act = s < t;
            const float sp = fmaxf(y, 0.f) + log2f(1.0f + exp2f(-fabsf(y)));
            float a = 0.f;
            if (act) { R += sp; a = exp2f(y - R); }
            const bf16_t* vr = Vb + ((size_t)b * SEQ + s) * 512 + col;
#pragma unroll
            for (int d8 = 0; d8 < 8; ++d8) { const u32x4 vv = *(const u32x4*)(vr + d8 * 8);
                o[d8 * 8 + 0] += a * bf2f(vv.x & 0xffffu); o[d8 * 8 + 1] += a * bf2f(vv.x >> 16);
                o[d8 * 8 + 2] += a * bf2f(vv.y & 0xffffu); o[d8 * 8 + 3] += a * bf2f(vv.y >> 16);
                o[d8 * 8 + 4] += a * bf2f(vv.z & 0xffffu); o[d8 * 8 + 5] += a * bf2f(vv.z >> 16);
                o[d8 * 8 + 6] += a * bf2f(vv.w & 0xffffu); o[d8 * 8 + 7] += a * bf2f(vv.w >> 16); }
            if (__all(R > SB_EXIT_BITS)) break;
        }
#pragma unroll
        for (int d = 0; d < 64; d += 2) *(unsigned*)(O + row * 512 + col + d) = pk2(o[d], o[d + 1]);
    }
}
__device__ __forceinline__ void naive_mx_attn(const Params& p, size_t gtid, size_t gsize) {
    const bf16_t* Q = (const bf16_t*)(p.ws + WS_MXQ); const bf16_t* KV = (const bf16_t*)(p.ws + WS_MEMKV);
    bf16_t* O = (bf16_t*)(p.ws + WS_OMX);
    for (size_t idx = gtid; idx < (size_t)8 * M; idx += gsize) {
        const int t = (int)(idx % SEQ); const int bq = (int)(idx / SEQ); const int vh = bq & 1, hh = (bq >> 1) & 3, b = bq >> 3;
        const size_t row = (size_t)b * SEQ + t;
        unsigned qp[64]; float o[64];
#pragma unroll
        for (int d = 0; d < 64; ++d) { qp[d] = *(const unsigned*)(Q + row * 512 + hh * 128 + 2 * d); o[d] = 0.f; }
        float mx = -1e30f, l = 0.f;
        for (int m = 0; m < MEMLEN; ++m) {
            const bf16_t* kr = KV + ((size_t)b * MEMLEN + m) * 1024 + hh * 128;
            float y = 0.f;
#pragma unroll
            for (int d8 = 0; d8 < 16; ++d8) { const u32x4 kk = *(const u32x4*)(kr + d8 * 8);
                y += bf2f(qp[d8 * 4 + 0] & 0xffffu) * bf2f(kk.x & 0xffffu) + bf2f(qp[d8 * 4 + 0] >> 16) * bf2f(kk.x >> 16)
                   + bf2f(qp[d8 * 4 + 1] & 0xffffu) * bf2f(kk.y & 0xffffu) + bf2f(qp[d8 * 4 + 1] >> 16) * bf2f(kk.y >> 16)
                   + bf2f(qp[d8 * 4 + 2] & 0xffffu) * bf2f(kk.z & 0xffffu) + bf2f(qp[d8 * 4 + 2] >> 16) * bf2f(kk.z >> 16)
                   + bf2f(qp[d8 * 4 + 3] & 0xffffu) * bf2f(kk.w & 0xffffu) + bf2f(qp[d8 * 4 + 3] >> 16) * bf2f(kk.w >> 16); }
            const float mn = fmaxf(mx, y), al = exp2f(mx - mn), pp = exp2f(y - mn);
            mx = mn; l = l * al + pp;
            const bf16_t* vr = KV + ((size_t)b * MEMLEN + m) * 1024 + 512 + hh * 128 + vh * 64;
#pragma unroll
            for (int d8 = 0; d8 < 8; ++d8) { const u32x4 vv = *(const u32x4*)(vr + d8 * 8);
                o[d8 * 8 + 0] = o[d8 * 8 + 0] * al + pp * bf2f(vv.x & 0xffffu); o[d8 * 8 + 1] = o[d8 * 8 + 1] * al + pp * bf2f(vv.x >> 16);
                o[d8 * 8 + 2] = o[d8 * 8 + 2] * al + pp * bf2f(vv.y & 0xffffu); o[d8 * 8 + 3] = o[d8 * 8 + 3] * al + pp * bf2f(vv.y >> 16);
                o[d8 * 8 + 4] = o[d8 * 8 + 4] * al + pp * bf2f(vv.z & 0xffffu); o[d8 * 8 + 5] = o[d8 * 8 + 5] * al + pp * bf2f(vv.z >> 16);
                o[d8 * 8 + 6] = o[d8 * 8 + 6] * al + pp * bf2f(vv.w & 0xffffu); o[d8 * 8 + 7] = o[d8 * 8 + 7] * al + pp * bf2f(vv.w >> 16); }
        }
        const float rl = 1.0f / l;
#pragma unroll
        for (int d = 0; d < 64; d += 2) *(unsigned*)(O + row * 512 + hh * 128 + vh * 64 + d) = pk2(o[d] * rl, o[d + 1] * rl);
    }
}
__device__ __forceinline__ void stage_df_combine(const Params& p, int gw, int ngw, int lane) {
    const bf16_t* O16 = (const bf16_t*)(p.ws + WS_ODF16); bf16_t* O = (bf16_t*)(p.ws + WS_ODF);
    const float s01 = wave_sum(p.df_lambda[lane] * p.df_lambda[64 + lane]), s23 = wave_sum(p.df_lambda[128 + lane] * p.df_lambda[192 + lane]);
    const float lam = __expf(s01) - __expf(s23) + LAMBDA_INIT;
    const int hh = lane >> 4, dv = (lane & 15) * 8, vh = dv >> 6, d = dv & 63;
    float gn[8];
#pragma unroll
    for (int j = 0; j < 8; ++j) gn[j] = p.df_norm_g[dv + j] * (1.0f - LAMBDA_INIT);
    for (int row = gw; row < M; row += ngw) {
        const u32x4 a = *(const u32x4*)(O16 + (size_t)row * 1024 + (hh * 4 + vh) * 64 + d);
        const u32x4 b = *(const u32x4*)(O16 + (size_t)row * 1024 + (hh * 4 + 2 + vh) * 64 + d);
        float v[8];
        v[0] = bf2f(a.x & 0xffffu) - lam * bf2f(b.x & 0xffffu); v[1] = bf2f(a.x >> 16) - lam * bf2f(b.x >> 16);
        v[2] = bf2f(a.y & 0xffffu) - lam * bf2f(b.y & 0xffffu); v[3] = bf2f(a.y >> 16) - lam * bf2f(b.y >> 16);
        v[4] = bf2f(a.z & 0xffffu) - lam * bf2f(b.z & 0xffffu); v[5] = bf2f(a.z >> 16) - lam * bf2f(b.z >> 16);
        v[6] = bf2f(a.w & 0xffffu) - lam * bf2f(b.w & 0xffffu); v[7] = bf2f(a.w >> 16) - lam * bf2f(b.w >> 16);
        float ss = 0.f;
#pragma unroll
        for (int j = 0; j < 8; ++j) ss += v[j] * v[j];
        ss += __shfl_xor(ss, 1); ss += __shfl_xor(ss, 2); ss += __shfl_xor(ss, 4); ss += __shfl_xor(ss, 8);
        const float rs = 1.0f / sqrtf(ss * (1.0f / 128.0f) + RMS_EPS);
        u32x4 o; o.x = pk2(v[0] * rs * gn[0], v[1] * rs * gn[1]); o.y = pk2(v[2] * rs * gn[2], v[3] * rs * gn[3]);
        o.z = pk2(v[4] * rs * gn[4], v[5] * rs * gn[5]); o.w = pk2(v[6] * rs * gn[6], v[7] * rs * gn[7]);
        *(u32x4*)(O + (size_t)row * 512 + hh * 128 + dv) = o;
    }
}
__device__ __forceinline__ void stage_ln1(const Params& p, int gw, int ngw, int lane) {
    bf16_t* X1B = (bf16_t*)(p.ws + WS_X1B);
    for (int row = gw; row < M; row += ngw) {
        f32x4* yr = (f32x4*)(p.out + (size_t)row * 1024) + lane;
        f32x4 v[4]; float s = 0.f;
#pragma unroll
        for (int j = 0; j < 4; ++j) { v[j] = yr[64 * j]; s += (v[j].x + v[j].y) + (v[j].z + v[j].w); }
        const float mean = wave_sum(s) * (1.f / 1024.f); float s2 = 0.f;
#pragma unroll
        for (int j = 0; j < 4; ++j) { v[j] = v[j] - mean; s2 += (v[j].x * v[j].x + v[j].y * v[j].y) + (v[j].z * v[j].z + v[j].w * v[j].w); }
        const float rstd = 1.f / sqrtf(wave_sum(s2) * (1.f / 1024.f) + LN_EPS);
#pragma unroll
        for (int j = 0; j < 4; ++j) { const f32x4 g = ((const f32x4*)p.ln1_g)[lane + 64 * j], bb = ((const f32x4*)p.ln1_b)[lane + 64 * j];
            const f32x4 o = v[j] * rstd * g + bb; yr[64 * j] = o;
            u32x2 w; w.x = pk2(o.x, o.y); w.y = pk2(o.z, o.w); ((u32x2*)(X1B + (size_t)row * 1024))[lane + 64 * j] = w; }
    }
}
#define TOPK_INSERT(tv, ti, val, id) do { float v_ = (val); int vi_ = (id); \
    _Pragma("unroll") for (int j_ = 0; j_ < 16; ++j_) { const bool gt_ = v_ > tv[j_]; const float t1_ = gt_ ? tv[j_] : v_; const int t2_ = gt_ ? ti[j_] : vi_; \
        tv[j_] = gt_ ? v_ : tv[j_]; ti[j_] = gt_ ? vi_ : ti[j_]; v_ = t1_; vi_ = t2_; } } while (0)
__device__ __forceinline__ void naive_routing(const Params& p, size_t gtid, size_t gsize) {
    const bf16_t* QP = (const bf16_t*)(p.ws + WS_QP); const bf16_t* SK = (const bf16_t*)(p.ws + WS_SUBK);
    int* IDS = (int*)(p.ws + WS_IDS); float* G = (float*)(p.ws + WS_G);
    for (size_t idx = gtid; idx < (size_t)8 * M; idx += gsize) {
        const int row = (int)(idx % M), hh = (int)(idx / M);
        float tv0[16], tv1[16]; int ti0[16], ti1[16];
#pragma unroll
        for (int j = 0; j < 16; ++j) { tv0[j] = -INFINITY; tv1[j] = -INFINITY; ti0[j] = 0; ti1[j] = 0; }
#pragma unroll
        for (int pp = 0; pp < 2; ++pp) {
            unsigned qp[64];
#pragma unroll
            for (int d = 0; d < 64; ++d) qp[d] = *(const unsigned*)(QP + (size_t)row * 2048 + (hh * 2 + pp) * 128 + 2 * d);
            for (int n = 0; n < 128; ++n) {
                const bf16_t* kr = SK + ((size_t)(hh * 2 + pp) * 128 + n) * 128;
                float y = 0.f;
#pragma unroll
                for (int d8 = 0; d8 < 16; ++d8) { const u32x4 kk = *(const u32x4*)(kr + d8 * 8);
                    y += bf2f(qp[d8 * 4 + 0] & 0xffffu) * bf2f(kk.x & 0xffffu) + bf2f(qp[d8 * 4 + 0] >> 16) * bf2f(kk.x >> 16)
                       + bf2f(qp[d8 * 4 + 1] & 0xffffu) * bf2f(kk.y & 0xffffu) + bf2f(qp[d8 * 4 + 1] >> 16) * bf2f(kk.y >> 16)
                       + bf2f(qp[d8 * 4 + 2] & 0xffffu) * bf2f(kk.z & 0xffffu) + bf2f(qp[d8 * 4 + 2] >> 16) * bf2f(kk.z >> 16)
                       + bf2f(qp[d8 * 4 + 3] & 0xffffu) * bf2f(kk.w & 0xffffu) + bf2f(qp[d8 * 4 + 3] >> 16) * bf2f(kk.w >> 16); }
                if (pp == 0) TOPK_INSERT(tv0, ti0, y, n); else TOPK_INSERT(tv1, ti1, y, n);
            }
        }
        float bv[16]; int bi[16];
#pragma unroll
        for (int j = 0; j < 16; ++j) { bv[j] = -INFINITY; bi[j] = 0; }
#pragma unroll
        for (int k0 = 0; k0 < 16; ++k0)
#pragma unroll
            for (int k1 = 0; k1 < 16; ++k1)
                if ((k0 + 1) * (k1 + 1) <= 16) TOPK_INSERT(bv, bi, tv0[k0] + tv1[k1], ti0[k0] * 128 + ti1[k1]);
        float e[16], sum = 0.f;
#pragma unroll
        for (int j = 0; j < 16; ++j) { e[j] = __expf(bv[j] - bv[0]); sum += e[j]; }
        const float rs = 1.0f / sum;
#pragma unroll
        for (int j = 0; j < 16; ++j) { IDS[(size_t)row * 128 + hh * 16 + j] = bi[j]; G[(size_t)row * 128 + hh * 16 + j] = e[j] * rs; }
    }
}
__device__ __forceinline__ void naive_peer(const Params& p, int gw, int ngw, int lane) {
    const bf16_t* UT = (const bf16_t*)(p.ws + WS_UTB); const bf16_t* VT = (const bf16_t*)(p.ws + WS_VTB);
    const int* IDS = (const int*)(p.ws + WS_IDS); const float* G = (const float*)(p.ws + WS_G);
    for (int row = gw; row < M; row += ngw) {
        f32x4* xr = (f32x4*)(p.out + (size_t)row * 1024) + lane;
        f32x4 xv[4], acc[4];
#pragma unroll
        for (int j = 0; j < 4; ++j) { xv[j] = xr[64 * j]; acc[j] = (f32x4){0.f, 0.f, 0.f, 0.f}; }
        for (int e = 0; e < 128; ++e) {
            const int id = IDS[(size_t)row * 128 + e]; const float gg = G[(size_t)row * 128 + e];
            const u32x2* ur = (const u32x2*)(UT + (size_t)id * 1024) + lane;
            float part = 0.f;
#pragma unroll
            for (int j = 0; j < 4; ++j) { const u32x2 u = ur[64 * j];
                part += xv[j].x * bf2f(u.x & 0xffffu) + xv[j].y * bf2f(u.x >> 16) + xv[j].z * bf2f(u.y & 0xffffu) + xv[j].w * bf2f(u.y >> 16); }
            const float hsum = wave_sum(part);
            const float a = gelu_exact(hsum) * gg;
            const u32x2* vr = (const u32x2*)(VT + (size_t)id * 1024) + lane;
#pragma unroll
            for (int j = 0; j < 4; ++j) { const u32x2 u = vr[64 * j];
                acc[j].x += a * bf2f(u.x & 0xffffu); acc[j].y += a * bf2f(u.x >> 16); acc[j].z += a * bf2f(u.y & 0xffffu); acc[j].w += a * bf2f(u.y >> 16); }
        }
        float s = 0.f;
#pragma unroll
        for (int j = 0; j < 4; ++j) { acc[j] = ALPHA * xv[j] + acc[j]; s += (acc[j].x + acc[j].y) + (acc[j].z + acc[j].w); }
        const float mean = wave_sum(s) * (1.f / 1024.f); float s2 = 0.f;
#pragma unroll
        for (int j = 0; j < 4; ++j) { acc[j] = acc[j] - mean; s2 += (acc[j].x * acc[j].x + acc[j].y * acc[j].y) + (acc[j].z * acc[j].z + acc[j].w * acc[j].w); }
        const float rstd = 1.f / sqrtf(wave_sum(s2) * (1.f / 1024.f) + LN_EPS);
#pragma unroll
        for (int j = 0; j < 4; ++j) { const f32x4 g = ((const f32x4*)p.ln2_g)[lane + 64 * j], bb = ((const f32x4*)p.ln2_b)[lane + 64 * j];
            xr[64 * j] = acc[j] * rstd * g + bb; }
    }
}

#define GT ((size_t)blockIdx.x * blockDim.x + threadIdx.x)
#define GS ((size_t)gridDim.x * blockDim.x)
#define GW ((int)(blockIdx.x * (blockDim.x >> 6) + (threadIdx.x >> 6)))
#define NGW ((int)(gridDim.x * (blockDim.x >> 6)))
#define LANE ((int)(threadIdx.x & 63))

__global__ void __launch_bounds__(256) k_prologue(Params p) {
    __shared__ float scr[4][64 * 33];
    stage_transposes(p, scr[threadIdx.x >> 6], GW, NGW, LANE);
    convert_bf16(p.x, (bf16_t*)(p.ws + WS_XB), (size_t)M * 1024, GT, GS);
    convert_bf16(p.mem, (bf16_t*)(p.ws + WS_MEMB), (size_t)512 * 1024, GT, GS);
    convert_bf16(p.sub_keys, (bf16_t*)(p.ws + WS_SUBK), (size_t)16 * 128 * 128, GT, GS);
    stage_rope(p, GT, GS);
}
__global__ void __launch_bounds__(256) k_proj(Params p) {
    EpiProj e{p.ws};
    naive_gemm((const bf16_t*)(p.ws + WS_XB), 1024, (const bf16_t*)(p.ws + WS_WIN), 1024, M, INW, 1024, e, GW, NGW, LANE);
    EpiPlain e2{(bf16_t*)(p.ws + WS_MEMKV), 1024};
    naive_gemm((const bf16_t*)(p.ws + WS_MEMB), 1024, (const bf16_t*)(p.ws + WS_WMEMKV), 1024, 512, 1024, 1024, e2, GW, NGW, LANE);
}
__global__ void __launch_bounds__(256) k_df(Params p) { naive_df_attn(p, GT, GS); }
__global__ void __launch_bounds__(256) k_sb(Params p) { naive_sb_attn(p, GT, GS); }
__global__ void __launch_bounds__(256) k_mx(Params p) { naive_mx_attn(p, GT, GS); }
__global__ void __launch_bounds__(256) k_dfc(Params p) { stage_df_combine(p, GW, NGW, LANE); }
__global__ void __launch_bounds__(256) k_gates(Params p) {
    EpiGate e{(bf16_t*)(p.ws + WS_GATES), p.b_gate};
    naive_gemm((const bf16_t*)(p.ws + WS_XB), 1024, (const bf16_t*)(p.ws + WS_WGATE), 1024, M, 3072, 1024, e, GW, NGW, LANE);
}
__global__ void __launch_bounds__(256) k_branch(Params p, int b) {
    const size_t osrc = (b == 0) ? WS_OSB : (b == 1 ? WS_ODF : WS_OMX);
    EpiBranch e{(const bf16_t*)(p.ws + WS_GATES), b * 1024, p.out, (bf16_t*)(p.ws + WS_MERGEDB), b};
    naive_gemm((const bf16_t*)(p.ws + osrc), 512, (const bf16_t*)(p.ws + WS_WBR + (size_t)b * MiB), 512, M, 1024, 512, e, GW, NGW, LANE);
}
__global__ void __launch_bounds__(256) k_out(Params p) {
    EpiOut e{p.x, p.out};
    naive_gemm((const bf16_t*)(p.ws + WS_MERGEDB), 1024, (const bf16_t*)(p.ws + WS_WOUT), 1024, M, 1024, 1024, e, GW, NGW, LANE);
}
__global__ void __launch_bounds__(256) k_ln1(Params p) {
    stage_ln1(p, GW, NGW, LANE);
    convert_bf16(p.u_tab, (bf16_t*)(p.ws + WS_UTB), (size_t)NEXP * 1024, GT, GS);
    convert_bf16(p.v_tab, (bf16_t*)(p.ws + WS_VTB), (size_t)NEXP * 1024, GT, GS);
}
__global__ void __launch_bounds__(256) k_query(Params p) {
    EpiPlain e{(bf16_t*)(p.ws + WS_QP), 2048};
    naive_gemm((const bf16_t*)(p.ws + WS_X1B), 1024, (const bf16_t*)(p.ws + WS_WQUERY), 1024, M, 2048, 1024, e, GW, NGW, LANE);
}
__global__ void __launch_bounds__(256) k_route(Params p) { naive_routing(p, GT, GS); }
__global__ void __launch_bounds__(256) k_peer(Params p) { naive_peer(p, GW, NGW, LANE); }

extern "C" void kernel_launch(void* const* d_in, const int* in_sizes, int n_in, void* d_out, int out_size, void* d_ws, size_t ws_size, hipStream_t stream) {
    Params p{};
    p.x = (const float*)d_in[0]; p.mem = (const float*)d_in[1]; p.pos = (const int*)d_in[2];
    p.w_in = (const float*)d_in[3]; p.w_memkv = (const float*)d_in[4]; p.df_lambda = (const float*)d_in[5]; p.df_norm_g = (const float*)d_in[6];
    p.w_gate = (const float*)d_in[7]; p.b_gate = (const float*)d_in[8]; p.w_br_sb = (const float*)d_in[9]; p.w_br_df = (const float*)d_in[10]; p.w_br_mx = (const float*)d_in[11];
    p.w_out = (const float*)d_in[12]; p.ln1_g = (const float*)d_in[13]; p.ln1_b = (const float*)d_in[14]; p.w_query = (const float*)d_in[15]; p.sub_keys = (const float*)d_in[16];
    p.u_tab = (const float*)d_in[17]; p.v_tab = (const float*)d_in[18]; p.ln2_g = (const float*)d_in[19]; p.ln2_b = (const float*)d_in[20];
    p.out = (float*)d_out; p.ws = (unsigned char*)d_ws;
    const dim3 blk(256);
    hipLaunchKernelGGL(k_prologue, dim3(2048), blk, 0, stream, p);
    hipLaunchKernelGGL(k_proj, dim3(4096), blk, 0, stream, p);
    hipLaunchKernelGGL(k_df, dim3(1024), blk, 0, stream, p);
    hipLaunchKernelGGL(k_sb, dim3(512), blk, 0, stream, p);
    hipLaunchKernelGGL(k_mx, dim3(512), blk, 0, stream, p);
    hipLaunchKernelGGL(k_dfc, dim3(1024), blk, 0, stream, p);
    hipLaunchKernelGGL(k_gates, dim3(4096), blk, 0, stream, p);
    for (int b = 0; b < 3; ++b) hipLaunchKernelGGL(k_branch, dim3(4096), blk, 0, stream, p, b);
    hipLaunchKernelGGL(k_out, dim3(4096), blk, 0, stream, p);
    hipLaunchKernelGGL(k_ln1, dim3(2048), blk, 0, stream, p);
    hipLaunchKernelGGL(k_query, dim3(4096), blk, 0, stream, p);
    hipLaunchKernelGGL(k_route, dim3(512), blk, 0, stream, p);
    hipLaunchKernelGGL(k_peer, dim3(2048), blk, 0, stream, p);
}
```

```cpp
#include <hip/hip_runtime.h>
#include <cstdint>
#include <cstdio>
#include <hip/hip_cooperative_groups.h>
namespace cg = cooperative_groups;

typedef unsigned short bf16_t;
typedef short bf16x8 __attribute__((ext_vector_type(8)));
typedef float f32x16 __attribute__((ext_vector_type(16)));
typedef float f32x4 __attribute__((ext_vector_type(4)));
typedef unsigned u32x4 __attribute__((ext_vector_type(4)));
typedef unsigned u32x2 __attribute__((ext_vector_type(2)));

constexpr int BATCH = 2, SEQ = 8192, DM = 1024, M = BATCH * SEQ;
constexpr int MEMLEN = 256;
constexpr int INW = 3584;
constexpr int NEXP = 16384;
constexpr float LOG2E = 1.4426950408889634f;
constexpr float C2_64 = 0.125f * LOG2E;
constexpr float C2_128 = 0.08838834764831845f * LOG2E;
constexpr float ALPHA = 1.189207115002721f;
constexpr float LN_EPS = 1e-5f, RMS_EPS = 1e-5f;
constexpr float LAMBDA_INIT = 0.2f;

constexpr size_t MiB = 1u << 20;
constexpr size_t WS_CTL = 0;
constexpr size_t WS_ROPE = 1 * MiB;
constexpr size_t WS_WIN = 2 * MiB;
constexpr size_t WS_WGATE = 9 * MiB;
constexpr size_t WS_WMEMKV = 15 * MiB;
constexpr size_t WS_WBR = 17 * MiB;
constexpr size_t WS_WOUT = 20 * MiB;
constexpr size_t WS_WQUERY = 22 * MiB;
constexpr size_t WS_SUBK = 26 * MiB;
constexpr size_t WS_MEMB = 27 * MiB;
constexpr size_t WS_MEMKV = 28 * MiB;
constexpr size_t WS_XB = 32 * MiB;
constexpr size_t WS_SBQ = 64 * MiB, WS_SBK = 80 * MiB, WS_SBV = 96 * MiB;
constexpr size_t WS_DFQ = 112 * MiB, WS_DFK = 128 * MiB, WS_DFV = 144 * MiB, WS_MXQ = 160 * MiB;
constexpr size_t WS_ODF16 = 176 * MiB;
constexpr size_t WS_OSB = 208 * MiB, WS_ODF = 224 * MiB, WS_OMX = 240 * MiB;
constexpr size_t WS_GATES = 64 * MiB;
constexpr size_t WS_MERGEDB = 160 * MiB;
constexpr size_t WS_X1B = 32 * MiB;
constexpr size_t WS_QP = 64 * MiB;
constexpr size_t WS_IDS = 128 * MiB;
constexpr size_t WS_G = 136 * MiB;
constexpr size_t WS_UTB = 160 * MiB;
constexpr size_t WS_VTB = 192 * MiB;

struct Params {
    const float *x, *mem; const int* pos;
    const float *w_in, *w_memkv, *df_lambda, *df_norm_g, *w_gate, *b_gate, *w_br_sb, *w_br_df, *w_br_mx, *w_out;
    const float *ln1_g, *ln1_b, *w_query, *sub_keys, *u_tab, *v_tab, *ln2_g, *ln2_b;
    float* out; unsigned char* ws;
};

__device__ __forceinline__ float bf2f(unsigned v) { return __uint_as_float(v << 16); }
__device__ __forceinline__ unsigned f2bf(float f) { unsigned u = __float_as_uint(f); return (u + 0x7fffu + ((u >> 16) & 1u)) >> 16; }
__device__ __forceinline__ unsigned pk2(float lo, float hi) { return f2bf(lo) | (f2bf(hi) << 16); }
__device__ __forceinline__ float wave_sum(float v) {
#pragma unroll
    for (int o = 1; o < 64; o <<= 1) v += __shfl_xor(v, o);
    return v;
}
__device__ __forceinline__ float gelu_exact(float v) { return 0.5f * v * (1.0f + erff(v * 0.70710678118654752f)); }

__device__ __forceinline__ void transpose_item(const float* W, int K, int N, bf16_t* WT, float* scr, int item, int lane) {
    const int nblk = N / 32, kb = item / nblk, nb = item % nblk, k0 = 64 * kb, n0 = 32 * nb;
#pragma unroll 8
    for (int i = 0; i < 32; ++i) { const int kk = 2 * i + (lane >> 5); scr[kk * 33 + (lane & 31)] = W[(size_t)(k0 + kk) * N + n0 + (lane & 31)]; }
    asm volatile("s_waitcnt lgkmcnt(0)" ::: "memory");
    const int c = lane & 7;
#pragma unroll
    for (int j = 0; j < 4; ++j) { const int n = (lane >> 3) + 8 * j; const float* s = scr + (8 * c) * 33 + n;
        u32x4 o; o.x = pk2(s[0 * 33], s[1 * 33]); o.y = pk2(s[2 * 33], s[3 * 33]); o.z = pk2(s[4 * 33], s[5 * 33]); o.w = pk2(s[6 * 33], s[7 * 33]);
        *(u32x4*)(WT + (size_t)(n0 + n) * K + k0 + 8 * c) = o; }
    asm volatile("s_waitcnt lgkmcnt(0)" ::: "memory");
}
__device__ __forceinline__ void stage_transposes(const Params& p, float* scr, int gw, int ngw, int lane) {
    struct TJ { const float* W; int K, N; size_t off; };
    const TJ jobs[8] = {
        {p.w_in, 1024, 3584, WS_WIN}, {p.w_gate, 1024, 3072, WS_WGATE}, {p.w_memkv, 1024, 1024, WS_WMEMKV},
        {p.w_br_sb, 512, 1024, WS_WBR}, {p.w_br_df, 512, 1024, WS_WBR + 1 * MiB}, {p.w_br_mx, 512, 1024, WS_WBR + 2 * MiB},
        {p.w_out, 1024, 1024, WS_WOUT}, {p.w_query, 1024, 2048, WS_WQUERY}};
    int base = 0;
#pragma unroll
    for (int j = 0; j < 8; ++j) {
        const int items = (jobs[j].K / 64) * (jobs[j].N / 32);
        int first = ((gw - base) % ngw + ngw) % ngw;
        for (int it = first; it < items; it += ngw) transpose_item(jobs[j].W, jobs[j].K, jobs[j].N, (bf16_t*)(p.ws + jobs[j].off), scr, it, lane);
        base += items;
    }
}
__device__ __forceinline__ void convert_bf16(const float* src, bf16_t* dst, size_t n, size_t gtid, size_t gsize) {
    const size_t n4 = n / 4;
    for (size_t i = gtid; i < n4; i += gsize) { const f32x4 v = ((const f32x4*)src)[i]; u32x2 o; o.x = pk2(v.x, v.y); o.y = pk2(v.z, v.w); ((u32x2*)dst)[i] = o; }
}
__device__ __forceinline__ void stage_rope(const Params& p, size_t gtid, size_t gsize) {
    const double inv[8] = {1.0, 0.19392274474868576, 0.03760603093086393, 0.007292664737217109, 0.001414213562373095, 0.0002742481756762073, 5.318295896944988e-05, 1.031338537721246e-05};
    float2* tab = (float2*)(p.ws + WS_ROPE);
    for (size_t i = gtid; i < (size_t)M * 8; i += gsize) {
        const int row = (int)(i >> 3), j = (int)(i & 7);
        double iv = inv[0];
#pragma unroll
        for (int q = 1; q < 8; ++q) iv = (j == q) ? inv[q] : iv;
        const double a = (double)p.pos[row] * iv;
        double rev = a * 0.15915494309189535;
        rev -= floor(rev);
        const float rf = (float)rev;
        tab[i] = make_float2(__builtin_amdgcn_cosf(rf), __builtin_amdgcn_sinf(rf));
    }
}

template <class Epi>
__device__ __forceinline__ void naive_gemm(const bf16_t* A, int lda, const bf16_t* Bt, int ldb, int Mr, int N, int K, const Epi& epi, int gw, int ngw, int lane) {
    const int r = lane & 31, h = lane >> 5;
    const int tnc = N / 32, ntiles = (Mr / 32) * tnc;
    for (int t = gw; t < ntiles; t += ngw) {
        const int tm = t / tnc, tn = t % tnc;
        const bf16_t* ap = A + (size_t)(tm * 32 + r) * lda + 8 * h;
        const bf16_t* bp = Bt + (size_t)(tn * 32 + r) * ldb + 8 * h;
        f32x16 acc;
#pragma unroll
        for (int i = 0; i < 16; ++i) acc[i] = 0.f;
        for (int k = 0; k < K; k += 16) {
            const bf16x8 a = *(const bf16x8*)(ap + k); const bf16x8 b = *(const bf16x8*)(bp + k);
            acc = __builtin_amdgcn_mfma_f32_32x32x16_bf16(a, b, acc, 0, 0, 0);
        }
        epi(acc, tm * 32, tn * 32, r, h);
    }
}
#define ACC_ROW(row0, i, h) ((row0) + ((i) & 3) + 8 * ((i) >> 2) + 4 * (h))

struct EpiProj {
    unsigned char* ws;
    __device__ __forceinline__ void operator()(const f32x16& acc, int row0, int col0, int r, int h) const {
        const int region = col0 >> 9;
        const int cc = (col0 & 511) + r;
        const size_t offs[7] = {WS_SBQ, WS_SBK, WS_SBV, WS_DFQ, WS_DFK, WS_DFV, WS_MXQ};
        size_t off = offs[0];
#pragma unroll
        for (int q = 1; q < 7; ++q) off = (region == q) ? offs[q] : off;
        bf16_t* dst = (bf16_t*)(ws + off);
        const float2* rope = (const float2*)(ws + WS_ROPE);
        const float scale = (region == 0 || region == 3) ? C2_64 : (region == 6 ? C2_128 : 1.0f);
        const bool rot = (region == 3 || region == 4);
        const int d = cc & 63;
#pragma unroll
        for (int i = 0; i < 16; ++i) {
            const int row = ACC_ROW(row0, i, h);
            float v = acc[i];
            const float partner = __shfl_xor(v, 8);
            if (rot && d < 16) {
                const float2 cs = rope[(size_t)row * 8 + (d & 7)];
                v = (d < 8) ? (v * cs.x - partner * cs.y) : (v * cs.x + partner * cs.y);
            }
            dst[(size_t)row * 512 + cc] = (bf16_t)f2bf(v * scale);
        }
    }
};
struct EpiPlain {
    bf16_t* dst; int ldc;
    __device__ __forceinline__ void operator()(const f32x16& acc, int row0, int col0, int r, int h) const {
#pragma unroll
        for (int i = 0; i < 16; ++i) dst[(size_t)ACC_ROW(row0, i, h) * ldc + col0 + r] = (bf16_t)f2bf(acc[i]);
    }
};
struct EpiGate {
    bf16_t* dst; const float* bias;
    __device__ __forceinline__ void operator()(const f32x16& acc, int row0, int col0, int r, int h) const {
        const float b = bias[col0 + r];
#pragma unroll
        for (int i = 0; i < 16; ++i) { const float z = acc[i] + b; dst[(size_t)ACC_ROW(row0, i, h) * 3072 + col0 + r] = (bf16_t)f2bf(1.0f / (1.0f + __expf(-z))); }
    }
};
struct EpiBranch {
    const bf16_t* gates; int gcol; float* m32; bf16_t* mb; int mode;
    __device__ __forceinline__ void operator()(const f32x16& acc, int row0, int col0, int r, int h) const {
#pragma unroll
        for (int i = 0; i < 16; ++i) { const size_t row = ACC_ROW(row0, i, h); const int c = col0 + r;
            const float g = bf2f(gates[row * 3072 + gcol + c]); float v = g * acc[i];
            if (mode > 0) v += m32[row * 1024 + c];
            if (mode < 2) m32[row * 1024 + c] = v; else mb[row * 1024 + c] = (bf16_t)f2bf(v); }
    }
};
struct EpiOut {
    const float* x; float* y;
    __device__ __forceinline__ void operator()(const f32x16& acc, int row0, int col0, int r, int h) const {
#pragma unroll
        for (int i = 0; i < 16; ++i) { const size_t o = (size_t)ACC_ROW(row0, i, h) * 1024 + col0 + r; y[o] = ALPHA * x[o] + acc[i]; }
    }
};

__device__ __forceinline__ void naive_df_attn(const Params& p, size_t gtid, size_t gsize) {
    const bf16_t* Q = (const bf16_t*)(p.ws + WS_DFQ); const bf16_t* Kb = (const bf16_t*)(p.ws + WS_DFK); const bf16_t* Vb = (const bf16_t*)(p.ws + WS_DFV);
    bf16_t* O = (bf16_t*)(p.ws + WS_ODF16);
    for (size_t idx = gtid; idx < (size_t)16 * M; idx += gsize) {
        const int t = (int)(idx % SEQ); const int bg = (int)(idx / SEQ); const int g = bg % 16, b = bg / 16;
        const int hh = g >> 2, mm = (g >> 1) & 1, vh = g & 1;
        const int qcol = (hh * 2 + mm) * 64, vcol = (hh * 2 + vh) * 64;
        const size_t row = (size_t)b * SEQ + t;
        float q[64], o[64];
#pragma unroll
        for (int d = 0; d < 64; ++d) { q[d] = bf2f(Q[row * 512 + qcol + d]); o[d] = 0.f; }
        float mx = -1e30f, l = 0.f;
        const int tmax = __shfl(t, 63);
        for (int s = 0; s <= tmax; ++s) {
            const bf16_t* kr = Kb + ((size_t)b * SEQ + s) * 512 + qcol;
            float y = 0.f;
#pragma unroll
            for (int d8 = 0; d8 < 8; ++d8) { const u32x4 kk = *(const u32x4*)(kr + d8 * 8);
                y += q[d8 * 8 + 0] * bf2f(kk.x & 0xffffu) + q[d8 * 8 + 1] * bf2f(kk.x >> 16) + q[d8 * 8 + 2] * bf2f(kk.y & 0xffffu) + q[d8 * 8 + 3] * bf2f(kk.y >> 16)
                   + q[d8 * 8 + 4] * bf2f(kk.z & 0xffffu) + q[d8 * 8 + 5] * bf2f(kk.z >> 16) + q[d8 * 8 + 6] * bf2f(kk.w & 0xffffu) + q[d8 * 8 + 7] * bf2f(kk.w >> 16); }
            if (s > t) y = -INFINITY;
            const float mn = fmaxf(mx, y), al = exp2f(mx - mn), pp = exp2f(y - mn);
            mx = mn; l = l * al + pp;
            const bf16_t* vr = Vb + ((size_t)b * SEQ + s) * 512 + vcol;
#pragma unroll
            for (int d8 = 0; d8 < 8; ++d8) { const u32x4 vv = *(const u32x4*)(vr + d8 * 8);
                o[d8 * 8 + 0] = o[d8 * 8 + 0] * al + pp * bf2f(vv.x & 0xffffu); o[d8 * 8 + 1] = o[d8 * 8 + 1] * al + pp * bf2f(vv.x >> 16);
                o[d8 * 8 + 2] = o[d8 * 8 + 2] * al + pp * bf2f(vv.y & 0xffffu); o[d8 * 8 + 3] = o[d8 * 8 + 3] * al + pp * bf2f(vv.y >> 16);
                o[d8 * 8 + 4] = o[d8 * 8 + 4] * al + pp * bf2f(vv.z & 0xffffu); o[d8 * 8 + 5] = o[d8 * 8 + 5] * al + pp * bf2f(vv.z >> 16);
                o[d8 * 8 + 6] = o[d8 * 8 + 6] * al + pp * bf2f(vv.w & 0xffffu); o[d8 * 8 + 7] = o[d8 * 8 + 7] * al + pp * bf2f(vv.w >> 16); }
        }
        const float rl = 1.0f / l;
#pragma unroll
        for (int d = 0; d < 64; d += 2) *(unsigned*)(O + row * 1024 + g * 64 + d) = pk2(o[d] * rl, o[d + 1] * rl);
    }
}
constexpr float SB_EXIT_BITS = 48.0f;
__device__ __forceinline__ void naive_sb_attn(const Params& p, size_t gtid, size_t gsize) {
    const bf16_t* Q = (const bf16_t*)(p.ws + WS_SBQ); const bf16_t* Kb = (const bf16_t*)(p.ws + WS_SBK); const bf16_t* Vb = (const bf16_t*)(p.ws + WS_SBV);
    bf16_t* O = (bf16_t*)(p.ws + WS_OSB);
    for (size_t idx = gtid; idx < (size_t)8 * M; idx += gsize) {
        const int t = (int)(idx % SEQ); const int bh = (int)(idx / SEQ); const int hh = bh % 8, b = bh / 8;
        const int col = hh * 64;
        const size_t row = (size_t)b * SEQ + t;
        float q[64], o[64];
#pragma unroll
        for (int d = 0; d < 64; ++d) { q[d] = bf2f(Q[row * 512 + col + d]); o[d] = 0.f; }
        float R = 0.f;
        const int tmax = __shfl(t, 63);
        for (int s = tmax - 1; s >= 0; --s) {
            const bf16_t* kr = Kb + ((size_t)b * SEQ + s) * 512 + col;
            float y = 0.f;
#pragma unroll
            for (int d8 = 0; d8 < 8; ++d8) { const u32x4 kk = *(const u32x4*)(kr + d8 * 8);
                y += q[d8 * 8 + 0] * bf2f(kk.x & 0xffffu) + q[d8 * 8 + 1] * bf2f(kk.x >> 16) + q[d8 * 8 + 2] * bf2f(kk.y & 0xffffu) + q[d8 * 8 + 3] * bf2f(kk.y >> 16)
                   + q[d8 * 8 + 4] * bf2f(kk.z & 0xffffu) + q[d8 * 8 + 5] * bf2f(kk.z >> 16) + q[d8 * 8 + 6] * bf2f(kk.w & 0xffffu) + q[d8 * 8 + 7] * bf2f(kk.w >> 16); }
            const bool act = s < t;
            const float sp = fmaxf(y, 0.f) + log2f(1.0f + exp2f(-fabsf(y)));
            float a = 0.f;
            if (act) { R += sp; a = exp2f(y - R); }
            const bf16_t* vr = Vb + ((size_t)b * SEQ + s) * 512 + col;
#pragma unroll
            for (int d8 = 0; d8 < 8; ++d8) { const u32x4 vv = *(const u32x4*)(vr + d8 * 8);
                o[d8 * 8 + 0] += a * bf2f(vv.x & 0xffffu); o[d8 * 8 + 1] += a * bf2f(vv.x >> 16);
                o[d8 * 8 + 2] += a * bf2f(vv.y & 0xffffu); o[d8 * 8 + 3] += a * bf2f(vv.y >> 16);
                o[d8 * 8 + 4] += a * bf2f(vv.z & 0xffffu); o[d8 * 8 + 5] += a * bf2f(vv.z >> 16);
                o[d8 * 8 + 6] += a * bf2f(vv.w & 0xffffu); o[d8 * 8 + 7] += a * bf2f(vv.w >> 16); }
            if (__all(R > SB_EXIT_BITS)) break;
        }
#pragma unroll
        for (int d = 0; d < 64; d += 2) *(unsigned*)(O + row * 512 + col + d) = pk2(o[d], o[d + 1]);
    }
}
__device__ __forceinline__ void naive_mx_attn(const Params& p, size_t gtid, size_t gsize) {
    const bf16_t* Q = (const bf16_t*)(p.ws + WS_MXQ); const bf16_t* KV = (const bf16_t*)(p.ws + WS_MEMKV);
    bf16_t* O = (bf16_t*)(p.ws + WS_OMX);
    for (size_t idx = gtid; idx < (size_t)8 * M; idx += gsize) {
        const int t = (int)(idx % SEQ); const int bq = (int)(idx / SEQ); const int vh = bq & 1, hh = (bq >> 1) & 3, b = bq >> 3;
        const size_t row = (size_t)b * SEQ + t;
        unsigned qp[64]; float o[64];
#pragma unroll
        for (int d = 0; d < 64; ++d) { qp[d] = *(const unsigned*)(Q + row * 512 + hh * 128 + 2 * d); o[d] = 0.f; }
        float mx = -1e30f, l = 0.f;
        for (int m = 0; m < MEMLEN; ++m) {
            const bf16_t* kr = KV + ((size_t)b * MEMLEN + m) * 1024 + hh * 128;
            float y = 0.f;
#pragma unroll
            for (int d8 = 0; d8 < 16; ++d8) { const u32x4 kk = *(const u32x4*)(kr + d8 * 8);
                y += bf2f(qp[d8 * 4 + 0] & 0xffffu) * bf2f(kk.x & 0xffffu) + bf2f(qp[d8 * 4 + 0] >> 16) * bf2f(kk.x >> 16)
                   + bf2f(qp[d8 * 4 + 1] & 0xffffu) * bf2f(kk.y & 0xffffu) + bf2f(qp[d8 * 4 + 1] >> 16) * bf2f(kk.y >> 16)
                   + bf2f(qp[d8 * 4 + 2] & 0xffffu) * bf2f(kk.z & 0xffffu) + bf2f(qp[d8 * 4 + 2] >> 16) * bf2f(kk.z >> 16)
                   + bf2f(qp[d8 * 4 + 3] & 0xffffu) * bf2f(kk.w & 0xffffu) + bf2f(qp[d8 * 4 + 3] >> 16) * bf2f(kk.w >> 16); }
            const float mn = fmaxf(mx, y), al = exp2f(mx - mn), pp = exp2f(y - mn);
            mx = mn; l = l * al + pp;
            const bf16_t* vr = KV + ((size_t)b * MEMLEN + m) * 1024 + 512 + hh * 128 + vh * 64;
#pragma unroll
            for (int d8 = 0; d8 < 8; ++d8) { const u32x4 vv = *(const u32x4*)(vr + d8 * 8);
                o[d8 * 8 + 0] = o[d8 * 8 + 0] * al + pp * bf2f(vv.x & 0xffffu); o[d8 * 8 + 1] = o[d8 * 8 + 1] * al + pp * bf2f(vv.x >> 16);
                o[d8 * 8 + 2] = o[d8 * 8 + 2] * al + pp * bf2f(vv.y & 0xffffu); o[d8 * 8 + 3] = o[d8 * 8 + 3] * al + pp * bf2f(vv.y >> 16);
                o[d8 * 8 + 4] = o[d8 * 8 + 4] * al + pp * bf2f(vv.z & 0xffffu); o[d8 * 8 + 5] = o[d8 * 8 + 5] * al + pp * bf2f(vv.z >> 16);
                o[d8 * 8 + 6] = o[d8 * 8 + 6] * al + pp * bf2f(vv.w & 0xffffu); o[d8 * 8 + 7] = o[d8 * 8 + 7] * al + pp * bf2f(vv.w >> 16); }
        }
        const float rl = 1.0f / l;
#pragma unroll
        for (int d = 0; d < 64; d += 2) *(unsigned*)(O + row * 512 + hh * 128 + vh * 64 + d) = pk2(o[d] * rl, o[d + 1] * rl);
    }
}
__device__ __forceinline__ void stage_df_combine(const Params& p, int gw, int ngw, int lane) {
    const bf16_t* O16 = (const bf16_t*)(p.ws + WS_ODF16); bf16_t* O = (bf16_t*)(p.ws + WS_ODF);
    const float s01 = wave_sum(p.df_lambda[lane] * p.df_lambda[64 + lane]), s23 = wave_sum(p.df_lambda[128 + lane] * p.df_lambda[192 + lane]);
    const float lam = __expf(s01) - __expf(s23) + LAMBDA_INIT;
    const int hh = lane >> 4, dv = (lane & 15) * 8, vh = dv >> 6, d = dv & 63;
    float gn[8];
#pragma unroll
    for (int j = 0; j < 8; ++j) gn[j] = p.df_norm_g[dv + j] * (1.0f - LAMBDA_INIT);
    for (int row = gw; row < M; row += ngw) {
        const u32x4 a = *(const u32x4*)(O16 + (size_t)row * 1024 + (hh * 4 + vh) * 64 + d);
        const u32x4 b = *(const u32x4*)(O16 + (size_t)row * 1024 + (hh * 4 + 2 + vh) * 64 + d);
        float v[8];
        v[0] = bf2f(a.x & 0xffffu) - lam * bf2f(b.x & 0xffffu); v[1] = bf2f(a.x >> 16) - lam * bf2f(b.x >> 16);
        v[2] = bf2f(a.y & 0xffffu) - lam * bf2f(b.y & 0xffffu); v[3] = bf2f(a.y >> 16) - lam * bf2f(b.y >> 16);
        v[4] = bf2f(a.z & 0xffffu) - lam * bf2f(b.z & 0xffffu); v[5] = bf2f(a.z >> 16) - lam * bf2f(b.z >> 16);
        v[6] = bf2f(a.w & 0xffffu) - lam * bf2f(b.w & 0xffffu); v[7] = bf2f(a.w >> 16) - lam * bf2f(b.w >> 16);
        float ss = 0.f;
#pragma unroll
        for (int j = 0; j < 8; ++j) ss += v[j] * v[j];
        ss += __shfl_xor(ss, 1); ss += __shfl_xor(ss, 2); ss += __shfl_xor(ss, 4); ss += __shfl_xor(ss, 8);
        const float rs = 1.0f / sqrtf(ss * (1.0f / 128.0f) + RMS_EPS);
        u32x4 o; o.x = pk2(v[0] * rs * gn[0], v[1] * rs * gn[1]); o.y = pk2(v[2] * rs * gn[2], v[3] * rs * gn[3]);
        o.z = pk2(v[4] * rs * gn[4], v[5] * rs * gn[5]); o.w = pk2(v[6] * rs * gn[6], v[7] * rs * gn[7]);
        *(u32x4*)(O + (size_t)row * 512 + hh * 128 + dv) = o;
    }
}
__device__ __forceinline__ void stage_ln1(const Params& p, int gw, int ngw, int lane) {
    bf16_t* X1B = (bf16_t*)(p.ws + WS_X1B);
    for (int row = gw; row < M; row += ngw) {
        f32x4* yr = (f32x4*)(p.out + (size_t)row * 1024) + lane;
        f32x4 v[4]; float s = 0.f;
#pragma unroll
        for (int j = 0; j < 4; ++j) { v[j] = yr[64 * j]; s += (v[j].x + v[j].y) + (v[j].z + v[j].w); }
        const float mean = wave_sum(s) * (1.f / 1024.f); float s2 = 0.f;
#pragma unroll
        for (int j = 0; j < 4; ++j) { v[j] = v[j] - mean; s2 += (v[j].x * v[j].x + v[j].y * v[j].y) + (v[j].z * v[j].z + v[j].w * v[j].w); }
        const float rstd = 1.f / sqrtf(wave_sum(s2) * (1.f / 1024.f) + LN_EPS);
#pragma unroll
        for (int j = 0; j < 4; ++j) { const f32x4 g = ((const f32x4*)p.ln1_g)[lane + 64 * j], bb = ((const f32x4*)p.ln1_b)[lane + 64 * j];
            const f32x4 o = v[j] * rstd * g + bb; yr[64 * j] = o;
            u32x2 w; w.x = pk2(o.x, o.y); w.y = pk2(o.z, o.w); ((u32x2*)(X1B + (size_t)row * 1024))[lane + 64 * j] = w; }
    }
}
#define TOPK_INSERT(tv, ti, val, id) do { float v_ = (val); int vi_ = (id); \
    _Pragma("unroll") for (int j_ = 0; j_ < 16; ++j_) { const bool gt_ = v_ > tv[j_]; const float t1_ = gt_ ? tv[j_] : v_; const int t2_ = gt_ ? ti[j_] : vi_; \
        tv[j_] = gt_ ? v_ : tv[j_]; ti[j_] = gt_ ? vi_ : ti[j_]; v_ = t1_; vi_ = t2_; } } while (0)
__device__ __forceinline__ void naive_routing(const Params& p, size_t gtid, size_t gsize) {
    const bf16_t* QP = (const bf16_t*)(p.ws + WS_QP); const bf16_t* SK = (const bf16_t*)(p.ws + WS_SUBK);
    int* IDS = (int*)(p.ws + WS_IDS); float* G = (float*)(p.ws + WS_G);
    for (size_t idx = gtid; idx < (size_t)8 * M; idx += gsize) {
        const int row = (int)(idx % M), hh = (int)(idx / M);
        float tv0[16], tv1[16]; int ti0[16], ti1[16];
#pragma unroll
        for (int j = 0; j < 16; ++j) { tv0[j] = -INFINITY; tv1[j] = -INFINITY; ti0[j] = 0; ti1[j] = 0; }
#pragma unroll
        for (int pp = 0; pp < 2; ++pp) {
            unsigned qp[64];
#pragma unroll
            for (int d = 0; d < 64; ++d) qp[d] = *(const unsigned*)(QP + (size_t)row * 2048 + (hh * 2 + pp) * 128 + 2 * d);
            for (int n = 0; n < 128; ++n) {
                const bf16_t* kr = SK + ((size_t)(hh * 2 + pp) * 128 + n) * 128;
                float y = 0.f;
#pragma unroll
                for (int d8 = 0; d8 < 16; ++d8) { const u32x4 kk = *(const u32x4*)(kr + d8 * 8);
                    y += bf2f(qp[d8 * 4 + 0] & 0xffffu) * bf2f(kk.x & 0xffffu) + bf2f(qp[d8 * 4 + 0] >> 16) * bf2f(kk.x >> 16)
                       + bf2f(qp[d8 * 4 + 1] & 0xffffu) * bf2f(kk.y & 0xffffu) + bf2f(qp[d8 * 4 + 1] >> 16) * bf2f(kk.y >> 16)
                       + bf2f(qp[d8 * 4 + 2] & 0xffffu) * bf2f(kk.z & 0xffffu) + bf2f(qp[d8 * 4 + 2] >> 16) * bf2f(kk.z >> 16)
                       + bf2f(qp[d8 * 4 + 3] & 0xffffu) * bf2f(kk.w & 0xffffu) + bf2f(qp[d8 * 4 + 3] >> 16) * bf2f(kk.w >> 16); }
                if (pp == 0) TOPK_INSERT(tv0, ti0, y, n); else TOPK_INSERT(tv1, ti1, y, n);
            }
        }
        float bv[16]; int bi[16];
#pragma unroll
        for (int j = 0; j < 16; ++j) { bv[j] = -INFINITY; bi[j] = 0; }
#pragma unroll
        for (int k0 = 0; k0 < 16; ++k0)
#pragma unroll
            for (int k1 = 0; k1 < 16; ++k1)
                if ((k0 + 1) * (k1 + 1) <= 16) TOPK_INSERT(bv, bi, tv0[k0] + tv1[k1], ti0[k0] * 128 + ti1[k1]);
        float e[16], sum = 0.f;
#pragma unroll
        for (int j = 0; j < 16; ++j) { e[j] = __expf(bv[j] - bv[0]); sum += e[j]; }
        const float rs = 1.0f / sum;
#pragma unroll
        for (int j = 0; j < 16; ++j) { IDS[(size_t)row * 128 + hh * 16 + j] = bi[j]; G[(size_t)row * 128 + hh * 16 + j] = e[j] * rs; }
    }
}
__device__ __forceinline__ void naive_peer(const Params& p, int gw, int ngw, int lane) {
    const bf16_t* UT = (const bf16_t*)(p.ws + WS_UTB); const bf16_t* VT = (const bf16_t*)(p.ws + WS_VTB);
    const int* IDS = (const int*)(p.ws + WS_IDS); const float* G = (const float*)(p.ws + WS_G);
    for (int row = gw; row < M; row += ngw) {
        f32x4* xr = (f32x4*)(p.out + (size_t)row * 1024) + lane;
        f32x4 xv[4], acc[4];
#pragma unroll
        for (int j = 0; j < 4; ++j) { xv[j] = xr[64 * j]; acc[j] = (f32x4){0.f, 0.f, 0.f, 0.f}; }
        for (int e = 0; e < 128; ++e) {
            const int id = IDS[(size_t)row * 128 + e]; const float gg = G[(size_t)row * 128 + e];
            const u32x2* ur = (const u32x2*)(UT + (size_t)id * 1024) + lane;
            float part = 0.f;
#pragma unroll
            for (int j = 0; j < 4; ++j) { const u32x2 u = ur[64 * j];
                part += xv[j].x * bf2f(u.x & 0xffffu) + xv[j].y * bf2f(u.x >> 16) + xv[j].z * bf2f(u.y & 0xffffu) + xv[j].w * bf2f(u.y >> 16); }
            const float hsum = wave_sum(part);
            const float a = gelu_exact(hsum) * gg;
            const u32x2* vr = (const u32x2*)(VT + (size_t)id * 1024) + lane;
#pragma unroll
            for (int j = 0; j < 4; ++j) { const u32x2 u = vr[64 * j];
                acc[j].x += a * bf2f(u.x & 0xffffu); acc[j].y += a * bf2f(u.x >> 16); acc[j].z += a * bf2f(u.y & 0xffffu); acc[j].w += a * bf2f(u.y >> 16); }
        }
        float s = 0.f;
#pragma unroll
        for (int j = 0; j < 4; ++j) { acc[j] = ALPHA * xv[j] + acc[j]; s += (acc[j].x + acc[j].y) + (acc[j].z + acc[j].w); }
        const float mean = wave_sum(s) * (1.f / 1024.f); float s2 = 0.f;
#pragma unroll
        for (int j = 0; j < 4; ++j) { acc[j] = acc[j] - mean; s2 += (acc[j].x * acc[j].x + acc[j].y * acc[j].y) + (acc[j].z * acc[j].z + acc[j].w * acc[j].w); }
        const float rstd = 1.f / sqrtf(wave_sum(s2) * (1.f / 1024.f) + LN_EPS);
#pragma unroll
        for (int j = 0; j < 4; ++j) { const f32x4 g = ((const f32x4*)p.ln2_g)[lane + 64 * j], bb = ((const f32x4*)p.ln2_b)[lane + 64 * j];
            xr[64 * j] = acc[j] * rstd * g + bb; }
    }
}

constexpr int NTHREADS = 512, NWAVES = 8;
constexpr int LDS_BYTES = 147456;

__global__ void __launch_bounds__(NTHREADS, 2) mega(Params p) {
    extern __shared__ __attribute__((aligned(16))) unsigned char lds[];
    cg::grid_group grid = cg::this_grid();
    const int tid = threadIdx.x, lane = tid & 63, wave = tid >> 6;
    const size_t gt = (size_t)blockIdx.x * NTHREADS + tid, gs = (size_t)gridDim.x * NTHREADS;
    const int gw = blockIdx.x * NWAVES + wave, ngw = gridDim.x * NWAVES;

    stage_transposes(p, (float*)(lds + wave * 8448), gw, ngw, lane);
    convert_bf16(p.x, (bf16_t*)(p.ws + WS_XB), (size_t)M * 1024, gt, gs);
    convert_bf16(p.mem, (bf16_t*)(p.ws + WS_MEMB), (size_t)512 * 1024, gt, gs);
    convert_bf16(p.sub_keys, (bf16_t*)(p.ws + WS_SUBK), (size_t)16 * 128 * 128, gt, gs);
    stage_rope(p, gt, gs);
    grid.sync();
    { EpiProj e{p.ws};
      naive_gemm((const bf16_t*)(p.ws + WS_XB), 1024, (const bf16_t*)(p.ws + WS_WIN), 1024, M, INW, 1024, e, gw, ngw, lane);
      EpiPlain e2{(bf16_t*)(p.ws + WS_MEMKV), 1024};
      naive_gemm((const bf16_t*)(p.ws + WS_MEMB), 1024, (const bf16_t*)(p.ws + WS_WMEMKV), 1024, 512, 1024, 1024, e2, gw, ngw, lane); }
    grid.sync();
    naive_df_attn(p, gt, gs);
    naive_sb_attn(p, gt, gs);
    naive_mx_attn(p, gt, gs);
    grid.sync();
    stage_df_combine(p, gw, ngw, lane);
    { EpiGate e{(bf16_t*)(p.ws + WS_GATES), p.b_gate};
      naive_gemm((const bf16_t*)(p.ws + WS_XB), 1024, (const bf16_t*)(p.ws + WS_WGATE), 1024, M, 3072, 1024, e, gw, ngw, lane); }
    grid.sync();
    for (int b = 0; b < 3; ++b) {
        const size_t osrc = (b == 0) ? WS_OSB : (b == 1 ? WS_ODF : WS_OMX);
        EpiBranch e{(const bf16_t*)(p.ws + WS_GATES), b * 1024, p.out, (bf16_t*)(p.ws + WS_MERGEDB), b};
        naive_gemm((const bf16_t*)(p.ws + osrc), 512, (const bf16_t*)(p.ws + WS_WBR + (size_t)b * MiB), 512, M, 1024, 512, e, gw, ngw, lane);
    }
    grid.sync();
    { EpiOut e{p.x, p.out};
      naive_gemm((const bf16_t*)(p.ws + WS_MERGEDB), 1024, (const bf16_t*)(p.ws + WS_WOUT), 1024, M, 1024, 1024, e, gw, ngw, lane); }
    grid.sync();
    stage_ln1(p, gw, ngw, lane);
    convert_bf16(p.u_tab, (bf16_t*)(p.ws + WS_UTB), (size_t)NEXP * 1024, gt, gs);
    convert_bf16(p.v_tab, (bf16_t*)(p.ws + WS_VTB), (size_t)NEXP * 1024, gt, gs);
    grid.sync();
    { EpiPlain e{(bf16_t*)(p.ws + WS_QP), 2048};
      naive_gemm((const bf16_t*)(p.ws + WS_X1B), 1024, (const bf16_t*)(p.ws + WS_WQUERY), 1024, M, 2048, 1024, e, gw, ngw, lane); }
    grid.sync();
    naive_routing(p, gt, gs);
    grid.sync();
    naive_peer(p, gw, ngw, lane);
}

extern "C" void kernel_launch(void* const* d_in, const int* in_sizes, int n_in, void* d_out, int out_size, void* d_ws, size_t ws_size, hipStream_t stream) {
    static int grid_blocks = 0;
    if (!grid_blocks) {
        int dev = 0, cus = 0, per_cu = 0;
        hipGetDevice(&dev);
        hipDeviceGetAttribute(&cus, hipDeviceAttributeMultiprocessorCount, dev);
        hipFuncSetAttribute((const void*)mega, hipFuncAttributeMaxDynamicSharedMemorySize, LDS_BYTES);
        hipOccupancyMaxActiveBlocksPerMultiprocessor(&per_cu, (const void*)mega, NTHREADS, LDS_BYTES);
        if (per_cu < 1) per_cu = 1;
        grid_blocks = cus * per_cu;
    }
    Params p{};
    p.x = (const float*)d_in[0]; p.mem = (const float*)d_in[1]; p.pos = (const int*)d_in[2];
    p.w_in = (const float*)d_in[3]; p.w_memkv = (const float*)d_in[4]; p.df_lambda = (const float*)d_in[5]; p.df_norm_g = (const float*)d_in[6];
    p.w_gate = (const float*)d_in[7]; p.b_gate = (const float*)d_in[8]; p.w_br_sb = (const float*)d_in[9]; p.w_br_df = (const float*)d_in[10]; p.w_br_mx = (const float*)d_in[11];
    p.w_out = (const float*)d_in[12]; p.ln1_g = (const float*)d_in[13]; p.ln1_b = (const float*)d_in[14]; p.w_query = (const float*)d_in[15]; p.sub_keys = (const float*)d_in[16];
    p.u_tab = (const float*)d_in[17]; p.v_tab = (const float*)d_in[18]; p.ln2_g = (const float*)d_in[19]; p.ln2_b = (const float*)d_in[20];
    p.out = (float*)d_out; p.ws = (unsigned char*)d_ws;
    void* args[] = {&p};
    hipError_t e = hipLaunchCooperativeKernel((const void*)mega, dim3(grid_blocks), dim3(NTHREADS), args, LDS_BYTES, stream);
    if (e != hipSuccess) fprintf(stderr, "cooperative launch failed: %s (grid %d)\n", hipGetErrorString(e), grid_blocks);
}
```

```cpp
#include <hip/hip_runtime.h>
#include <cstdint>
#include <cstdio>
#include <hip/hip_cooperative_groups.h>
namespace cg = cooperative_groups;

typedef unsigned short bf16_t;
typedef short bf16x8 __attribute__((ext_vector_type(8)));
typedef float f32x16 __attribute__((ext_vector_type(16)));
typedef float f32x4 __attribute__((ext_vector_type(4)));
typedef unsigned u32x4 __attribute__((ext_vector_type(4)));
typedef unsigned u32x2 __attribute__((ext_vector_type(2)));

constexpr int BATCH = 2, SEQ = 8192, DM = 1024, M = BATCH * SEQ;
constexpr int MEMLEN = 256;
constexpr int INW = 3584;
constexpr int NEXP = 16384;
constexpr float LOG2E = 1.4426950408889634f;
constexpr float C2_64 = 0.125f * LOG2E;
constexpr float C2_128 = 0.08838834764831845f * LOG2E;
constexpr float ALPHA = 1.189207115002721f;
constexpr float LN_EPS = 1e-5f, RMS_EPS = 1e-5f;
constexpr float LAMBDA_INIT = 0.2f;

constexpr size_t MiB = 1u << 20;
constexpr size_t WS_CTL = 0;
constexpr size_t WS_ROPE = 1 * MiB;
constexpr size_t WS_WIN = 2 * MiB;
constexpr size_t WS_WGATE = 9 * MiB;
constexpr size_t WS_WMEMKV = 15 * MiB;
constexpr size_t WS_WBR = 17 * MiB;
constexpr size_t WS_WOUT = 20 * MiB;
constexpr size_t WS_WQUERY = 22 * MiB;
constexpr size_t WS_SUBK = 26 * MiB;
constexpr size_t WS_MEMB = 27 * MiB;
constexpr size_t WS_MEMKV = 28 * MiB;
constexpr size_t WS_XB = 32 * MiB;
constexpr size_t WS_SBQ = 64 * MiB, WS_SBK = 80 * MiB, WS_SBV = 96 * MiB;
constexpr size_t WS_DFQ = 112 * MiB, WS_DFK = 128 * MiB, WS_DFV = 144 * MiB, WS_MXQ = 160 * MiB;
constexpr size_t WS_ODF16 = 176 * MiB;
constexpr size_t WS_OSB = 208 * MiB, WS_ODF = 224 * MiB, WS_OMX = 240 * MiB;
constexpr size_t WS_GATES = 64 * MiB;
constexpr size_t WS_MERGEDB = 160 * MiB;
constexpr size_t WS_X1B = 32 * MiB;
constexpr size_t WS_QP = 64 * MiB;
constexpr size_t WS_IDS = 128 * MiB;
constexpr size_t WS_G = 136 * MiB;
constexpr size_t WS_UTB = 160 * MiB;
constexpr size_t WS_VTB = 192 * MiB;

struct Params {
    const float *x, *mem; const int* pos;
    const float *w_in, *w_memkv, *df_lambda, *df_norm_g, *w_gate, *b_gate, *w_br_sb, *w_br_df, *w_br_mx, *w_out;
    const float *ln1_g, *ln1_b, *w_query, *sub_keys, *u_tab, *v_tab, *ln2_g, *ln2_b;
    float* out; unsigned char* ws;
};

__device__ __forceinline__ float bf2f(unsigned v) { return __uint_as_float(v << 16); }
__device__ __forceinline__ unsigned f2bf(float f) { unsigned u = __float_as_uint(f); return (u + 0x7fffu + ((u >> 16) & 1u)) >> 16; }
__device__ __forceinline__ unsigned pk2(float lo, float hi) { return f2bf(lo) | (f2bf(hi) << 16); }
__device__ __forceinline__ float wave_sum(float v) {
#pragma unroll
    for (int o = 1; o < 64; o <<= 1) v += __shfl_xor(v, o);
    return v;
}
__device__ __forceinline__ float gelu_exact(float v) { return 0.5f * v * (1.0f + erff(v * 0.70710678118654752f)); }

__device__ __forceinline__ void transpose_item(const float* W, int K, int N, bf16_t* WT, float* scr, int item, int lane) {
    const int nblk = N / 32, kb = item / nblk, nb = item % nblk, k0 = 64 * kb, n0 = 32 * nb;
#pragma unroll 8
    for (int i = 0; i < 32; ++i) { const int kk = 2 * i + (lane >> 5); scr[kk * 33 + (lane & 31)] = W[(size_t)(k0 + kk) * N + n0 + (lane & 31)]; }
    asm volatile("s_waitcnt lgkmcnt(0)" ::: "memory");
    const int c = lane & 7;
#pragma unroll
    for (int j = 0; j < 4; ++j) { const int n = (lane >> 3) + 8 * j; const float* s = scr + (8 * c) * 33 + n;
        u32x4 o; o.x = pk2(s[0 * 33], s[1 * 33]); o.y = pk2(s[2 * 33], s[3 * 33]); o.z = pk2(s[4 * 33], s[5 * 33]); o.w = pk2(s[6 * 33], s[7 * 33]);
        *(u32x4*)(WT + (size_t)(n0 + n) * K + k0 + 8 * c) = o; }
    asm volatile("s_waitcnt lgkmcnt(0)" ::: "memory");
}
__device__ __forceinline__ void stage_transposes(const Params& p, float* scr, int gw, int ngw, int lane) {
    struct TJ { const float* W; int K, N; size_t off; };
    const TJ jobs[8] = {
        {p.w_in, 1024, 3584, WS_WIN}, {p.w_gate, 1024, 3072, WS_WGATE}, {p.w_memkv, 1024, 1024, WS_WMEMKV},
        {p.w_br_sb, 512, 1024, WS_WBR}, {p.w_br_df, 512, 1024, WS_WBR + 1 * MiB}, {p.w_br_mx, 512, 1024, WS_WBR + 2 * MiB},
        {p.w_out, 1024, 1024, WS_WOUT}, {p.w_query, 1024, 2048, WS_WQUERY}};
    int base = 0;
#pragma unroll
    for (int j = 0; j < 8; ++j) {
        const int items = (jobs[j].K / 64) * (jobs[j].N / 32);
        int first = ((gw - base) % ngw + ngw) % ngw;
        for (int it = first; it < items; it += ngw) transpose_item(jobs[j].W, jobs[j].K, jobs[j].N, (bf16_t*)(p.ws + jobs[j].off), scr, it, lane);
        base += items;
    }
}
__device__ __forceinline__ void convert_bf16(const float* src, bf16_t* dst, size_t n, size_t gtid, size_t gsize) {
    const size_t n4 = n / 4;
    for (size_t i = gtid; i < n4; i += gsize) { const f32x4 v = ((const f32x4*)src)[i]; u32x2 o; o.x = pk2(v.x, v.y); o.y = pk2(v.z, v.w); ((u32x2*)dst)[i] = o; }
}
__device__ __forceinline__ void stage_rope(const Params& p, size_t gtid, size_t gsize) {
    const double inv[8] = {1.0, 0.19392274474868576, 0.03760603093086393, 0.007292664737217109, 0.001414213562373095, 0.0002742481756762073, 5.318295896944988e-05, 1.031338537721246e-05};
    float2* tab = (float2*)(p.ws + WS_ROPE);
    for (size_t i = gtid; i < (size_t)M * 8; i += gsize) {
        const int row = (int)(i >> 3), j = (int)(i & 7);
        double iv = inv[0];
#pragma unroll
        for (int q = 1; q < 8; ++q) iv = (j == q) ? inv[q] : iv;
        const double a = (double)p.pos[row] * iv;
        double rev = a * 0.15915494309189535;
        rev -= floor(rev);
        const float rf = (float)rev;
        tab[i] = make_float2(__builtin_amdgcn_cosf(rf), __builtin_amdgcn_sinf(rf));
    }
}

template <class Epi>
__device__ __forceinline__ void naive_gemm(const bf16_t* A, int lda, const bf16_t* Bt, int ldb, int Mr, int N, int K, const Epi& epi, int gw, int ngw, int lane) {
    const int r = lane & 31, h = lane >> 5;
    const int tnc = N / 32, ntiles = (Mr / 32) * tnc;
    for (int t = gw; t < ntiles; t += ngw) {
        const int tm = t / tnc, tn = t % tnc;
        const bf16_t* ap = A + (size_t)(tm * 32 + r) * lda + 8 * h;
        const bf16_t* bp = Bt + (size_t)(tn * 32 + r) * ldb + 8 * h;
        f32x16 acc;
#pragma unroll
        for (int i = 0; i < 16; ++i) acc[i] = 0.f;
        for (int k = 0; k < K; k += 16) {
            const bf16x8 a = *(const bf16x8*)(ap + k); const bf16x8 b = *(const bf16x8*)(bp + k);
            acc = __builtin_amdgcn_mfma_f32_32x32x16_bf16(a, b, acc, 0, 0, 0);
        }
        epi(acc, tm * 32, tn * 32, r, h);
    }
}
#define ACC_ROW(row0, i, h) ((row0) + ((i) & 3) + 8 * ((i) >> 2) + 4 * (h))

struct EpiProj {
    unsigned char* ws;
    __device__ __forceinline__ void operator()(const f32x16& acc, int row0, int col0, int r, int h) const {
        const int region = col0 >> 9;
        const int cc = (col0 & 511) + r;
        const size_t offs[7] = {WS_SBQ, WS_SBK, WS_SBV, WS_DFQ, WS_DFK, WS_DFV, WS_MXQ};
        size_t off = offs[0];
#pragma unroll
        for (int q = 1; q < 7; ++q) off = (region == q) ? offs[q] : off;
        bf16_t* dst = (bf16_t*)(ws + off);
        const float2* rope = (const float2*)(ws + WS_ROPE);
        const float scale = (region == 0 || region == 3) ? C2_64 : (region == 6 ? C2_128 : 1.0f);
        const bool rot = (region == 3 || region == 4);
        const int d = cc & 63;
#pragma unroll
        for (int i = 0; i < 16; ++i) {
            const int row = ACC_ROW(row0, i, h);
            float v = acc[i];
            const float partner = __shfl_xor(v, 8);
            if (rot && d < 16) {
                const float2 cs = rope[(size_t)row * 8 + (d & 7)];
                v = (d < 8) ? (v * cs.x - partner * cs.y) : (v * cs.x + partner * cs.y);
            }
            dst[(size_t)row * 512 + cc] = (bf16_t)f2bf(v * scale);
        }
    }
};
struct EpiPlain {
    bf16_t* dst; int ldc;
    __device__ __forceinline__ void operator()(const f32x16& acc, int row0, int col0, int r, int h) const {
#pragma unroll
        for (int i = 0; i < 16; ++i) dst[(size_t)ACC_ROW(row0, i, h) * ldc + col0 + r] = (bf16_t)f2bf(acc[i]);
    }
};
struct EpiGate {
    bf16_t* dst; const float* bias;
    __device__ __forceinline__ void operator()(const f32x16& acc, int row0, int col0, int r, int h) const {
        const float b = bias[col0 + r];
#pragma unroll
        for (int i = 0; i < 16; ++i) { const float z = acc[i] + b; dst[(size_t)ACC_ROW(row0, i, h) * 3072 + col0 + r] = (bf16_t)f2bf(1.0f / (1.0f + __expf(-z))); }
    }
};
struct EpiBranch {
    const bf16_t* gates; int gcol; float* m32; bf16_t* mb; int mode;
    __device__ __forceinline__ void operator()(const f32x16& acc, int row0, int col0, int r, int h) const {
#pragma unroll
        for (int i = 0; i < 16; ++i) { const size_t row = ACC_ROW(row0, i, h); const int c = col0 + r;
            const float g = bf2f(gates[row * 3072 + gcol + c]); float v = g * acc[i];
            if (mode > 0) v += m32[row * 1024 + c];
            if (mode < 2) m32[row * 1024 + c] = v; else mb[row * 1024 + c] = (bf16_t)f2bf(v); }
    }
};
struct EpiOut {
    const float* x; float* y;
    __device__ __forceinline__ void operator()(const f32x16& acc, int row0, int col0, int r, int h) const {
#pragma unroll
        for (int i = 0; i < 16; ++i) { const size_t o = (size_t)ACC_ROW(row0, i, h) * 1024 + col0 + r; y[o] = ALPHA * x[o] + acc[i]; }
    }
};

__device__ __forceinline__ void naive_df_attn(const Params& p, size_t gtid, size_t gsize) {
    const bf16_t* Q = (const bf16_t*)(p.ws + WS_DFQ); const bf16_t* Kb = (const bf16_t*)(p.ws + WS_DFK); const bf16_t* Vb = (const bf16_t*)(p.ws + WS_DFV);
    bf16_t* O = (bf16_t*)(p.ws + WS_ODF16);
    for (size_t idx = gtid; idx < (size_t)16 * M; idx += gsize) {
        const int t = (int)(idx % SEQ); const int bg = (int)(idx / SEQ); const int g = bg % 16, b = bg / 16;
        const int hh = g >> 2, mm = (g >> 1) & 1, vh = g & 1;
        const int qcol = (hh * 2 + mm) * 64, vcol = (hh * 2 + vh) * 64;
        const size_t row = (size_t)b * SEQ + t;
        float q[64], o[64];
#pragma unroll
        for (int d = 0; d < 64; ++d) { q[d] = bf2f(Q[row * 512 + qcol + d]); o[d] = 0.f; }
        float mx = -1e30f, l = 0.f;
        const int tmax = __shfl(t, 63);
        for (int s = 0; s <= tmax; ++s) {
            const bf16_t* kr = Kb + ((size_t)b * SEQ + s) * 512 + qcol;
            float y = 0.f;
#pragma unroll
            for (int d8 = 0; d8 < 8; ++d8) { const u32x4 kk = *(const u32x4*)(kr + d8 * 8);
                y += q[d8 * 8 + 0] * bf2f(kk.x & 0xffffu) + q[d8 * 8 + 1] * bf2f(kk.x >> 16) + q[d8 * 8 + 2] * bf2f(kk.y & 0xffffu) + q[d8 * 8 + 3] * bf2f(kk.y >> 16)
                   + q[d8 * 8 + 4] * bf2f(kk.z & 0xffffu) + q[d8 * 8 + 5] * bf2f(kk.z >> 16) + q[d8 * 8 + 6] * bf2f(kk.w & 0xffffu) + q[d8 * 8 + 7] * bf2f(kk.w >> 16); }
            if (s > t) y = -INFINITY;
            const float mn = fmaxf(mx, y), al = exp2f(mx - mn), pp = exp2f(y - mn);
            mx = mn; l = l * al + pp;
            const bf16_t* vr = Vb + ((size_t)b * SEQ + s) * 512 + vcol;
#pragma unroll
            for (int d8 = 0; d8 < 8; ++d8) { const u32x4 vv = *(const u32x4*)(vr + d8 * 8);
                o[d8 * 8 + 0] = o[d8 * 8 + 0] * al + pp * bf2f(vv.x & 0xffffu); o[d8 * 8 + 1] = o[d8 * 8 + 1] * al + pp * bf2f(vv.x >> 16);
                o[d8 * 8 + 2] = o[d8 * 8 + 2] * al + pp * bf2f(vv.y & 0xffffu); o[d8 * 8 + 3] = o[d8 * 8 + 3] * al + pp * bf2f(vv.y >> 16);
                o[d8 * 8 + 4] = o[d8 * 8 + 4] * al + pp * bf2f(vv.z & 0xffffu); o[d8 * 8 + 5] = o[d8 * 8 + 5] * al + pp * bf2f(vv.z >> 16);
                o[d8 * 8 + 6] = o[d8 * 8 + 6] * al + pp * bf2f(vv.w & 0xffffu); o[d8 * 8 + 7] = o[d8 * 8 + 7] * al + pp * bf2f(vv.w >> 16); }
        }
        const float rl = 1.0f / l;
#pragma unroll
        for (int d = 0; d < 64; d += 2) *(unsigned*)(O + row * 1024 + g * 64 + d) = pk2(o[d] * rl, o[d + 1] * rl);
    }
}
constexpr float SB_EXIT_BITS = 48.0f;
__device__ __forceinline__ void naive_sb_attn(const Params& p, size_t gtid, size_t gsize) {
    const bf16_t* Q = (const bf16_t*)(p.ws + WS_SBQ); const bf16_t* Kb = (const bf16_t*)(p.ws + WS_SBK); const bf16_t* Vb = (const bf16_t*)(p.ws + WS_SBV);
    bf16_t* O = (bf16_t*)(p.ws + WS_OSB);
    for (size_t idx = gtid; idx < (size_t)8 * M; idx += gsize) {
        const int t = (int)(idx % SEQ); const int bh = (int)(idx / SEQ); const int hh = bh % 8, b = bh / 8;
        const int col = hh * 64;
        const size_t row = (size_t)b * SEQ + t;
        float q[64], o[64];
#pragma unroll
        for (int d = 0; d < 64; ++d) { q[d] = bf2f(Q[row * 512 + col + d]); o[d] = 0.f; }
        float R = 0.f;
        const int tmax = __shfl(t, 63);
        for (int s = tmax - 1; s >= 0; --s) {
            const bf16_t* kr = Kb + ((size_t)b * SEQ + s) * 512 + col;
            float y = 0.f;
#pragma unroll
            for (int d8 = 0; d8 < 8; ++d8) { const u32x4 kk = *(const u32x4*)(kr + d8 * 8);
                y += q[d8 * 8 + 0] * bf2f(kk.x & 0xffffu) + q[d8 * 8 + 1] * bf2f(kk.x >> 16) + q[d8 * 8 + 2] * bf2f(kk.y & 0xffffu) + q[d8 * 8 + 3] * bf2f(kk.y >> 16)
                   + q[d8 * 8 + 4] * bf2f(kk.z & 0xffffu) + q[d8 * 8 + 5] * bf2f(kk.z >> 16) + q[d8 * 8 + 6] * bf2f(kk.w & 0xffffu) + q[d8 * 8 + 7] * bf2f(kk.w >> 16); }
            const bool act = s < t;
            const float sp = fmaxf(y, 0.f) + log2f(1.0f + exp2f(-fabsf(y)));
            float a = 0.f;
            if (act) { R += sp; a = exp2f(y - R); }
            const bf16_t* vr = Vb + ((size_t)b * SEQ + s) * 512 + col;
#pragma unroll
            for (int d8 = 0; d8 < 8; ++d8) { const u32x4 vv = *(const u32x4*)(vr + d8 * 8);
                o[d8 * 8 + 0] += a * bf2f(vv.x & 0xffffu); o[d8 * 8 + 1] += a * bf2f(vv.x >> 16);
                o[d8 * 8 + 2] += a * bf2f(vv.y & 0xffffu); o[d8 * 8 + 3] += a * bf2f(vv.y >> 16);
                o[d8 * 8 + 4] += a * bf2f(vv.z & 0xffffu); o[d8 * 8 + 5] += a * bf2f(vv.z >> 16);
                o[d8 * 8 + 6] += a * bf2f(vv.w & 0xffffu); o[d8 * 8 + 7] += a * bf2f(vv.w >> 16); }
            if (__all(R > SB_EXIT_BITS)) break;
        }
#pragma unroll
        for (int d = 0; d < 64; d += 2) *(unsigned*)(O + row * 512 + col + d) = pk2(o[d], o[d + 1]);
    }
}
__device__ __forceinline__ void naive_mx_attn(const Params& p, size_t gtid, size_t gsize) {
    const bf16_t* Q = (const bf16_t*)(p.ws + WS_MXQ); const bf16_t* KV = (const bf16_t*)(p.ws + WS_MEMKV);
    bf16_t* O = (bf16_t*)(p.ws + WS_OMX);
    for (size_t idx = gtid; idx < (size_t)8 * M; idx += gsize) {
        const int t = (int)(idx % SEQ); const int bq = (int)(idx / SEQ); const int vh = bq & 1, hh = (bq >> 1) & 3, b = bq >> 3;
        const size_t row = (size_t)b * SEQ + t;
        unsigned qp[64]; float o[64];
#pragma unroll
        for (int d = 0; d < 64; ++d) { qp[d] = *(const unsigned*)(Q + row * 512 + hh * 128 + 2 * d); o[d] = 0.f; }
        float mx = -1e30f, l = 0.f;
        for (int m = 0; m < MEMLEN; ++m) {
            const bf16_t* kr = KV + ((size_t)b * MEMLEN + m) * 1024 + hh * 128;
            float y = 0.f;
#pragma unroll
            for (int d8 = 0; d8 < 16; ++d8) { const u32x4 kk = *(const u32x4*)(kr + d8 * 8);
                y += bf2f(qp[d8 * 4 + 0] & 0xffffu) * bf2f(kk.x & 0xffffu) + bf2f(qp[d8 * 4 + 0] >> 16) * bf2f(kk.x >> 16)
                   + bf2f(qp[d8 * 4 + 1] & 0xffffu) * bf2f(kk.y & 0xffffu) + bf2f(qp[d8 * 4 + 1] >> 16) * bf2f(kk.y >> 16)
                   + bf2f(qp[d8 * 4 + 2] & 0xffffu) * bf2f(kk.z & 0xffffu) + bf2f(qp[d8 * 4 + 2] >> 16) * bf2f(kk.z >> 16)
                   + bf2f(qp[d8 * 4 + 3] & 0xffffu) * bf2f(kk.w & 0xffffu) + bf2f(qp[d8 * 4 + 3] >> 16) * bf2f(kk.w >> 16); }
            const float mn = fmaxf(mx, y), al = exp2f(mx - mn), pp = exp2f(y - mn);
            mx = mn; l = l * al + pp;
            const bf16_t* vr = KV + ((size_t)b * MEMLEN + m) * 1024 + 512 + hh * 128 + vh * 64;
#pragma unroll
            for (int d8 = 0; d8 < 8; ++d8) { const u32x4 vv = *(const u32x4*)(vr + d8 * 8);
                o[d8 * 8 + 0] = o[d8 * 8 + 0] * al + pp * bf2f(vv.x & 0xffffu); o[d8 * 8 + 1] = o[d8 * 8 + 1] * al + pp * bf2f(vv.x >> 16);
                o[d8 * 8 + 2] = o[d8 * 8 + 2] * al + pp * bf2f(vv.y & 0xffffu); o[d8 * 8 + 3] = o[d8 * 8 + 3] * al + pp * bf2f(vv.y >> 16);
                o[d8 * 8 + 4] = o[d8 * 8 + 4] * al + pp * bf2f(vv.z & 0xffffu); o[d8 * 8 + 5] = o[d8 * 8 + 5] * al + pp * bf2f(vv.z >> 16);
                o[d8 * 8 + 6] = o[d8 * 8 + 6] * al + pp * bf2f(vv.w & 0xffffu); o[d8 * 8 + 7] = o[d8 * 8 + 7] * al + pp * bf2f(vv.w >> 16); }
        }
        const float rl = 1.0f / l;
#pragma unroll
        for (int d = 0; d < 64; d += 2) *(unsigned*)(O + row * 512 + hh * 128 + vh * 64 + d) = pk2(o[d] * rl, o[d + 1] * rl);
    }
}
__device__ __forceinline__ void stage_df_combine(const Params& p, int gw, int ngw, int lane) {
    const bf16_t* O16 = (const bf16_t*)(p.ws + WS_ODF16); bf16_t* O = (bf16_t*)(p.ws + WS_ODF);
    const float s01 = wave_sum(p.df_lambda[lane] * p.df_lambda[64 + lane]), s23 = wave_sum(p.df_lambda[128 + lane] * p.df_lambda[192 + lane]);
    const float lam = __expf(s01) - __expf(s23) + LAMBDA_INIT;
    const int hh = lane >> 4, dv = (lane & 15) * 8, vh = dv >> 6, d = dv & 63;
    float gn[8];
#pragma unroll
    for (int j = 0; j < 8; ++j) gn[j] = p.df_norm_g[dv + j] * (1.0f - LAMBDA_INIT);
    for (int row = gw; row < M; row += ngw) {
        const u32x4 a = *(const u32x4*)(O16 + (size_t)row * 1024 + (hh * 4 + vh) * 64 + d);
        const u32x4 b = *(const u32x4*)(O16 + (size_t)row * 1024 + (hh * 4 + 2 + vh) * 64 + d);
        float v[8];
        v[0] = bf2f(a.x & 0xffffu) - lam * bf2f(b.x & 0xffffu); v[1] = bf2f(a.x >> 16) - lam * bf2f(b.x >> 16);
        v[2] = bf2f(a.y & 0xffffu) - lam * bf2f(b.y & 0xffffu); v[3] = bf2f(a.y >> 16) - lam * bf2f(b.y >> 16);
        v[4] = bf2f(a.z & 0xffffu) - lam * bf2f(b.z & 0xffffu); v[5] = bf2f(a.z >> 16) - lam * bf2f(b.z >> 16);
        v[6] = bf2f(a.w & 0xffffu) - lam * bf2f(b.w & 0xffffu); v[7] = bf2f(a.w >> 16) - lam * bf2f(b.w >> 16);
        float ss = 0.f;
#pragma unroll
        for (int j = 0; j < 8; ++j) ss += v[j] * v[j];
        ss += __shfl_xor(ss, 1); ss += __shfl_xor(ss, 2); ss += __shfl_xor(ss, 4); ss += __shfl_xor(ss, 8);
        const float rs = 1.0f / sqrtf(ss * (1.0f / 128.0f) + RMS_EPS);
        u32x4 o; o.x = pk2(v[0] * rs * gn[0], v[1] * rs * gn[1]); o.y = pk2(v[2] * rs * gn[2], v[3] * rs * gn[3]);
        o.z = pk2(v[4] * rs * gn[4], v[5] * rs * gn[5]); o.w = pk2(v[6] * rs * gn[6], v[7] * rs * gn[7]);
        *(u32x4*)(O + (size_t)row * 512 + hh * 128 + dv) = o;
    }
}
__device__ __forceinline__ void stage_ln1(const Params& p, int gw, int ngw, int lane) {
    bf16_t* X1B = (bf16_t*)(p.ws + WS_X1B);
    for (int row = gw; row < M; row += ngw) {
        f32x4* yr = (f32x4*)(p.out + (size_t)row * 1024) + lane;
        f32x4 v[4]; float s = 0.f;
#pragma unroll
        for (int j = 0; j < 4; ++j) { v[j] = yr[64 * j]; s += (v[j].x + v[j].y) + (v[j].z + v[j].w); }
        const float mean = wave_sum(s) * (1.f / 1024.f); float s2 = 0.f;
#pragma unroll
        for (int j = 0; j < 4; ++j) { v[j] = v[j] - mean; s2 += (v[j].x * v[j].x + v[j].y * v[j].y) + (v[j].z * v[j].z + v[j].w * v[j].w); }
        const float rstd = 1.f / sqrtf(wave_sum(s2) * (1.f / 1024.f) + LN_EPS);
#pragma unroll
        for (int j = 0; j < 4; ++j) { const f32x4 g = ((const f32x4*)p.ln1_g)[lane + 64 * j], bb = ((const f32x4*)p.ln1_b)[lane + 64 * j];
            const f32x4 o = v[j] * rstd * g + bb; yr[64 * j] = o;
            u32x2 w; w.x = pk2(o.x, o.y); w.y = pk2(o.z, o.w); ((u32x2*)(X1B + (size_t)row * 1024))[lane + 64 * j] = w; }
    }
}
#define TOPK_INSERT(tv, ti, val, id) do { float v_ = (val); int vi_ = (id); \
    _Pragma("unroll") for (int j_ = 0; j_ < 16; ++j_) { const bool gt_ = v_ > tv[j_]; const float t1_ = gt_ ? tv[j_] : v_; const int t2_ = gt_ ? ti[j_] : vi_; \
        tv[j_] = gt_ ? v_ : tv[j_]; ti[j_] = gt_ ? vi_ : ti[j_]; v_ = t1_; vi_ = t2_; } } while (0)
__device__ __forceinline__ void naive_routing(const Params& p, size_t gtid, size_t gsize) {
    const bf16_t* QP = (const bf16_t*)(p.ws + WS_QP); const bf16_t* SK = (const bf16_t*)(p.ws + WS_SUBK);
    int* IDS = (int*)(p.ws + WS_IDS); float* G = (float*)(p.ws + WS_G);
    for (size_t idx = gtid; idx < (size_t)8 * M; idx += gsize) {
        const int row = (int)(idx % M), hh = (int)(idx / M);
        float tv0[16], tv1[16]; int ti0[16], ti1[16];
#pragma unroll
        for (int j = 0; j < 16; ++j) { tv0[j] = -INFINITY; tv1[j] = -INFINITY; ti0[j] = 0; ti1[j] = 0; }
#pragma unroll
        for (int pp = 0; pp < 2; ++pp) {
            unsigned qp[64];
#pragma unroll
            for (int d = 0; d < 64; ++d) qp[d] = *(const unsigned*)(QP + (size_t)row * 2048 + (hh * 2 + pp) * 128 + 2 * d);
            for (int n = 0; n < 128; ++n) {
                const bf16_t* kr = SK + ((size_t)(hh * 2 + pp) * 128 + n) * 128;
                float y = 0.f;
#pragma unroll
                for (int d8 = 0; d8 < 16; ++d8) { const u32x4 kk = *(const u32x4*)(kr + d8 * 8);
                    y += bf2f(qp[d8 * 4 + 0] & 0xffffu) * bf2f(kk.x & 0xffffu) + bf2f(qp[d8 * 4 + 0] >> 16) * bf2f(kk.x >> 16)
                       + bf2f(qp[d8 * 4 + 1] & 0xffffu) * bf2f(kk.y & 0xffffu) + bf2f(qp[d8 * 4 + 1] >> 16) * bf2f(kk.y >> 16)
                       + bf2f(qp[d8 * 4 + 2] & 0xffffu) * bf2f(kk.z & 0xffffu) + bf2f(qp[d8 * 4 + 2] >> 16) * bf2f(kk.z >> 16)
                       + bf2f(qp[d8 * 4 + 3] & 0xffffu) * bf2f(kk.w & 0xffffu) + bf2f(qp[d8 * 4 + 3] >> 16) * bf2f(kk.w >> 16); }
                if (pp == 0) TOPK_INSERT(tv0, ti0, y, n); else TOPK_INSERT(tv1, ti1, y, n);
            }
        }
        float bv[16]; int bi[16];
#pragma unroll
        for (int j = 0; j < 16; ++j) { bv[j] = -INFINITY; bi[j] = 0; }
#pragma unroll
        for (int k0 = 0; k0 < 16; ++k0)
#pragma unroll
            for (int k1 = 0; k1 < 16; ++k1)
                if ((k0 + 1) * (k1 + 1) <= 16) TOPK_INSERT(bv, bi, tv0[k0] + tv1[k1], ti0[k0] * 128 + ti1[k1]);
        float e[16], sum = 0.f;
#pragma unroll
        for (int j = 0; j < 16; ++j) { e[j] = __expf(bv[j] - bv[0]); sum += e[j]; }
        const float rs = 1.0f / sum;
#pragma unroll
        for (int j = 0; j < 16; ++j) { IDS[(size_t)row * 128 + hh * 16 + j] = bi[j]; G[(size_t)row * 128 + hh * 16 + j] = e[j] * rs; }
    }
}
__device__ __forceinline__ void naive_peer(const Params& p, int gw, int ngw, int lane) {
    const bf16_t* UT = (const bf16_t*)(p.ws + WS_UTB); const bf16_t* VT = (const bf16_t*)(p.ws + WS_VTB);
    const int* IDS = (const int*)(p.ws + WS_IDS); const float* G = (const float*)(p.ws + WS_G);
    for (int row = gw; row < M; row += ngw) {
        f32x4* xr = (f32x4*)(p.out + (size_t)row * 1024) + lane;
        f32x4 xv[4], acc[4];
#pragma unroll
        for (int j = 0; j < 4; ++j) { xv[j] = xr[64 * j]; acc[j] = (f32x4){0.f, 0.f, 0.f, 0.f}; }
        for (int e = 0; e < 128; ++e) {
            const int id = IDS[(size_t)row * 128 + e]; const float gg = G[(size_t)row * 128 + e];
            const u32x2* ur = (const u32x2*)(UT + (size_t)id * 1024) + lane;
            float part = 0.f;
#pragma unroll
            for (int j = 0; j < 4; ++j) { const u32x2 u = ur[64 * j];
                part += xv[j].x * bf2f(u.x & 0xffffu) + xv[j].y * bf2f(u.x >> 16) + xv[j].z * bf2f(u.y & 0xffffu) + xv[j].w * bf2f(u.y >> 16); }
            const float hsum = wave_sum(part);
            const float a = gelu_exact(hsum) * gg;
            const u32x2* vr = (const u32x2*)(VT + (size_t)id * 1024) + lane;
#pragma unroll
            for (int j = 0; j < 4; ++j) { const u32x2 u = vr[64 * j];
                acc[j].x += a * bf2f(u.x & 0xffffu); acc[j].y += a * bf2f(u.x >> 16); acc[j].z += a * bf2f(u.y & 0xffffu); acc[j].w += a * bf2f(u.y >> 16); }
        }
        float s = 0.f;
#pragma unroll
        for (int j = 0; j < 4; ++j) { acc[j] = ALPHA * xv[j] + acc[j]; s += (acc[j].x + acc[j].y) + (acc[j].z + acc[j].w); }
        const float mean = wave_sum(s) * (1.f / 1024.f); float s2 = 0.f;
#pragma unroll
        for (int j = 0; j < 4; ++j) { acc[j] = acc[j] - mean; s2 += (acc[j].x * acc[j].x + acc[j].y * acc[j].y) + (acc[j].z * acc[j].z + acc[j].w * acc[j].w); }
        const float rstd = 1.f / sqrtf(wave_sum(s2) * (1.f / 1024.f) + LN_EPS);
#pragma unroll
        for (int j = 0; j < 4; ++j) { const f32x4 g = ((const f32x4*)p.ln2_g)[lane + 64 * j], bb = ((const f32x4*)p.ln2_b)[lane + 64 * j];
            xr[64 * j] = acc[j] * rstd * g + bb; }
    }
}

namespace pg8 {
#define PG8_LAS __attribute__((address_space(3)))
typedef unsigned short bf16_t;
typedef short bf16x8 __attribute__((ext_vector_type(8)));
typedef float f32x4 __attribute__((ext_vector_type(4)));
typedef unsigned u32x4 __attribute__((ext_vector_type(4)));
constexpr int BM = 256, BK = 64, HALF = 128, HTB = HALF * BK * 2  , STAGE_BYTES = 8 * HTB, NXCD = 8, WGM = 8;

__host__ __device__ __forceinline__ int lds_byte(int r, int c) { const int st = (r >> 4) * 2 + (c >> 5), rr = r & 15, cc = c & 31, ob = rr * 64 + cc * 2; return st * 1024 + (ob ^ (((ob >> 9) & 1) << 5)); }
__host__ __device__ __forceinline__ void stage_rc(int b, int& R, int& C) { const int st = b / 1024, sb = b % 1024, swz = sb ^ (((sb >> 9) & 1) << 5); R = (st >> 1) * 16 + swz / 64; C = (st & 1) * 32 + (swz % 64) / 2; }
__host__ __device__ __forceinline__ int perm32(int rho) { const int n = rho >> 4, i = rho & 15; return 8 * (i >> 2) + 4 * n + (i & 3); }

struct Unit { int pm, pn; };
struct Gemm { const bf16_t* A; const bf16_t* Bt; int M, N, K; };

struct StaticOrder {
    int nM, nN, nwg, G, c;
    __host__ __device__ void init(int M, int N, int G_, int c_) { nM = M / BM; nN = N / BM; nwg = nM * nN; G = G_; c = c_; }
    __host__ __device__ bool next(int i, Unit& u) const {
        const long L = (long)i * G + c; if (L >= nwg) return false;
        int wgid = (int)L; { const int q = nwg / NXCD, r = nwg % NXCD, xcd = wgid % NXCD, off = wgid / NXCD; wgid = (xcd < r ? xcd * (q + 1) : r * (q + 1) + (xcd - r) * q) + off; }
        const int nig = WGM * nN, gid = wgid / nig, fm = gid * WGM, gsz = (nM - fm) < WGM ? (nM - fm) : WGM;
        u.pm = fm + ((wgid % nig) % gsz); u.pn = (wgid % nig) / gsz; return true;
    }
    __device__ __forceinline__ void a_ready(const Unit&) const {}
    __device__ __forceinline__ void done(const Unit&) const {}
};

typedef float f32x2c_t __attribute__((ext_vector_type(2))); typedef __bf16 bf16x2c_t __attribute__((ext_vector_type(2)));
__device__ __forceinline__ unsigned cvt_pk_bf16(float lo, float hi) { f32x2c_t v = {lo, hi}; bf16x2c_t b = __builtin_convertvector(v, bf16x2c_t); return __builtin_bit_cast(unsigned, b); }
typedef float f32x2 __attribute__((ext_vector_type(2)));
__device__ __forceinline__ f32x2 gelu_pk(f32x2 v) {
    const f32x2 av = __builtin_elementwise_abs(v), d = av * 0.2316418882f + 1.0f;
    f32x2 t; t.x = __builtin_amdgcn_rcpf(d.x); t.y = __builtin_amdgcn_rcpf(d.y);
    f32x2 q = t * 0.5307027145f + (-0.7265760135f); q = q * t + 0.7107068705f; q = q * t + (-0.142248368f); q = q * t + 0.127414796f; q = q * t;
    const f32x2 s = (v * v) * (-0.72134752044f);
    f32x2 e; e.x = __builtin_amdgcn_exp2f(s.x); e.y = __builtin_amdgcn_exp2f(s.y);
    const f32x2 m = v * (q * e), r = v - m;
    f32x2 o; o.x = v.x < 0.f ? m.x : r.x; o.y = v.y < 0.f ? m.y : r.y; return o;
}

template <int ACT  > struct EpiBf16 {
    static constexpr bool PERM = true, AFTER_DRAIN = false; static_assert(ACT == 0 || ACT == 1, "EpiBf16: ACT is 0 (none) or 1 (gelu_pk)");
    bf16_t* O; int ldc; const float* bias; int split_cols; size_t split_stride; float scale0;
    __device__ __forceinline__ void operator()(const f32x4 (&acc)[2][2][4][2], const Unit& u, int wr, int wc, int fr, int fq) const {
        const int row0 = u.pm * BM + wr * 64 + fr; int colt = u.pn * BM; bf16_t* base = O;
        float sc = 1.f; if (split_cols) { const int t = colt / split_cols; base += (size_t)t * split_stride; colt -= t * split_cols; if (t == 0) sc = scale0; }
        const int col0 = colt + wc * 32 + 8 * fq, bcol0 = u.pn * BM + wc * 32 + 8 * fq;
        f32x4 bv[2][2];
#pragma unroll
        for (int bj = 0; bj < 2; ++bj)
#pragma unroll
            for (int n = 0; n < 2; ++n) bv[bj][n] = bias ? *(const f32x4*)(bias + bcol0 + bj * HALF + 4 * n) : (f32x4){0.f, 0.f, 0.f, 0.f};
#pragma unroll
        for (int ai = 0; ai < 2; ++ai)
#pragma unroll
            for (int m = 0; m < 4; ++m) { bf16_t* rowp = base + (size_t)(row0 + ai * HALF + m * 16) * ldc + col0;
#pragma unroll
                for (int bj = 0; bj < 2; ++bj) { f32x4 v0 = acc[ai][bj][m][0] + bv[bj][0], v1 = acc[ai][bj][m][1] + bv[bj][1];
                    if (ACT == 1) { f32x2 a = gelu_pk((f32x2){v0[0], v0[1]}), b = gelu_pk((f32x2){v0[2], v0[3]}), c = gelu_pk((f32x2){v1[0], v1[1]}), d = gelu_pk((f32x2){v1[2], v1[3]});
                        v0 = (f32x4){a.x, a.y, b.x, b.y}; v1 = (f32x4){c.x, c.y, d.x, d.y}; }
                    v0 = v0 * sc; v1 = v1 * sc; u32x4 w; w.x = cvt_pk_bf16(v0[0], v0[1]); w.y = cvt_pk_bf16(v0[2], v0[3]); w.z = cvt_pk_bf16(v1[0], v1[1]); w.w = cvt_pk_bf16(v1[2], v1[3]);
                    *(u32x4*)(rowp + bj * HALF) = w; } }
    }
};


__device__ __forceinline__ float fast_sigmoid(float z) { return __builtin_amdgcn_rcpf(1.0f + __builtin_amdgcn_exp2f(-1.4426950408889634f * z)); }
#define PG8_EPI_LOOP(row0) _Pragma("unroll") for (int ai = 0; ai < 2; ++ai) _Pragma("unroll") for (int m = 0; m < 4; ++m) { const int row = (row0) + ai * HALF + m * 16; _Pragma("unroll") for (int bj = 0; bj < 2; ++bj) { f32x4 v0 = acc[ai][bj][m][0], v1 = acc[ai][bj][m][1];
#define PG8_EPI_END } asm volatile("" ::: "memory"); }
struct EpiProjF {
    static constexpr bool PERM = true, AFTER_DRAIN = false;
    unsigned char* ws;
    __device__ __forceinline__ void operator()(const f32x4 (&acc)[2][2][4][2], const Unit& u, int wr, int wc, int fr, int fq) const {
        const int region = u.pn >> 1;
        const size_t offs[7] = {WS_SBQ, WS_SBK, WS_SBV, WS_DFQ, WS_DFK, WS_DFV, WS_MXQ};
        size_t off = offs[0];
#pragma unroll
        for (int q = 1; q < 7; ++q) off = (region == q) ? offs[q] : off;
        bf16_t* dst = (bf16_t*)(ws + off);
        const float sc = (region == 0 || region == 3) ? C2_64 : (region == 6 ? C2_128 : 1.0f);
        const bool rot = (region == 3 || region == 4) && ((wc & 1) == 0);
        const float sgn = (fq == 0) ? -1.0f : 1.0f;
        const int row0 = u.pm * BM + wr * 64 + fr, colt = (u.pn & 1) * BM + wc * 32 + 8 * fq;
        const f32x4* rope = (const f32x4*)(ws + WS_ROPE);
        PG8_EPI_LOOP(row0)
            if (rot) {
                f32x4 p0, p1;
#pragma unroll
                for (int j = 0; j < 4; ++j) { p0[j] = __shfl_xor(v0[j], 16); p1[j] = __shfl_xor(v1[j], 16); }
                if (fq < 2) {
                    const f32x4 c01 = rope[(size_t)row * 4 + 0], c23 = rope[(size_t)row * 4 + 1], c45 = rope[(size_t)row * 4 + 2], c67 = rope[(size_t)row * 4 + 3];
                    v0[0] = v0[0] * c01[0] + sgn * p0[0] * c01[1]; v0[1] = v0[1] * c01[2] + sgn * p0[1] * c01[3];
                    v0[2] = v0[2] * c23[0] + sgn * p0[2] * c23[1]; v0[3] = v0[3] * c23[2] + sgn * p0[3] * c23[3];
                    v1[0] = v1[0] * c45[0] + sgn * p1[0] * c45[1]; v1[1] = v1[1] * c45[2] + sgn * p1[1] * c45[3];
                    v1[2] = v1[2] * c67[0] + sgn * p1[2] * c67[1]; v1[3] = v1[3] * c67[2] + sgn * p1[3] * c67[3];
                }
            }
            v0 = v0 * sc; v1 = v1 * sc;
            u32x4 w; w.x = cvt_pk_bf16(v0[0], v0[1]); w.y = cvt_pk_bf16(v0[2], v0[3]); w.z = cvt_pk_bf16(v1[0], v1[1]); w.w = cvt_pk_bf16(v1[2], v1[3]);
            *(u32x4*)(dst + (size_t)row * 512 + colt + bj * HALF) = w;
        PG8_EPI_END
    }
};
struct EpiGateF {
    static constexpr bool PERM = true, AFTER_DRAIN = false;
    bf16_t* dst; const float* bias;
    __device__ __forceinline__ void operator()(const f32x4 (&acc)[2][2][4][2], const Unit& u, int wr, int wc, int fr, int fq) const {
        const int row0 = u.pm * BM + wr * 64 + fr, col0 = u.pn * BM + wc * 32 + 8 * fq;
        f32x4 bv[2][2];
#pragma unroll
        for (int bj = 0; bj < 2; ++bj)
#pragma unroll
            for (int n = 0; n < 2; ++n) bv[bj][n] = *(const f32x4*)(bias + col0 + bj * HALF + 4 * n);
        PG8_EPI_LOOP(row0)
            v0 = v0 + bv[bj][0]; v1 = v1 + bv[bj][1];
#pragma unroll
            for (int j = 0; j < 4; ++j) { v0[j] = fast_sigmoid(v0[j]); v1[j] = fast_sigmoid(v1[j]); }
            u32x4 w; w.x = cvt_pk_bf16(v0[0], v0[1]); w.y = cvt_pk_bf16(v0[2], v0[3]); w.z = cvt_pk_bf16(v1[0], v1[1]); w.w = cvt_pk_bf16(v1[2], v1[3]);
            *(u32x4*)(dst + (size_t)row * 3072 + col0 + bj * HALF) = w;
        PG8_EPI_END
    }
};
template <int MODE> struct EpiBranchF {
    static constexpr bool PERM = true, AFTER_DRAIN = false;
    const bf16_t* gates; int gcol; float* m32; bf16_t* mb;
    __device__ __forceinline__ void operator()(const f32x4 (&acc)[2][2][4][2], const Unit& u, int wr, int wc, int fr, int fq) const {
        const int row0 = u.pm * BM + wr * 64 + fr, col0 = u.pn * BM + wc * 32 + 8 * fq;
        PG8_EPI_LOOP(row0)
            const int c = col0 + bj * HALF;
            const u32x4 g = *(const u32x4*)(gates + (size_t)row * 3072 + gcol + c);
            v0[0] *= __uint_as_float(g.x << 16); v0[1] *= __uint_as_float(g.x & 0xffff0000u); v0[2] *= __uint_as_float(g.y << 16); v0[3] *= __uint_as_float(g.y & 0xffff0000u);
            v1[0] *= __uint_as_float(g.z << 16); v1[1] *= __uint_as_float(g.z & 0xffff0000u); v1[2] *= __uint_as_float(g.w << 16); v1[3] *= __uint_as_float(g.w & 0xffff0000u);
            float* mp = m32 + (size_t)row * 1024 + c;
            if (MODE > 0) { v0 = v0 + *(const f32x4*)mp; v1 = v1 + *(const f32x4*)(mp + 4); }
            if (MODE < 2) { *(f32x4*)mp = v0; *(f32x4*)(mp + 4) = v1; }
            else { u32x4 w; w.x = cvt_pk_bf16(v0[0], v0[1]); w.y = cvt_pk_bf16(v0[2], v0[3]); w.z = cvt_pk_bf16(v1[0], v1[1]); w.w = cvt_pk_bf16(v1[2], v1[3]);
                   *(u32x4*)(mb + (size_t)row * 1024 + c) = w; }
        PG8_EPI_END
    }
};
struct EpiOutF {
    static constexpr bool PERM = true, AFTER_DRAIN = false;
    const float* x; float* y;
    __device__ __forceinline__ void operator()(const f32x4 (&acc)[2][2][4][2], const Unit& u, int wr, int wc, int fr, int fq) const {
        const int row0 = u.pm * BM + wr * 64 + fr, col0 = u.pn * BM + wc * 32 + 8 * fq;
        PG8_EPI_LOOP(row0)
            const size_t o = (size_t)row * 1024 + col0 + bj * HALF;
            v0 = v0 + ALPHA * *(const f32x4*)(x + o); v1 = v1 + ALPHA * *(const f32x4*)(x + o + 4);
            *(f32x4*)(y + o) = v0; *(f32x4*)(y + o + 4) = v1;
        PG8_EPI_END
    }
};
struct GateOrder { Unit base;
    __device__ bool next(int i, Unit& u) const { if (i >= 3) return false; u.pm = base.pm; u.pn = 4 * i + base.pn; return true; }
    __device__ __forceinline__ void a_ready(const Unit&) const {} __device__ __forceinline__ void done(const Unit&) const {} };
struct OneOrder { int pm, pn;
    __device__ __forceinline__ bool next(int i, Unit& u) const { if (i >= 1) return false; u.pm = pm; u.pn = pn; return true; }
    __device__ __forceinline__ void a_ready(const Unit&) const {} __device__ __forceinline__ void done(const Unit&) const {} };
struct MemOrder { int c;
    __device__ bool next(int i, Unit& u) const { if (i >= 1 || c < 128 || c >= 136) return false; u.pm = (c - 128) >> 2; u.pn = (c - 128) & 3; return true; }
    __device__ __forceinline__ void a_ready(const Unit&) const {} __device__ __forceinline__ void done(const Unit&) const {} };

template <class Epi, class Sched, bool ALIGN_EPI = false, bool SP2 = false>
__device__ __forceinline__ void gemm_phase(PG8_LAS unsigned char* lds, const Gemm g, const Sched& S, const Epi& E) {
    int tid = threadIdx.x; asm volatile("" : "+v"(tid));
    const int wid = __builtin_amdgcn_readfirstlane(tid >> 6), lane = tid & 63, wr = wid >> 2, wc = wid & 3, fr = lane & 15, fq = lane >> 4;
    const int K = g.K, nt = K / BK;
    unsigned voffA[2], voffB[2];
#pragma unroll
    for (int i = 0; i < 2; ++i) { int R, C; stage_rc(tid * 16 + i * 8192, R, C); const int Rb = Epi::PERM ? ((R & ~31) + perm32(R & 31)) : R;
        voffA[i] = (unsigned)(R * K + C) * 2u; voffB[i] = (unsigned)(Rb * K + C) * 2u; }
    const size_t kstep = (size_t)(BK * 2);
    const size_t hstep = (size_t)HALF * K * 2;
    const size_t tstep = 2 * hstep;
    const unsigned ldsw = (unsigned)wid * 1024u;
    const int aoff = lds_byte(wr * 64 + fr, fq * 8), boff = lds_byte(wc * 32 + fr, fq * 8);
#define PG8_SA(b, h) (((b) * 2 + (h)) * HTB)
#define PG8_SB(b, h) ((4 + (b) * 2 + (h)) * HTB)
#define PG8_STAGE(bufoff, gbase, voff) do { _Pragma("unroll") for (int _i = 0; _i < 2; ++_i) \
        __builtin_amdgcn_global_load_lds((const unsigned*)((const char*)(gbase) + (voff)[_i]), (PG8_LAS unsigned*)(lds + (bufoff) + ldsw + _i * 8192), 16, 0, 0); } while (0)
#define PG8_LDA(dst, b, h) do { _Pragma("unroll") for (int m = 0; m < 4; ++m) _Pragma("unroll") for (int k = 0; k < 2; ++k) dst[m][k] = *(const PG8_LAS bf16x8*)(lds + PG8_SA(b, h) + aoff + m * 2048 + k * 1024); } while (0)
#define PG8_LDB(dst, b, h) do { _Pragma("unroll") for (int n = 0; n < 2; ++n) _Pragma("unroll") for (int k = 0; k < 2; ++k) dst[n][k] = *(const PG8_LAS bf16x8*)(lds + PG8_SB(b, h) + boff + n * 2048 + k * 1024); } while (0)
#define PG8_MMA(ai, bj, At, Bt) do { __builtin_amdgcn_s_setprio(1); _Pragma("unroll") for (int m = 0; m < 4; ++m) _Pragma("unroll") for (int n = 0; n < 2; ++n) _Pragma("unroll") for (int k = 0; k < 2; ++k) \
        acc[ai][bj][m][n] = __builtin_amdgcn_mfma_f32_16x16x32_bf16(Bt[n][k], At[m][k], acc[ai][bj][m][n], 0, 0, 0); __builtin_amdgcn_s_setprio(0); } while (0)
#define PG8_WAIT_V(n) asm volatile("s_waitcnt vmcnt(" #n ")" ::: "memory")
#define PG8_WAIT_L(n) asm volatile("s_waitcnt lgkmcnt(" #n ")" ::: "memory")
#define PG8_BAR __builtin_amdgcn_s_barrier()
#define PG8_SCHED __builtin_amdgcn_sched_barrier(0)
    Unit cur, nxt; int ui = 0;
    if (!S.next(0, cur)) return;
    f32x4 acc[2][2][4][2];
#pragma unroll
    for (int a = 0; a < 2; ++a)
#pragma unroll
        for (int b = 0; b < 2; ++b)
#pragma unroll
            for (int m = 0; m < 4; ++m)
#pragma unroll
                for (int n = 0; n < 2; ++n) acc[a][b][m][n] = (f32x4){0.f, 0.f, 0.f, 0.f};
    bf16x8 At[4][2], B0[2][2], B1[2][2];
    const char* cA = (const char*)g.A + (size_t)cur.pm * tstep; const char* cB = (const char*)g.Bt + (size_t)cur.pn * tstep;
    S.a_ready(cur);
    if constexpr (SP2) {
        PG8_STAGE(PG8_SB(0, 0), cB, voffB); PG8_STAGE(PG8_SB(0, 1), cB + hstep, voffB); PG8_STAGE(PG8_SA(0, 0), cA, voffA); PG8_STAGE(PG8_SA(0, 1), cA + hstep, voffA);
        if (wr == 1) PG8_BAR;
        PG8_WAIT_V(2); PG8_BAR;
        PG8_STAGE(PG8_SB(1, 0), cB + kstep, voffB); PG8_STAGE(PG8_SA(1, 0), cA + kstep, voffA); PG8_STAGE(PG8_SB(1, 1), cB + hstep + kstep, voffB);
        PG8_WAIT_V(6); PG8_BAR;
    } else {
        PG8_STAGE(PG8_SB(0, 0), cB, voffB); PG8_STAGE(PG8_SA(0, 0), cA, voffA); PG8_STAGE(PG8_SB(0, 1), cB + hstep, voffB); PG8_STAGE(PG8_SA(0, 1), cA + hstep, voffA);
        if (wr == 1) PG8_BAR;
        PG8_WAIT_V(4); PG8_BAR;
        PG8_STAGE(PG8_SB(1, 0), cB + kstep, voffB); PG8_STAGE(PG8_SA(1, 0), cA + kstep, voffA); PG8_STAGE(PG8_SB(1, 1), cB + hstep + kstep, voffB);
        PG8_WAIT_V(6); PG8_BAR;
    }
    for (;;) {
        const bool has_next = S.next(ui + 1, nxt);
        const char* nA = has_next ? (const char*)g.A + (size_t)nxt.pm * tstep : cA; const char* nB = has_next ? (const char*)g.Bt + (size_t)nxt.pn * tstep : cB;
        for (int t = 0; t < nt; t += 2) {
            const bool last = (t == nt - 2);
            const char* a1 = cA + (size_t)(t + 1) * kstep;
            const char* a2 = last ? nA : cA + (size_t)(t + 2) * kstep; const char* b2 = last ? nB : cB + (size_t)(t + 2) * kstep;
            const char* a3 = a2 + kstep; const char* b3 = b2 + kstep;
            if (last && has_next) S.a_ready(nxt);
            if constexpr (SP2) {
            PG8_LDB(B0, 0, 0); PG8_LDB(B1, 0, 1); PG8_SCHED; PG8_LDA(At, 0, 0); PG8_STAGE(PG8_SA(1, 1), a1 + hstep, voffA);
            PG8_WAIT_V(8); PG8_WAIT_L(0); PG8_BAR; PG8_MMA(0, 0, At, B0); PG8_MMA(0, 1, At, B1); PG8_BAR; PG8_SCHED;
            PG8_LDA(At, 0, 1); PG8_STAGE(PG8_SB(0, 0), b2, voffB); PG8_STAGE(PG8_SB(0, 1), b2 + hstep, voffB); PG8_STAGE(PG8_SA(0, 0), a2, voffA);
            PG8_WAIT_V(8); PG8_WAIT_L(0); PG8_BAR; PG8_MMA(1, 0, At, B0); PG8_MMA(1, 1, At, B1); PG8_BAR; PG8_SCHED;
            PG8_LDB(B0, 1, 0); PG8_LDB(B1, 1, 1); PG8_SCHED; PG8_LDA(At, 1, 0); PG8_STAGE(PG8_SA(0, 1), a2 + hstep, voffA);
            PG8_WAIT_V(8); PG8_WAIT_L(0); PG8_BAR; PG8_MMA(0, 0, At, B0); PG8_MMA(0, 1, At, B1); PG8_BAR; PG8_SCHED;
            PG8_LDA(At, 1, 1); PG8_STAGE(PG8_SB(1, 0), b3, voffB); PG8_STAGE(PG8_SB(1, 1), b3 + hstep, voffB); PG8_STAGE(PG8_SA(1, 0), a3, voffA);
            PG8_WAIT_V(8); PG8_WAIT_L(0); PG8_BAR; PG8_MMA(1, 0, At, B0); PG8_MMA(1, 1, At, B1); PG8_BAR; PG8_SCHED;
            } else {
            PG8_LDB(B0, 0, 0); PG8_SCHED; PG8_LDA(At, 0, 0); PG8_STAGE(PG8_SA(1, 1), a1 + hstep, voffA);
            PG8_WAIT_L(8); PG8_BAR; PG8_WAIT_L(0); PG8_MMA(0, 0, At, B0); PG8_BAR; PG8_SCHED;
            PG8_LDB(B1, 0, 1); PG8_STAGE(PG8_SB(0, 0), b2, voffB);
            PG8_BAR; PG8_WAIT_L(0); PG8_MMA(0, 1, At, B1); PG8_BAR;
            PG8_LDA(At, 0, 1); PG8_STAGE(PG8_SA(0, 0), a2, voffA);
            PG8_BAR; PG8_WAIT_L(0); PG8_MMA(1, 0, At, B0); PG8_BAR; PG8_SCHED;
            PG8_STAGE(PG8_SB(0, 1), b2 + hstep, voffB);
            PG8_WAIT_V(6); PG8_BAR; PG8_MMA(1, 1, At, B1); PG8_BAR;
            PG8_LDB(B0, 1, 0); PG8_SCHED; PG8_LDA(At, 1, 0); PG8_STAGE(PG8_SA(0, 1), a2 + hstep, voffA);
            PG8_WAIT_L(8); PG8_BAR; PG8_WAIT_L(0); PG8_MMA(0, 0, At, B0); PG8_BAR; PG8_SCHED;
            PG8_LDB(B1, 1, 1); PG8_STAGE(PG8_SB(1, 0), b3, voffB);
            PG8_BAR; PG8_WAIT_L(0); PG8_MMA(0, 1, At, B1); PG8_BAR;
            PG8_LDA(At, 1, 1); PG8_STAGE(PG8_SA(1, 0), a3, voffA);
            PG8_BAR; PG8_WAIT_L(0); PG8_MMA(1, 0, At, B0); PG8_BAR; PG8_SCHED;
            PG8_STAGE(PG8_SB(1, 1), b3 + hstep, voffB);
            PG8_WAIT_V(6); PG8_BAR; PG8_MMA(1, 1, At, B1); PG8_BAR;
            }
        }
        if constexpr (ALIGN_EPI) { if (wr == 0) PG8_BAR; }
        if constexpr (!Epi::AFTER_DRAIN) { E(acc, cur, wr, wc, fr, fq); S.done(cur); }
        if (!has_next) break;
#pragma unroll
        for (int a = 0; a < 2; ++a)
#pragma unroll
            for (int b = 0; b < 2; ++b)
#pragma unroll
                for (int m = 0; m < 4; ++m)
#pragma unroll
                    for (int n = 0; n < 2; ++n) acc[a][b][m][n] = (f32x4){0.f, 0.f, 0.f, 0.f};
        cur = nxt; cA = nA; cB = nB; ++ui;
        if constexpr (ALIGN_EPI) { if (wr == 1) PG8_BAR; }
    }
    PG8_WAIT_V(0);
    if constexpr (!ALIGN_EPI) { if (wr == 0) PG8_BAR; }
    PG8_BAR;
    if constexpr (Epi::AFTER_DRAIN) { E.fused(acc, cur, wr, wc, fr, fq, lds, wid, lane); S.done(cur); }
#undef PG8_SA
#undef PG8_SB
#undef PG8_STAGE
#undef PG8_LDA
#undef PG8_LDB
#undef PG8_MMA
#undef PG8_WAIT_V
#undef PG8_WAIT_L
#undef PG8_BAR
#undef PG8_SCHED
}
}

#ifndef PG8_SP2
#define PG8_SP2 true
#endif
#ifndef PG8_ALIGN
#define PG8_ALIGN true
#endif

#include <hip/hip_bf16.h>
#include <cmath>
namespace attn_body {
using bf16=__hip_bfloat16;
using bf16x8=__attribute__((ext_vector_type(8)))short;
using s16x4=__attribute__((ext_vector_type(4)))short;
using f32x16=__attribute__((ext_vector_type(16)))float;
using u32x4=__attribute__((ext_vector_type(4)))unsigned;
constexpr int BATCH=2,NHEAD=16,SEQ=8192,D=64,DM=NHEAD*D,PQ=512,PO=1024;
constexpr int NW=8,QBLK=32,QB=QBLK*NW,KVBLK=64,NQB=SEQ/QB;
constexpr int ATTN_PITCH=DM, ATTN_UNIT_ROWS=QB;
__device__ __forceinline__ int crow(int r,int hi){return (r&3)+8*(r>>2)+4*hi;}
#define SBAR() __builtin_amdgcn_sched_barrier(0)
__device__ __forceinline__ void cmask(f32x16&p0,f32x16&p1,int jb,int qrel,int hi){
  const float NEG=-INFINITY; int kb=64*jb+4*hi;
  #pragma unroll
  for(int r=0;r<16;++r){int kv=kb+(r&3)+8*(r>>2); if(kv>qrel)p0[r]=NEG; if(kv+32>qrel)p1[r]=NEG;}
}

constexpr int NSLOT=3, SLOTB=8192;
constexpr int LDS_K=0, LDS_V=NSLOT*SLOTB, LDS_WS=2*NSLOT*SLOTB, LDS_OST=LDS_WS+NW*64*4, LDS_BYTES=LDS_OST+NW*4096;
constexpr float C2=0.125f*1.4426950408889634f;
__device__ __forceinline__ void glds16(const void*gsrc,unsigned lds_dst){unsigned keep;
  asm volatile("s_mov_b32 %0, m0\n\ts_mov_b32 m0, %2\n\ts_nop 0\n\tglobal_load_lds_dwordx4 %1, off\n\ts_mov_b32 m0, %0":"=&s"(keep):"v"(gsrc),"s"(lds_dst):"memory");}
__device__ __forceinline__ float max3f(float a,float b,float c){float r;asm("v_max3_f32 %0, %1, %2, %3":"=v"(r):"v"(a),"v"(b),"v"(c));return r;}
__device__ __forceinline__ float max2f(float a,float b){float r;asm("v_max_f32_e32 %0, %1, %2":"=v"(r):"v"(a),"v"(b));return r;}
__device__ __forceinline__ float fadd_s(float a,float b){float r;asm("v_add_f32_e32 %0, %1, %2":"=v"(r):"v"(a),"v"(b));return r;}
__device__ __forceinline__ float fsub_s(float a,float b){float r;asm("v_sub_f32_e32 %0, %1, %2":"=v"(r):"v"(a),"v"(b));return r;}
typedef float f32x2_t __attribute__((ext_vector_type(2))); typedef __bf16 bf16x2_t __attribute__((ext_vector_type(2)));
__device__ __forceinline__ unsigned cvtpk_s(float lo,float hi){f32x2_t v={lo,hi};bf16x2_t b=__builtin_convertvector(v,bf16x2_t);return __builtin_bit_cast(unsigned,b);}
#define WAIT_BAR(N) asm volatile("s_waitcnt vmcnt(" #N ") lgkmcnt(0)\n\ts_barrier":::"memory")

__device__ __forceinline__ void qkt(f32x16&p0,f32x16&p1,const char*Kslot,const bf16x8*qr,const f32x16&negm,int r32,int hi){
  const char*kb=Kslot+hi*1024+r32*16;
  #pragma unroll
  for(int d0=0;d0<4;++d0){
    const bf16x8 b0=*reinterpret_cast<const bf16x8*>(kb+d0*2048);
    const bf16x8 b1=*reinterpret_cast<const bf16x8*>(kb+d0*2048+512);
    if(d0==0){p0=__builtin_amdgcn_mfma_f32_32x32x16_bf16(b0,qr[0],negm,0,0,0);p1=__builtin_amdgcn_mfma_f32_32x32x16_bf16(b1,qr[0],negm,0,0,0);}
    else{p0=__builtin_amdgcn_mfma_f32_32x32x16_bf16(b0,qr[d0],p0,0,0,0);p1=__builtin_amdgcn_mfma_f32_32x32x16_bf16(b1,qr[d0],p1,0,0,0);}}
}
typedef __attribute__((address_space(3))) const char* lds_cptr;
typedef short v4i16_t __attribute__((ext_vector_type(4)));
__device__ __forceinline__ void kload8(bf16x8*kf,lds_cptr kp){
  kf[0]=*(const __attribute__((address_space(3))) bf16x8*)(kp);      kf[1]=*(const __attribute__((address_space(3))) bf16x8*)(kp+512);
  kf[2]=*(const __attribute__((address_space(3))) bf16x8*)(kp+2048); kf[3]=*(const __attribute__((address_space(3))) bf16x8*)(kp+2560);
  kf[4]=*(const __attribute__((address_space(3))) bf16x8*)(kp+4096); kf[5]=*(const __attribute__((address_space(3))) bf16x8*)(kp+4608);
  kf[6]=*(const __attribute__((address_space(3))) bf16x8*)(kp+6144); kf[7]=*(const __attribute__((address_space(3))) bf16x8*)(kp+6656);
}
__device__ __forceinline__ void kload2(bf16x8*kf,lds_cptr kp,int j){ kf[2*j]=*(const __attribute__((address_space(3))) bf16x8*)(kp+j*2048); kf[2*j+1]=*(const __attribute__((address_space(3))) bf16x8*)(kp+j*2048+512); }
__device__ __forceinline__ s16x4 vtr(lds_cptr p){ return __builtin_bit_cast(s16x4,__builtin_amdgcn_ds_read_tr16_b64_v4i16((__attribute__((address_space(3))) v4i16_t*)p)); }
__device__ __forceinline__ float rowmax(const f32x16&p0,const f32x16&p1){
  float a=max3f(p0[0],p0[1],p1[0]),b=max3f(p0[2],p0[3],p1[1]);a=max3f(a,p1[2],p1[3]);
  #pragma unroll
  for(int r=4;r<16;r+=4){a=max3f(a,p0[r],p0[r+1]);b=max3f(b,p0[r+2],p0[r+3]);a=max3f(a,p1[r],p1[r+1]);b=max3f(b,p1[r+2],p1[r+3]);}
  const float m=max2f(a,b);
  auto rr=__builtin_amdgcn_permlane32_swap(__float_as_uint(m),__float_as_uint(m),false,false);
  return max2f(__uint_as_float(rr[0]),__uint_as_float(rr[1]));
}
__device__ __forceinline__ void pv(f32x16*o,int vb,bf16x8 pa0,bf16x8 pa1,bf16x8 pa2,bf16x8 pa3){
  #pragma unroll
  for(int d0=0;d0<2;++d0){s16x4 lo[4],hi[4];
    #pragma unroll
    for(int ks=0;ks<4;++ks){
      asm volatile("ds_read_b64_tr_b16 %0,%1 offset:%c2":"=&v"(lo[ks]):"v"(vb),"i"(d0*4096+ks*1024):"memory");
      asm volatile("ds_read_b64_tr_b16 %0,%1 offset:%c2":"=&v"(hi[ks]):"v"(vb),"i"(d0*4096+ks*1024+512):"memory");}
    asm volatile("s_waitcnt lgkmcnt(0)":::"memory");SBAR();
    #define PK(k) (bf16x8){lo[k][0],lo[k][1],lo[k][2],lo[k][3],hi[k][0],hi[k][1],hi[k][2],hi[k][3]}
    o[d0]=__builtin_amdgcn_mfma_f32_32x32x16_bf16(pa0,PK(0),o[d0],0,0,0);
    o[d0]=__builtin_amdgcn_mfma_f32_32x32x16_bf16(pa1,PK(1),o[d0],0,0,0);
    o[d0]=__builtin_amdgcn_mfma_f32_32x32x16_bf16(pa2,PK(2),o[d0],0,0,0);
    o[d0]=__builtin_amdgcn_mfma_f32_32x32x16_bf16(pa3,PK(3),o[d0],0,0,0);
    #undef PK
  }
}

#ifndef ATTN_STORE16
#define ATTN_STORE16(p,v) (*(u32x4*)(p)=(v))
#endif
template<int THRL> __device__ __forceinline__ void attn_unit(int b,int h,int qb,const bf16*Q,const bf16*__restrict__ K,const bf16*__restrict__ V,bf16*O,char*shm){
  int tid=threadIdx.x; asm volatile("":"+v"(tid)); const int lane=tid&63,r32=lane&31,hi=lane>>5; const int wid=__builtin_amdgcn_readfirstlane(tid>>6);
  const long rowbase=(long)b*SEQ; const int q0=qb*QB;
  const bf16*Qw=Q+(rowbase+q0+wid*QBLK)*PQ;
  const bf16*Kh=K+rowbase*PQ,*Vh=V+rowbase*PQ;
  const unsigned lds0=(unsigned)(uintptr_t)shm;
  float*wsf=(float*)(shm+LDS_WS)+wid*64;
  const bf16*ksrc=Kh+(long)lane*PQ+wid*8;
  const bf16*vsrc=Vh+(long)(16*(wid&3)+(lane>>2))*PQ+(wid>>2)*32+(lane&3)*8;
  const unsigned kdst=lds0+LDS_K+wid*1024, vdst=lds0+LDS_V+wid*1024;
  #define DMA_K(t,slot) glds16(ksrc+(long)(t)*KVBLK*PQ,(unsigned)__builtin_amdgcn_readfirstlane(kdst+(slot)))
  #define DMA_V(t,slot) glds16(vsrc+(long)(t)*KVBLK*PQ,(unsigned)__builtin_amdgcn_readfirstlane(vdst+(slot)))
  const int vb0=(int)(lds0+LDS_V)+((lane>>4)&1)*32+(lane&3)*8+(4*hi+((lane&15)>>2))*64;
  const char*Kbase=shm+LDS_K; bf16x8 kf[8];
  const lds_cptr shm3=(lds_cptr)shm; const lds_cptr kp0=shm3+LDS_K+hi*1024+r32*16; const lds_cptr vp0=shm3+LDS_V+((lane>>4)&1)*32+(lane&3)*8+(4*hi+((lane&15)>>2))*64;
  const int NT=(q0+QB)/KVBLK;
  DMA_K(0,0);DMA_V(0,0);DMA_K(1,SLOTB);
  bf16x8 qr[4];
  #pragma unroll
  for(int d0=0;d0<4;++d0)qr[d0]=*reinterpret_cast<const bf16x8*>(&Qw[(long)r32*PQ+d0*16+hi*8]);
  float mhat=0.f,l_reg=0.f;f32x16 o[2];o[0]=f32x16{};o[1]=f32x16{};f32x16 negm=f32x16{};asm volatile("":"+v"(negm));
  const int qrel=wid*QBLK+r32;
  #define CMASK(P0,P1,t) do{int jb_=(t)-(NT-4); if(jb_>=0)cmask(P0,P1,jb_,qrel,hi);}while(0)
  bool resc=false;
  #define START(P0,P1) do{ const float rm=rowmax(P0,P1); resc=false; \
    { const float dl=rm; mhat=fadd_s(mhat,dl); \
      _Pragma("unroll") for(int r=0;r<16;++r){P0[r]=fsub_s(P0[r],dl);P1[r]=fsub_s(P1[r],dl);} \
      _Pragma("unroll") for(int r=0;r<16;++r)negm[r]=-mhat; asm volatile("":"+v"(negm)); } \
    _Pragma("unroll") for(int r=0;r<16;++r)P0[r]=__builtin_amdgcn_exp2f(P0[r]); }while(0)
  #define RESC() do{ if(resc){ asm volatile("s_waitcnt lgkmcnt(0)":::"memory"); \
      _Pragma("unroll") for(int d_=0;d_<2;++d_) _Pragma("unroll") for(int r=0;r<16;++r)o[d_][r]*=wsf[crow(r,hi)]; } }while(0)
  f32x16 pA0,pA1,pB0,pB1;
  int sl_prev=0,sl_cur=0,sl_next=SLOTB;
  #define ROT() do{sl_prev=sl_cur;sl_cur=sl_next;sl_next=(sl_next==(NSLOT-1)*SLOTB)?0:sl_next+SLOTB;}while(0)
  DMA_K(2,2*SLOTB);
  WAIT_BAR(3);
  qkt(pA0,pA1,Kbase,qr,negm,r32,hi);asm volatile("s_nop 15\n\ts_nop 7":"+v"(pA0),"+v"(pA1));CMASK(pA0,pA1,0);
  START(pA0,pA1);
  _Pragma("unroll") for(int r=0;r<16;++r)pA1[r]=__builtin_amdgcn_exp2f(pA1[r]);
  WAIT_BAR(0);
  DMA_K(3,0);DMA_V(1,SLOTB);
  ROT();
  kload8(kf,kp0+sl_cur);
  WAIT_BAR(2);
  s16x4 vlo[8],vhi[8]; u32x4 pw0,pw1,pw2,pw3;
  #define PKW(P,B) cvtpk_s(P[B],P[B+1])
  #define PAF(k) __builtin_bit_cast(bf16x8,pw##k)
  #define VFR(i) (bf16x8){vlo[i][0],vlo[i][1],vlo[i][2],vlo[i][3],vhi[i][0],vhi[i][1],vhi[i][2],vhi[i][3]}
  #define PIN(x) asm volatile("":"+v"(x))
  #define MX3(a,b,c) __builtin_fmaxf(__builtin_fmaxf((a),(b)),(c))
  #define GAPA(MF,A0,A1,A2,A3,W0,W1,PW) do{ MF; sacc+=A0; sacc+=A1; sacc+=A2; sacc+=A3; PIN(sacc); W0; W1; PIN(PW); SBAR(); }while(0)
  #define EX(v) __builtin_amdgcn_exp2f(v)
  #define GAPB(MF,X,B) do{ MF; X[B]=EX(X[B]); X[B+1]=EX(X[B+1]); X[B+2]=EX(X[B+2]); X[B+3]=EX(X[B+3]); PIN(X); SBAR(); }while(0)
  #define VRD(i) do{ vlo[i]=vtr(vp_+(((i)>>2)*4096+((i)&3)*1024)); vhi[i]=vtr(vp_+(((i)>>2)*4096+((i)&3)*1024+512)); }while(0)
  #define KRD(G,j) do{ if(G){ kload2(kf,kp0+sl_next,j); SBAR(); } }while(0)
  #define STEP(C0,C1,P0,P1,t,GK,GV,GL) do{ SBAR(); \
    const lds_cptr vp_=vp0+sl_prev; \
    VRD(0); SBAR(); float sacc=(P0[0]+P0[1]); \
    GAPA(C0=__builtin_amdgcn_mfma_f32_32x32x16_bf16(kf[0],qr[0],negm,0,0,0), P0[2],P0[3],P0[4],P0[5],     pw0[0]=PKW(P0,0), pw0[1]=PKW(P0,2), pw0); \
    VRD(4); SBAR(); GAPA(C1=__builtin_amdgcn_mfma_f32_32x32x16_bf16(kf[1],qr[0],negm,0,0,0), P0[6],P0[7],P0[8],P0[9],     pw0[2]=PKW(P0,4), pw0[3]=PKW(P0,6), pw0); \
    VRD(1); SBAR(); GAPA(C0=__builtin_amdgcn_mfma_f32_32x32x16_bf16(kf[2],qr[1],C0,0,0,0),   P0[10],P0[11],P0[12],P0[13], pw1[0]=PKW(P0,8), pw1[1]=PKW(P0,10), pw1); \
    VRD(5); SBAR(); GAPA(C1=__builtin_amdgcn_mfma_f32_32x32x16_bf16(kf[3],qr[1],C1,0,0,0),   P0[14],P0[15],P1[0],P1[1],   pw1[2]=PKW(P0,12),pw1[3]=PKW(P0,14), pw1); \
    VRD(2); SBAR(); GAPA(C0=__builtin_amdgcn_mfma_f32_32x32x16_bf16(kf[4],qr[2],C0,0,0,0),   P1[2],P1[3],P1[4],P1[5],     pw2[0]=PKW(P1,0), pw2[1]=PKW(P1,2), pw2); \
    VRD(6); SBAR(); GAPA(C1=__builtin_amdgcn_mfma_f32_32x32x16_bf16(kf[5],qr[2],C1,0,0,0),   P1[6],P1[7],P1[8],P1[9],     pw2[2]=PKW(P1,4), pw2[3]=PKW(P1,6), pw2); \
    VRD(3); SBAR(); GAPA(C0=__builtin_amdgcn_mfma_f32_32x32x16_bf16(kf[6],qr[3],C0,0,0,0),   P1[10],P1[11],P1[12],P1[13], pw3[0]=PKW(P1,8), pw3[1]=PKW(P1,10), pw3); \
    VRD(7); SBAR(); GAPA(C1=__builtin_amdgcn_mfma_f32_32x32x16_bf16(kf[7],qr[3],C1,0,0,0),   P1[14],P1[15],0.f,0.f,       pw3[2]=PKW(P1,12),pw3[3]=PKW(P1,14), pw3); \
    l_reg+=sacc; \
    if(GK){DMA_K((t)+3,sl_cur);} if(GV){DMA_V((t)+1,sl_next);} \
    CMASK(C0,C1,t); \
    { float a=MX3(C0[0],C0[1],C1[0]),b=MX3(C0[2],C0[3],C1[1]); a=MX3(a,C1[2],C1[3]); \
      _Pragma("unroll") for(int r=4;r<16;r+=4){a=MX3(a,C0[r],C0[r+1]);b=MX3(b,C0[r+2],C0[r+3]);a=MX3(a,C1[r],C1[r+1]);b=MX3(b,C1[r+2],C1[r+3]);} \
      float rm=__builtin_fmaxf(a,b); { auto rr=__builtin_amdgcn_permlane32_swap(__float_as_uint(rm),__float_as_uint(rm),false,false); rm=__builtin_fmaxf(__uint_as_float(rr[0]),__uint_as_float(rr[1])); } \
      resc=false; \
      if(__builtin_expect(__any(rm>(float)THRL),0)){ const float dl=__builtin_fmaxf(rm,0.f); mhat+=dl; \
        _Pragma("unroll") for(int r=0;r<16;++r){C0[r]-=dl;C1[r]-=dl;} \
        _Pragma("unroll") for(int r=0;r<16;++r)negm[r]=-mhat; asm volatile("":"+v"(negm)); \
        const float f=__builtin_amdgcn_exp2f(-dl); l_reg*=f; if(hi==0)wsf[r32]=f; resc=true; } } \
    SBAR(); \
    GAPB(o[0]=__builtin_amdgcn_mfma_f32_32x32x16_bf16(PAF(0),VFR(0),o[0],0,0,0), C0,0); \
    GAPB(o[1]=__builtin_amdgcn_mfma_f32_32x32x16_bf16(PAF(0),VFR(4),o[1],0,0,0), C0,4); \
    KRD(GL,0); GAPB(o[0]=__builtin_amdgcn_mfma_f32_32x32x16_bf16(PAF(1),VFR(1),o[0],0,0,0), C0,8); \
    KRD(GL,1); GAPB(o[1]=__builtin_amdgcn_mfma_f32_32x32x16_bf16(PAF(1),VFR(5),o[1],0,0,0), C0,12); \
    KRD(GL,2); GAPB(o[0]=__builtin_amdgcn_mfma_f32_32x32x16_bf16(PAF(2),VFR(2),o[0],0,0,0), C1,0); \
    KRD(GL,3); GAPB(o[1]=__builtin_amdgcn_mfma_f32_32x32x16_bf16(PAF(2),VFR(6),o[1],0,0,0), C1,4); \
    GAPB(o[0]=__builtin_amdgcn_mfma_f32_32x32x16_bf16(PAF(3),VFR(3),o[0],0,0,0), C1,8); \
    GAPB(o[1]=__builtin_amdgcn_mfma_f32_32x32x16_bf16(PAF(3),VFR(7),o[1],0,0,0), C1,12); \
    }while(0)
  int t=1;
  #undef CMASK
  #define CMASK(P0,P1,t) do{}while(0)
  for(;t+5<NT;t+=2){
    STEP(pB0,pB1,pA0,pA1,t,true,true,true);     WAIT_BAR(2); RESC(); ROT();
    STEP(pA0,pA1,pB0,pB1,t+1,true,true,true);   WAIT_BAR(2); RESC(); ROT();
  }
  #undef CMASK
  #define CMASK(P0,P1,t) do{int jb_=(t)-(NT-4); if(jb_>=0)cmask(P0,P1,jb_,qrel,hi);}while(0)
  #define ENDW(tt) do{ if((tt)+3<NT){WAIT_BAR(2);} else if((tt)+2<NT){WAIT_BAR(1);} else {WAIT_BAR(0);} }while(0)
  for(;t+1<NT;t+=2){
    STEP(pB0,pB1,pA0,pA1,t,(t+3<NT),(t+1<NT),(t+1<NT));       ENDW(t);   RESC(); ROT();
    STEP(pA0,pA1,pB0,pB1,t+1,(t+4<NT),(t+2<NT),(t+2<NT));     ENDW(t+1); RESC(); ROT();
  }
  STEP(pB0,pB1,pA0,pA1,NT-1,false,false,false); RESC();
  { float sacc=pB0[0]+pB0[1]; _Pragma("unroll") for(int r=2;r<16;++r)sacc+=pB0[r]; _Pragma("unroll") for(int r=0;r<16;++r)sacc+=pB1[r]; l_reg+=sacc;
    pw0=(u32x4){PKW(pB0,0),PKW(pB0,2),PKW(pB0,4),PKW(pB0,6)};pw1=(u32x4){PKW(pB0,8),PKW(pB0,10),PKW(pB0,12),PKW(pB0,14)};pw2=(u32x4){PKW(pB1,0),PKW(pB1,2),PKW(pB1,4),PKW(pB1,6)};pw3=(u32x4){PKW(pB1,8),PKW(pB1,10),PKW(pB1,12),PKW(pB1,14)};
    SBAR(); pv(o,vb0+sl_cur,PAF(0),PAF(1),PAF(2),PAF(3)); }
  #undef PKW
  #undef PAF
  #undef VFR
  #undef PIN
  #undef MX3
  #undef GAPA
  #undef GAPB
  #undef EX
  #undef VRD
  #undef KRD
  #undef STEP
  #undef ENDW
  {auto rr=__builtin_amdgcn_permlane32_swap(__float_as_uint(l_reg),__float_as_uint(l_reg),false,false);l_reg=__uint_as_float(rr[0])+__uint_as_float(rr[1]);}
  if(hi==0)wsf[32+r32]=l_reg;asm volatile("s_waitcnt lgkmcnt(0)":::"memory");
  float rli[16];
  #pragma unroll
  for(int r=0;r<16;++r)rli[r]=__builtin_amdgcn_rcpf(wsf[32+crow(r,hi)]);
  bf16*Ow=O+(rowbase+q0+wid*QBLK)*PO;
  { bf16*stg=(bf16*)(shm+LDS_OST)+wid*2048;
    #pragma unroll
    for(int r=0;r<16;++r){const int orow=crow(r,hi);
      #pragma unroll
      for(int d0=0;d0<2;++d0)stg[orow*64+d0*32+r32]=__float2bfloat16(o[d0][r]*rli[r]);}
    asm volatile("s_waitcnt lgkmcnt(0)":::"memory");
    #pragma unroll
    for(int i=0;i<4;++i){const int row=i*8+(lane>>3),ch=lane&7; const u32x4 v=*(const u32x4*)(stg+row*64+ch*8); ATTN_STORE16(Ow+(long)row*PO+ch*8,v);} }
  asm volatile("s_waitcnt lgkmcnt(0)\n\ts_barrier":::"memory");
  #undef DMA_K
  #undef DMA_V
  #undef CMASK
  #undef START
  #undef RESC
  #undef ROT
}
constexpr int ATTN_LDS_BYTES=LDS_BYTES;
struct AttnTensors { const bf16* Q; const bf16* K; const bf16* V; bf16* O; };
struct AttnUnit { int bh; int qb; };
struct StaticOrder {
  int vcu;
  __device__ __forceinline__ explicit StaticOrder(int grid,int block):vcu((block%8)*(grid/8)+block/8){}
  __device__ __forceinline__ bool next(int i,AttnUnit&u)const{ if(i>=4)return false; const int s=vcu&7; u.bh=vcu>>3; u.qb=(i==0)?s:(i==1)?15-s:(i==2)?16+s:31-s; return true; }
  __device__ __forceinline__ void a_ready(const AttnUnit&)const{}
  __device__ __forceinline__ void done(const AttnUnit&)const{}
};
template<class Sched,int THRL=8> __device__ __forceinline__ void attn_phase(char*lds,const AttnTensors&T,const Sched&S){
  AttnUnit u;
  for(int i=0;S.next(i,u);++i){ S.a_ready(u); const int b=u.bh/NHEAD,g=u.bh%NHEAD,hh=g>>2,mm=(g>>1)&1,vh=g&1;
    attn_unit<THRL>(b,0,u.qb,T.Q+(hh*2+mm)*64,T.K+(hh*2+mm)*64,T.V+(hh*2+vh)*64,T.O+g*64,lds); S.done(u); }
}
#undef SBAR
#undef WAIT_BAR
}


constexpr int NTHREADS = 512, NWAVES = 8;
constexpr int LDS_BYTES = 147456;

__global__ void __launch_bounds__(NTHREADS, 2) mega(Params p) {
    extern __shared__ __attribute__((aligned(16))) unsigned char lds[];
    cg::grid_group grid = cg::this_grid();
    typedef pg8::bf16_t pbf;
#define PHASE_IDS() int tid = threadIdx.x; asm volatile("" : "+v"(tid)); const int lane = tid & 63, wave = __builtin_amdgcn_readfirstlane(tid >> 6); \
    const int G = gridDim.x, bx = blockIdx.x; const size_t gt = (size_t)bx * NTHREADS + tid, gs = (size_t)G * NTHREADS; const int gw = bx * NWAVES + wave, ngw = G * NWAVES; \
    PG8_LAS unsigned char* ldsl = (PG8_LAS unsigned char*)lds; (void)lane; (void)gt; (void)gs; (void)gw; (void)ngw; (void)ldsl;

#if !defined(SKIP_P0)
    { PHASE_IDS()
    stage_transposes(p, (float*)(lds + wave * 8448), gw, ngw, lane);
    convert_bf16(p.x, (bf16_t*)(p.ws + WS_XB), (size_t)M * 1024, gt, gs);
    convert_bf16(p.mem, (bf16_t*)(p.ws + WS_MEMB), (size_t)512 * 1024, gt, gs);
    convert_bf16(p.sub_keys, (bf16_t*)(p.ws + WS_SUBK), (size_t)16 * 128 * 128, gt, gs);
    stage_rope(p, gt, gs);
    }
#endif
    grid.sync();
#if !defined(SKIP_P1)
    { PHASE_IDS()
#if defined(NAIVE_P1)
    { EpiProj e{p.ws};
      naive_gemm((const bf16_t*)(p.ws + WS_XB), 1024, (const bf16_t*)(p.ws + WS_WIN), 1024, M, INW, 1024, e, gw, ngw, lane);
      EpiPlain e2{(bf16_t*)(p.ws + WS_MEMKV), 1024};
      naive_gemm((const bf16_t*)(p.ws + WS_MEMB), 1024, (const bf16_t*)(p.ws + WS_WMEMKV), 1024, 512, 1024, 1024, e2, gw, ngw, lane); }
#else
    { pg8::Gemm g{(const pbf*)(p.ws + WS_XB), (const pbf*)(p.ws + WS_WIN), M, INW, 1024}; pg8::StaticOrder S; S.init(M, INW, G, bx);
      pg8::EpiProjF E{p.ws};
      pg8::gemm_phase<pg8::EpiProjF, pg8::StaticOrder, PG8_ALIGN, PG8_SP2>(ldsl, g, S, E);
      pg8::Gemm g2{(const pbf*)(p.ws + WS_MEMB), (const pbf*)(p.ws + WS_WMEMKV), 512, 1024, 1024}; pg8::MemOrder S2{bx};
      pg8::EpiBf16<0> E2{(pbf*)(p.ws + WS_MEMKV), 1024, nullptr, 0, 0, 1.f};
      pg8::gemm_phase<pg8::EpiBf16<0>, pg8::MemOrder, PG8_ALIGN, PG8_SP2>(ldsl, g2, S2, E2); }
#endif
    }
#endif
    grid.sync();
#if !defined(SKIP_P2)
    { PHASE_IDS()
    { const attn_body::AttnTensors AT{(const attn_body::bf16*)(p.ws + WS_DFQ), (const attn_body::bf16*)(p.ws + WS_DFK), (const attn_body::bf16*)(p.ws + WS_DFV), (attn_body::bf16*)(p.ws + WS_ODF16)};
      const attn_body::StaticOrder S(G, bx);
#if defined(NAIVE_DF)
      (void)AT; (void)S; naive_df_attn(p, gt, gs);
#else
      attn_body::attn_phase<attn_body::StaticOrder>((char*)lds, AT, S);
#endif
    }
    }
#endif
    grid.sync();
#if !defined(SKIP_P3)
    { PHASE_IDS()
    stage_df_combine(p, gw, ngw, lane);
    naive_sb_attn(p, gt, gs);
    naive_mx_attn(p, gt, gs);
    }
#endif
    grid.sync();
#if !defined(SKIP_P4)
    { PHASE_IDS()
#if defined(NAIVE_P4)
    { EpiGate e{(bf16_t*)(p.ws + WS_GATES), p.b_gate};
      naive_gemm((const bf16_t*)(p.ws + WS_XB), 1024, (const bf16_t*)(p.ws + WS_WGATE), 1024, M, 3072, 1024, e, gw, ngw, lane); }
    grid.sync();
    for (int b = 0; b < 3; ++b) {
        const size_t osrc = (b == 0) ? WS_OSB : (b == 1 ? WS_ODF : WS_OMX);
        EpiBranch e{(const bf16_t*)(p.ws + WS_GATES), b * 1024, p.out, (bf16_t*)(p.ws + WS_MERGEDB), b};
        naive_gemm((const bf16_t*)(p.ws + osrc), 512, (const bf16_t*)(p.ws + WS_WBR + (size_t)b * MiB), 512, M, 1024, 512, e, gw, ngw, lane);
    }
#else
    { pg8::StaticOrder S1; S1.init(M, 1024, G, bx); pg8::Unit base; const bool has = S1.next(0, base);
      if (has) {
#if defined(NAIVE_GATES)
        { EpiGate e{(bf16_t*)(p.ws + WS_GATES), p.b_gate};
          naive_gemm((const bf16_t*)(p.ws + WS_XB), 1024, (const bf16_t*)(p.ws + WS_WGATE), 1024, M, 3072, 1024, e, gw, ngw, lane); }
        grid.sync();
#else
        pg8::Gemm gg{(const pbf*)(p.ws + WS_XB), (const pbf*)(p.ws + WS_WGATE), M, 3072, 1024}; pg8::GateOrder SG{base};
        pg8::EpiGateF EG{(pbf*)(p.ws + WS_GATES), p.b_gate};
        pg8::gemm_phase<pg8::EpiGateF, pg8::GateOrder, PG8_ALIGN, PG8_SP2>(ldsl, gg, SG, EG);
#endif
#define P4_SEAM() do { asm volatile("s_waitcnt vmcnt(0)" ::: "memory"); __syncthreads(); if (tid < 64) { __builtin_amdgcn_fence(__ATOMIC_ACQUIRE, "agent"); asm volatile("s_waitcnt vmcnt(0)" ::: "memory"); } __syncthreads(); } while (0)
        P4_SEAM();
#if defined(NAIVE_BR)
    for (int b = 0; b < 3; ++b) {
        const size_t osrc = (b == 0) ? WS_OSB : (b == 1 ? WS_ODF : WS_OMX);
        EpiBranch e{(const bf16_t*)(p.ws + WS_GATES), b * 1024, p.out, (bf16_t*)(p.ws + WS_MERGEDB), b};
        naive_gemm((const bf16_t*)(p.ws + osrc), 512, (const bf16_t*)(p.ws + WS_WBR + (size_t)b * MiB), 512, M, 1024, 512, e, gw, ngw, lane);
    }
#else
        const pbf* GT_ = (const pbf*)(p.ws + WS_GATES); pbf* MB = (pbf*)(p.ws + WS_MERGEDB);
        { pg8::Gemm g{(const pbf*)(p.ws + WS_OSB), (const pbf*)(p.ws + WS_WBR), M, 1024, 512}; pg8::EpiBranchF<0> E{GT_, 0, p.out, MB};
          pg8::gemm_phase<pg8::EpiBranchF<0>, pg8::StaticOrder, PG8_ALIGN, PG8_SP2>(ldsl, g, S1, E); }
        P4_SEAM();
        { pg8::Gemm g{(const pbf*)(p.ws + WS_ODF), (const pbf*)(p.ws + WS_WBR + 1 * MiB), M, 1024, 512}; pg8::EpiBranchF<1> E{GT_, 1024, p.out, MB};
          pg8::gemm_phase<pg8::EpiBranchF<1>, pg8::StaticOrder, PG8_ALIGN, PG8_SP2>(ldsl, g, S1, E); }
        P4_SEAM();
        { pg8::Gemm g{(const pbf*)(p.ws + WS_OMX), (const pbf*)(p.ws + WS_WBR + 2 * MiB), M, 1024, 512}; pg8::EpiBranchF<2> E{GT_, 2048, p.out, MB};
          pg8::gemm_phase<pg8::EpiBranchF<2>, pg8::StaticOrder, PG8_ALIGN, PG8_SP2>(ldsl, g, S1, E); }
#endif
      } }
#endif
    }
#endif
    grid.sync();
#if !defined(SKIP_P5)
    { PHASE_IDS()
#if defined(NAIVE_P5)
    { EpiOut e{p.x, p.out};
      naive_gemm((const bf16_t*)(p.ws + WS_MERGEDB), 1024, (const bf16_t*)(p.ws + WS_WOUT), 1024, M, 1024, 1024, e, gw, ngw, lane); }
#else
    { pg8::Gemm g{(const pbf*)(p.ws + WS_MERGEDB), (const pbf*)(p.ws + WS_WOUT), M, 1024, 1024}; pg8::StaticOrder S; S.init(M, 1024, G, bx);
      pg8::EpiOutF E{p.x, p.out};
      pg8::gemm_phase<pg8::EpiOutF, pg8::StaticOrder, PG8_ALIGN, PG8_SP2>(ldsl, g, S, E); }
#endif
    }
#endif
    grid.sync();
#if !defined(SKIP_P6)
    { PHASE_IDS()
    stage_ln1(p, gw, ngw, lane);
    convert_bf16(p.u_tab, (bf16_t*)(p.ws + WS_UTB), (size_t)NEXP * 1024, gt, gs);
    convert_bf16(p.v_tab, (bf16_t*)(p.ws + WS_VTB), (size_t)NEXP * 1024, gt, gs);
    }
#endif
    grid.sync();
#if !defined(SKIP_P7)
    { PHASE_IDS()
#if defined(NAIVE_P7)
    { EpiPlain e{(bf16_t*)(p.ws + WS_QP), 2048};
      naive_gemm((const bf16_t*)(p.ws + WS_X1B), 1024, (const bf16_t*)(p.ws + WS_WQUERY), 1024, M, 2048, 1024, e, gw, ngw, lane); }
#else
    { pg8::Gemm g{(const pbf*)(p.ws + WS_X1B), (const pbf*)(p.ws + WS_WQUERY), M, 2048, 1024}; pg8::StaticOrder S; S.init(M, 2048, G, bx);
      pg8::EpiBf16<0> E{(pbf*)(p.ws + WS_QP), 2048, nullptr, 0, 0, 1.f};
      pg8::gemm_phase<pg8::EpiBf16<0>, pg8::StaticOrder, PG8_ALIGN, PG8_SP2>(ldsl, g, S, E); }
#endif
    }
#endif
    grid.sync();
#if !defined(SKIP_P8)
    { PHASE_IDS()
    naive_routing(p, gt, gs);
    }
#endif
    grid.sync();
#if !defined(SKIP_P9)
    { PHASE_IDS()
    naive_peer(p, gw, ngw, lane);
    }
#endif
}

extern "C" void kernel_launch(void* const* d_in, const int* in_sizes, int n_in, void* d_out, int out_size, void* d_ws, size_t ws_size, hipStream_t stream) {
    static int grid_blocks = 0;
    if (!grid_blocks) {
        int dev = 0, cus = 0, per_cu = 0;
        hipGetDevice(&dev);
        hipDeviceGetAttribute(&cus, hipDeviceAttributeMultiprocessorCount, dev);
        hipFuncSetAttribute((const void*)mega, hipFuncAttributeMaxDynamicSharedMemorySize, LDS_BYTES);
        hipOccupancyMaxActiveBlocksPerMultiprocessor(&per_cu, (const void*)mega, NTHREADS, LDS_BYTES);
        if (per_cu < 1) per_cu = 1;
        grid_blocks = cus * per_cu;
    }
    Params p{};
    p.x = (const float*)d_in[0]; p.mem = (const float*)d_in[1]; p.pos = (const int*)d_in[2];
    p.w_in = (const float*)d_in[3]; p.w_memkv = (const float*)d_in[4]; p.df_lambda = (const float*)d_in[5]; p.df_norm_g = (const float*)d_in[6];
    p.w_gate = (const float*)d_in[7]; p.b_gate = (const float*)d_in[8]; p.w_br_sb = (const float*)d_in[9]; p.w_br_df = (const float*)d_in[10]; p.w_br_mx = (const float*)d_in[11];
    p.w_out = (const float*)d_in[12]; p.ln1_g = (const float*)d_in[13]; p.ln1_b = (const float*)d_in[14]; p.w_query = (const float*)d_in[15]; p.sub_keys = (const float*)d_in[16];
    p.u_tab = (const float*)d_in[17]; p.v_tab = (const float*)d_in[18]; p.ln2_g = (const float*)d_in[19]; p.ln2_b = (const float*)d_in[20];
    p.out = (float*)d_out; p.ws = (unsigned char*)d_ws;
    void* args[] = {&p};
    hipError_t e = hipLaunchCooperativeKernel((const void*)mega, dim3(grid_blocks), dim3(NTHREADS), args, LDS_BYTES, stream);
    if (e != hipSuccess) fprintf(stderr, "cooperative launch failed: %s (grid %d)\n", hipGetErrorString(e), grid_blocks);
}
```

```cpp
#include <hip/hip_runtime.h>
#include <cstdint>
#include <cstdio>
#include <hip/hip_cooperative_groups.h>
namespace cg = cooperative_groups;

typedef unsigned short bf16_t;
typedef short bf16x8 __attribute__((ext_vector_type(8)));
typedef float f32x16 __attribute__((ext_vector_type(16)));
typedef float f32x4 __attribute__((ext_vector_type(4)));
typedef unsigned u32x4 __attribute__((ext_vector_type(4)));
typedef unsigned u32x2 __attribute__((ext_vector_type(2)));

constexpr int BATCH = 2, SEQ = 8192, DM = 1024, M = BATCH * SEQ;
constexpr int MEMLEN = 256;
constexpr int INW = 3584;
constexpr int NEXP = 16384;
constexpr float LOG2E = 1.4426950408889634f;
constexpr float C2_64 = 0.125f * LOG2E;
constexpr float C2_128 = 0.08838834764831845f * LOG2E;
constexpr float ALPHA = 1.189207115002721f;
constexpr float LN_EPS = 1e-5f, RMS_EPS = 1e-5f;
constexpr float LAMBDA_INIT = 0.2f;

constexpr size_t MiB = 1u << 20;
constexpr size_t WS_CTL = 0;
constexpr size_t WS_ROPE = 1 * MiB;
constexpr size_t WS_WIN = 2 * MiB;
constexpr size_t WS_WGATE = 9 * MiB;
constexpr size_t WS_WMEMKV = 15 * MiB;
constexpr size_t WS_WBR = 17 * MiB;
constexpr size_t WS_WOUT = 20 * MiB;
constexpr size_t WS_WQUERY = 22 * MiB;
constexpr size_t WS_SUBK = 26 * MiB;
constexpr size_t WS_MEMB = 27 * MiB;
constexpr size_t WS_MEMKV = 28 * MiB;
constexpr size_t WS_XB = 32 * MiB;
constexpr size_t WS_SBQ = 64 * MiB, WS_SBK = 80 * MiB, WS_SBV = 96 * MiB;
constexpr size_t WS_DFQ = 112 * MiB, WS_DFK = 128 * MiB, WS_DFV = 144 * MiB, WS_MXQ = 160 * MiB;
constexpr size_t WS_ODF16 = 176 * MiB;
constexpr size_t WS_OSB = 208 * MiB, WS_ODF = 224 * MiB, WS_OMX = 240 * MiB;
constexpr size_t WS_GATES = 64 * MiB;
constexpr size_t WS_MERGEDB = 160 * MiB;
constexpr size_t WS_X1B = 32 * MiB;
constexpr size_t WS_QP = 64 * MiB;
constexpr size_t WS_IDS = 128 * MiB;
constexpr size_t WS_G = 136 * MiB;
constexpr size_t WS_UTB = 160 * MiB;
constexpr size_t WS_VTB = 192 * MiB;

struct Params {
    const float *x, *mem; const int* pos;
    const float *w_in, *w_memkv, *df_lambda, *df_norm_g, *w_gate, *b_gate, *w_br_sb, *w_br_df, *w_br_mx, *w_out;
    const float *ln1_g, *ln1_b, *w_query, *sub_keys, *u_tab, *v_tab, *ln2_g, *ln2_b;
    float* out; unsigned char* ws;
};

__device__ __forceinline__ float bf2f(unsigned v) { return __uint_as_float(v << 16); }
__device__ __forceinline__ unsigned f2bf(float f) { unsigned u = __float_as_uint(f); return (u + 0x7fffu + ((u >> 16) & 1u)) >> 16; }
__device__ __forceinline__ unsigned pk2(float lo, float hi) { return f2bf(lo) | (f2bf(hi) << 16); }
__device__ __forceinline__ float wave_sum(float v) {
#pragma unroll
    for (int o = 1; o < 64; o <<= 1) v += __shfl_xor(v, o);
    return v;
}
__device__ __forceinline__ float gelu_exact(float v) { return 0.5f * v * (1.0f + erff(v * 0.70710678118654752f)); }

__device__ __forceinline__ void transpose_item(const float* W, int K, int N, bf16_t* WT, float* scr, int item, int lane) {
    const int nblk = N / 32, kb = item / nblk, nb = item % nblk, k0 = 64 * kb, n0 = 32 * nb;
#pragma unroll 8
    for (int i = 0; i < 32; ++i) { const int kk = 2 * i + (lane >> 5); scr[kk * 33 + (lane & 31)] = W[(size_t)(k0 + kk) * N + n0 + (lane & 31)]; }
    asm volatile("s_waitcnt lgkmcnt(0)" ::: "memory");
    const int c = lane & 7;
#pragma unroll
    for (int j = 0; j < 4; ++j) { const int n = (lane >> 3) + 8 * j; const float* s = scr + (8 * c) * 33 + n;
        u32x4 o; o.x = pk2(s[0 * 33], s[1 * 33]); o.y = pk2(s[2 * 33], s[3 * 33]); o.z = pk2(s[4 * 33], s[5 * 33]); o.w = pk2(s[6 * 33], s[7 * 33]);
        *(u32x4*)(WT + (size_t)(n0 + n) * K + k0 + 8 * c) = o; }
    asm volatile("s_waitcnt lgkmcnt(0)" ::: "memory");
}
__device__ __forceinline__ void stage_transposes(const Params& p, float* scr, int gw, int ngw, int lane) {
    struct TJ { const float* W; int K, N; size_t off; };
    const TJ jobs[8] = {
        {p.w_in, 1024, 3584, WS_WIN}, {p.w_gate, 1024, 3072, WS_WGATE}, {p.w_memkv, 1024, 1024, WS_WMEMKV},
        {p.w_br_sb, 512, 1024, WS_WBR}, {p.w_br_df, 512, 1024, WS_WBR + 1 * MiB}, {p.w_br_mx, 512, 1024, WS_WBR + 2 * MiB},
        {p.w_out, 1024, 1024, WS_WOUT}, {p.w_query, 1024, 2048, WS_WQUERY}};
    int base = 0;
#pragma unroll
    for (int j = 0; j < 8; ++j) {
        const int items = (jobs[j].K / 64) * (jobs[j].N / 32);
        int first = ((gw - base) % ngw + ngw) % ngw;
        for (int it = first; it < items; it += ngw) transpose_item(jobs[j].W, jobs[j].K, jobs[j].N, (bf16_t*)(p.ws + jobs[j].off), scr, it, lane);
        base += items;
    }
}
__device__ __forceinline__ void convert_bf16(const float* src, bf16_t* dst, size_t n, size_t gtid, size_t gsize) {
    const size_t n4 = n / 4;
    for (size_t i = gtid; i < n4; i += gsize) { const f32x4 v = ((const f32x4*)src)[i]; u32x2 o; o.x = pk2(v.x, v.y); o.y = pk2(v.z, v.w); ((u32x2*)dst)[i] = o; }
}
__device__ __forceinline__ void stage_rope(const Params& p, size_t gtid, size_t gsize) {
    const double inv[8] = {1.0, 0.19392274474868576, 0.03760603093086393, 0.007292664737217109, 0.001414213562373095, 0.0002742481756762073, 5.318295896944988e-05, 1.031338537721246e-05};
    float2* tab = (float2*)(p.ws + WS_ROPE);
    for (size_t i = gtid; i < (size_t)M * 8; i += gsize) {
        const int row = (int)(i >> 3), j = (int)(i & 7);
        double iv = inv[0];
#pragma unroll
        for (int q = 1; q < 8; ++q) iv = (j == q) ? inv[q] : iv;
        const double a = (double)p.pos[row] * iv;
        double rev = a * 0.15915494309189535;
        rev -= floor(rev);
        const float rf = (float)rev;
        tab[i] = make_float2(__builtin_amdgcn_cosf(rf), __builtin_amdgcn_sinf(rf));
    }
}

template <class Epi>
__device__ __forceinline__ void naive_gemm(const bf16_t* A, int lda, const bf16_t* Bt, int ldb, int Mr, int N, int K, const Epi& epi, int gw, int ngw, int lane) {
    const int r = lane & 31, h = lane >> 5;
    const int tnc = N / 32, ntiles = (Mr / 32) * tnc;
    for (int t = gw; t < ntiles; t += ngw) {
        const int tm = t / tnc, tn = t % tnc;
        const bf16_t* ap = A + (size_t)(tm * 32 + r) * lda + 8 * h;
        const bf16_t* bp = Bt + (size_t)(tn * 32 + r) * ldb + 8 * h;
        f32x16 acc;
#pragma unroll
        for (int i = 0; i < 16; ++i) acc[i] = 0.f;
        for (int k = 0; k < K; k += 16) {
            const bf16x8 a = *(const bf16x8*)(ap + k); const bf16x8 b = *(const bf16x8*)(bp + k);
            acc = __builtin_amdgcn_mfma_f32_32x32x16_bf16(a, b, acc, 0, 0, 0);
        }
        epi(acc, tm * 32, tn * 32, r, h);
    }
}
#define ACC_ROW(row0, i, h) ((row0) + ((i) & 3) + 8 * ((i) >> 2) + 4 * (h))

struct EpiProj {
    unsigned char* ws;
    __device__ __forceinline__ void operator()(const f32x16& acc, int row0, int col0, int r, int h) const {
        const int region = col0 >> 9;
        const int cc = (col0 & 511) + r;
        const size_t offs[7] = {WS_SBQ, WS_SBK, WS_SBV, WS_DFQ, WS_DFK, WS_DFV, WS_MXQ};
        size_t off = offs[0];
#pragma unroll
        for (int q = 1; q < 7; ++q) off = (region == q) ? offs[q] : off;
        bf16_t* dst = (bf16_t*)(ws + off);
        const float2* rope = (const float2*)(ws + WS_ROPE);
        const float scale = (region == 0 || region == 3) ? C2_64 : (region == 6 ? C2_128 : 1.0f);
        const bool rot = (region == 3 || region == 4);
        const int d = cc & 63;
#pragma unroll
        for (int i = 0; i < 16; ++i) {
            const int row = ACC_ROW(row0, i, h);
            float v = acc[i];
            const float partner = __shfl_xor(v, 8);
            if (rot && d < 16) {
                const float2 cs = rope[(size_t)row * 8 + (d & 7)];
                v = (d < 8) ? (v * cs.x - partner * cs.y) : (v * cs.x + partner * cs.y);
            }
            dst[(size_t)row * 512 + cc] = (bf16_t)f2bf(v * scale);
        }
    }
};
struct EpiPlain {
    bf16_t* dst; int ldc;
    __device__ __forceinline__ void operator()(const f32x16& acc, int row0, int col0, int r, int h) const {
#pragma unroll
        for (int i = 0; i < 16; ++i) dst[(size_t)ACC_ROW(row0, i, h) * ldc + col0 + r] = (bf16_t)f2bf(acc[i]);
    }
};
struct EpiGate {
    bf16_t* dst; const float* bias;
    __device__ __forceinline__ void operator()(const f32x16& acc, int row0, int col0, int r, int h) const {
        const float b = bias[col0 + r];
#pragma unroll
        for (int i = 0; i < 16; ++i) { const float z = acc[i] + b; dst[(size_t)ACC_ROW(row0, i, h) * 3072 + col0 + r] = (bf16_t)f2bf(1.0f / (1.0f + __expf(-z))); }
    }
};
struct EpiBranch {
    const bf16_t* gates; int gcol; float* m32; bf16_t* mb; int mode;
    __device__ __forceinline__ void operator()(const f32x16& acc, int row0, int col0, int r, int h) const {
#pragma unroll
        for (int i = 0; i < 16; ++i) { const size_t row = ACC_ROW(row0, i, h); const int c = col0 + r;
            const float g = bf2f(gates[row * 3072 + gcol + c]); float v = g * acc[i];
            if (mode > 0) v += m32[row * 1024 + c];
            if (mode < 2) m32[row * 1024 + c] = v; else mb[row * 1024 + c] = (bf16_t)f2bf(v); }
    }
};
struct EpiOut {
    const float* x; float* y;
    __device__ __forceinline__ void operator()(const f32x16& acc, int row0, int col0, int r, int h) const {
#pragma unroll
        for (int i = 0; i < 16; ++i) { const size_t o = (size_t)ACC_ROW(row0, i, h) * 1024 + col0 + r; y[o] = ALPHA * x[o] + acc[i]; }
    }
};

__device__ __forceinline__ void naive_df_attn(const Params& p, size_t gtid, size_t gsize) {
    const bf16_t* Q = (const bf16_t*)(p.ws + WS_DFQ); const bf16_t* Kb = (const bf16_t*)(p.ws + WS_DFK); const bf16_t* Vb = (const bf16_t*)(p.ws + WS_DFV);
    bf16_t* O = (bf16_t*)(p.ws + WS_ODF16);
    for (size_t idx = gtid; idx < (size_t)16 * M; idx += gsize) {
        const int t = (int)(idx % SEQ); const int bg = (int)(idx / SEQ); const int g = bg % 16, b = bg / 16;
        const int hh = g >> 2, mm = (g >> 1) & 1, vh = g & 1;
        const int qcol = (hh * 2 + mm) * 64, vcol = (hh * 2 + vh) * 64;
        const size_t row = (size_t)b * SEQ + t;
        float q[64], o[64];
#pragma unroll
        for (int d = 0; d < 64; ++d) { q[d] = bf2f(Q[row * 512 + qcol + d]); o[d] = 0.f; }
        float mx = -1e30f, l = 0.f;
        const int tmax = __shfl(t, 63);
        for (int s = 0; s <= tmax; ++s) {
            const bf16_t* kr = Kb + ((size_t)b * SEQ + s) * 512 + qcol;
            float y = 0.f;
#pragma unroll
            for (int d8 = 0; d8 < 8; ++d8) { const u32x4 kk = *(const u32x4*)(kr + d8 * 8);
                y += q[d8 * 8 + 0] * bf2f(kk.x & 0xffffu) + q[d8 * 8 + 1] * bf2f(kk.x >> 16) + q[d8 * 8 + 2] * bf2f(kk.y & 0xffffu) + q[d8 * 8 + 3] * bf2f(kk.y >> 16)
                   + q[d8 * 8 + 4] * bf2f(kk.z & 0xffffu) + q[d8 * 8 + 5] * bf2f(kk.z >> 16) + q[d8 * 8 + 6] * bf2f(kk.w & 0xffffu) + q[d8 * 8 + 7] * bf2f(kk.w >> 16); }
            if (s > t) y = -INFINITY;
            const float mn = fmaxf(mx, y), al = exp2f(mx - mn), pp = exp2f(y - mn);
            mx = mn; l = l * al + pp;
            const bf16_t* vr = Vb + ((size_t)b * SEQ + s) * 512 + vcol;
#pragma unroll
            for (int d8 = 0; d8 < 8; ++d8) { const u32x4 vv = *(const u32x4*)(vr + d8 * 8);
                o[d8 * 8 + 0] = o[d8 * 8 + 0] * al + pp * bf2f(vv.x & 0xffffu); o[d8 * 8 + 1] = o[d8 * 8 + 1] * al + pp * bf2f(vv.x >> 16);
                o[d8 * 8 + 2] = o[d8 * 8 + 2] * al + pp * bf2f(vv.y & 0xffffu); o[d8 * 8 + 3] = o[d8 * 8 + 3] * al + pp * bf2f(vv.y >> 16);
                o[d8 * 8 + 4] = o[d8 * 8 + 4] * al + pp * bf2f(vv.z & 0xffffu); o[d8 * 8 + 5] = o[d8 * 8 + 5] * al + pp * bf2f(vv.z >> 16);
                o[d8 * 8 + 6] = o[d8 * 8 + 6] * al + pp * bf2f(vv.w & 0xffffu); o[d8 * 8 + 7] = o[d8 * 8 + 7] * al + pp * bf2f(vv.w >> 16); }
        }
        const float rl = 1.0f / l;
#pragma unroll
        for (int d = 0; d < 64; d += 2) *(unsigned*)(O + row * 1024 + g * 64 + d) = pk2(o[d] * rl, o[d + 1] * rl);
    }
}
constexpr float SB_EXIT_BITS = 48.0f;
__device__ __forceinline__ void naive_sb_attn(const Params& p, size_t gtid, size_t gsize) {
    const bf16_t* Q = (const bf16_t*)(p.ws + WS_SBQ); const bf16_t* Kb = (const bf16_t*)(p.ws + WS_SBK); const bf16_t* Vb = (const bf16_t*)(p.ws + WS_SBV);
    bf16_t* O = (bf16_t*)(p.ws + WS_OSB);
    for (size_t idx = gtid; idx < (size_t)8 * M; idx += gsize) {
        const int t = (int)(idx % SEQ); const int bh = (int)(idx / SEQ); const int hh = bh % 8, b = bh / 8;
        const int col = hh * 64;
        const size_t row = (size_t)b * SEQ + t;
        float q[64], o[64];
#pragma unroll
        for (int d = 0; d < 64; ++d) { q[d] = bf2f(Q[row * 512 + col + d]); o[d] = 0.f; }
        float R = 0.f;
        const int tmax = __shfl(t, 63);
        for (int s = tmax - 1; s >= 0; --s) {
            const bf16_t* kr = Kb + ((size_t)b * SEQ + s) * 512 + col;
            float y = 0.f;
#pragma unroll
            for (int d8 = 0; d8 < 8; ++d8) { const u32x4 kk = *(const u32x4*)(kr + d8 * 8);
                y += q[d8 * 8 + 0] * bf2f(kk.x & 0xffffu) + q[d8 * 8 + 1] * bf2f(kk.x >> 16) + q[d8 * 8 + 2] * bf2f(kk.y & 0xffffu) + q[d8 * 8 + 3] * bf2f(kk.y >> 16)
                   + q[d8 * 8 + 4] * bf2f(kk.z & 0xffffu) + q[d8 * 8 + 5] * bf2f(kk.z >> 16) + q[d8 * 8 + 6] * bf2f(kk.w & 0xffffu) + q[d8 * 8 + 7] * bf2f(kk.w >> 16); }
            const bool act = s < t;
            const float sp = fmaxf(y, 0.f) + log2f(1.0f + exp2f(-fabsf(y)));
            float a = 0.f;
            if (act) { R += sp; a = exp2f(y - R); }
            const bf16_t* vr = Vb + ((size_t)b * SEQ + s) * 512 + col;
#pragma unroll
            for (int d8 = 0; d8 < 8; ++d8) { const u32x4 vv = *(const u32x4*)(vr + d8 * 8);
                o[d8 * 8 + 0] += a * bf2f(vv.x & 0xffffu); o[d8 * 8 + 1] += a * bf2f(vv.x >> 16);
                o[d8 * 8 + 2] += a * bf2f(vv.y & 0xffffu); o[d8 * 8 + 3] += a * bf2f(vv.y >> 16);
                o[d8 * 8 + 4] += a * bf2f(vv.z & 0xffffu); o[d8 * 8 + 5] += a * bf2f(vv.z >> 16);
                o[d8 * 8 + 6] += a * bf2f(vv.w & 0xffffu); o[d8 * 8 + 7] += a * bf2f(vv.w >> 16); }
            if (__all(R > SB_EXIT_BITS)) break;
        }
#pragma unroll
        for (int d = 0; d < 64; d += 2) *(unsigned*)(O + row * 512 + col + d) = pk2(o[d], o[d + 1]);
    }
}
__device__ __forceinline__ void naive_mx_attn(const Params& p, size_t gtid, size_t gsize) {
    const bf16_t* Q = (const bf16_t*)(p.ws + WS_MXQ); const bf16_t* KV = (const bf16_t*)(p.ws + WS_MEMKV);
    bf16_t* O = (bf16_t*)(p.ws + WS_OMX);
    for (size_t idx = gtid; idx < (size_t)8 * M; idx += gsize) {
        const int t = (int)(idx % SEQ); const int bq = (int)(idx / SEQ); const int vh = bq & 1, hh = (bq >> 1) & 3, b = bq >> 3;
        const size_t row = (size_t)b * SEQ + t;
        unsigned qp[64]; float o[64];
#pragma unroll
        for (int d = 0; d < 64; ++d) { qp[d] = *(const unsigned*)(Q + row * 512 + hh * 128 + 2 * d); o[d] = 0.f; }
        float mx = -1e30f, l = 0.f;
        for (int m = 0; m < MEMLEN; ++m) {
            const bf16_t* kr = KV + ((size_t)b * MEMLEN + m) * 1024 + hh * 128;
            float y = 0.f;
#pragma unroll
            for (int d8 = 0; d8 < 16; ++d8) { const u32x4 kk = *(const u32x4*)(kr + d8 * 8);
                y += bf2f(qp[d8 * 4 + 0] & 0xffffu) * bf2f(kk.x & 0xffffu) + bf2f(qp[d8 * 4 + 0] >> 16) * bf2f(kk.x >> 16)
                   + bf2f(qp[d8 * 4 + 1] & 0xffffu) * bf2f(kk.y & 0xffffu) + bf2f(qp[d8 * 4 + 1] >> 16) * bf2f(kk.y >> 16)
                   + bf2f(qp[d8 * 4 + 2] & 0xffffu) * bf2f(kk.z & 0xffffu) + bf2f(qp[d8 * 4 + 2] >> 16) * bf2f(kk.z >> 16)
                   + bf2f(qp[d8 * 4 + 3] & 0xffffu) * bf2f(kk.w & 0xffffu) + bf2f(qp[d8 * 4 + 3] >> 16) * bf2f(kk.w >> 16); }
            const float mn = fmaxf(mx, y), al = exp2f(mx - mn), pp = exp2f(y - mn);
            mx = mn; l = l * al + pp;
            const bf16_t* vr = KV + ((size_t)b * MEMLEN + m) * 1024 + 512 + hh * 128 + vh * 64;
#pragma unroll
            for (int d8 = 0; d8 < 8; ++d8) { const u32x4 vv = *(const u32x4*)(vr + d8 * 8);
                o[d8 * 8 + 0] = o[d8 * 8 + 0] * al + pp * bf2f(vv.x & 0xffffu); o[d8 * 8 + 1] = o[d8 * 8 + 1] * al + pp * bf2f(vv.x >> 16);
                o[d8 * 8 + 2] = o[d8 * 8 + 2] * al + pp * bf2f(vv.y & 0xffffu); o[d8 * 8 + 3] = o[d8 * 8 + 3] * al + pp * bf2f(vv.y >> 16);
                o[d8 * 8 + 4] = o[d8 * 8 + 4] * al + pp * bf2f(vv.z & 0xffffu); o[d8 * 8 + 5] = o[d8 * 8 + 5] * al + pp * bf2f(vv.z >> 16);
                o[d8 * 8 + 6] = o[d8 * 8 + 6] * al + pp * bf2f(vv.w & 0xffffu); o[d8 * 8 + 7] = o[d8 * 8 + 7] * al + pp * bf2f(vv.w >> 16); }
        }
        const float rl = 1.0f / l;
#pragma unroll
        for (int d = 0; d < 64; d += 2) *(unsigned*)(O + row * 512 + hh * 128 + vh * 64 + d) = pk2(o[d] * rl, o[d + 1] * rl);
    }
}
__device__ __forceinline__ void stage_df_combine(const Params& p, int gw, int ngw, int lane) {
    const bf16_t* O16 = (const bf16_t*)(p.ws + WS_ODF16); bf16_t* O = (bf16_t*)(p.ws + WS_ODF);
    const float s01 = wave_sum(p.df_lambda[lane] * p.df_lambda[64 + lane]), s23 = wave_sum(p.df_lambda[128 + lane] * p.df_lambda[192 + lane]);
    const float lam = __expf(s01) - __expf(s23) + LAMBDA_INIT;
    const int hh = lane >> 4, dv = (lane & 15) * 8, vh = dv >> 6, d = dv & 63;
    float gn[8];
#pragma unroll
    for (int j = 0; j < 8; ++j) gn[j] = p.df_norm_g[dv + j] * (1.0f - LAMBDA_INIT);
    for (int row = gw; row < M; row += ngw) {
        const u32x4 a = *(const u32x4*)(O16 + (size_t)row * 1024 + (hh * 4 + vh) * 64 + d);
        const u32x4 b = *(const u32x4*)(O16 + (size_t)row * 1024 + (hh * 4 + 2 + vh) * 64 + d);
        float v[8];
        v[0] = bf2f(a.x & 0xffffu) - lam * bf2f(b.x & 0xffffu); v[1] = bf2f(a.x >> 16) - lam * bf2f(b.x >> 16);
        v[2] = bf2f(a.y & 0xffffu) - lam * bf2f(b.y & 0xffffu); v[3] = bf2f(a.y >> 16) - lam * bf2f(b.y >> 16);
        v[4] = bf2f(a.z & 0xffffu) - lam * bf2f(b.z & 0xffffu); v[5] = bf2f(a.z >> 16) - lam * bf2f(b.z >> 16);
        v[6] = bf2f(a.w & 0xffffu) - lam * bf2f(b.w & 0xffffu); v[7] = bf2f(a.w >> 16) - lam * bf2f(b.w >> 16);
        float ss = 0.f;
#pragma unroll
        for (int j = 0; j < 8; ++j) ss += v[j] * v[j];
        ss += __shfl_xor(ss, 1); ss += __shfl_xor(ss, 2); ss += __shfl_xor(ss, 4); ss += __shfl_xor(ss, 8);
        const float rs = 1.0f / sqrtf(ss * (1.0f / 128.0f) + RMS_EPS);
        u32x4 o; o.x = pk2(v[0] * rs * gn[0], v[1] * rs * gn[1]); o.y = pk2(v[2] * rs * gn[2], v[3] * rs * gn[3]);
        o.z = pk2(v[4] * rs * gn[4], v[5] * rs * gn[5]); o.w = pk2(v[6] * rs * gn[6], v[7] * rs * gn[7]);
        *(u32x4*)(O + (size_t)row * 512 + hh * 128 + dv) = o;
    }
}
__device__ __forceinline__ void stage_ln1(const Params& p, int gw, int ngw, int lane) {
    bf16_t* X1B = (bf16_t*)(p.ws + WS_X1B);
    for (int row = gw; row < M; row += ngw) {
        f32x4* yr = (f32x4*)(p.out + (size_t)row * 1024) + lane;
        f32x4 v[4]; float s = 0.f;
#pragma unroll
        for (int j = 0; j < 4; ++j) { v[j] = yr[64 * j]; s += (v[j].x + v[j].y) + (v[j].z + v[j].w); }
        const float mean = wave_sum(s) * (1.f / 1024.f); float s2 = 0.f;
#pragma unroll
        for (int j = 0; j < 4; ++j) { v[j] = v[j] - mean; s2 += (v[j].x * v[j].x + v[j].y * v[j].y) + (v[j].z * v[j].z + v[j].w * v[j].w); }
        const float rstd = 1.f / sqrtf(wave_sum(s2) * (1.f / 1024.f) + LN_EPS);
#pragma unroll
        for (int j = 0; j < 4; ++j) { const f32x4 g = ((const f32x4*)p.ln1_g)[lane + 64 * j], bb = ((const f32x4*)p.ln1_b)[lane + 64 * j];
            const f32x4 o = v[j] * rstd * g + bb; yr[64 * j] = o;
            u32x2 w; w.x = pk2(o.x, o.y); w.y = pk2(o.z, o.w); ((u32x2*)(X1B + (size_t)row * 1024))[lane + 64 * j] = w; }
    }
}
#define TOPK_INSERT(tv, ti, val, id) do { float v_ = (val); int vi_ = (id); \
    _Pragma("unroll") for (int j_ = 0; j_ < 16; ++j_) { const bool gt_ = v_ > tv[j_]; const float t1_ = gt_ ? tv[j_] : v_; const int t2_ = gt_ ? ti[j_] : vi_; \
        tv[j_] = gt_ ? v_ : tv[j_]; ti[j_] = gt_ ? vi_ : ti[j_]; v_ = t1_; vi_ = t2_; } } while (0)
__device__ __forceinline__ void naive_routing(const Params& p, size_t gtid, size_t gsize) {
    const bf16_t* QP = (const bf16_t*)(p.ws + WS_QP); const bf16_t* SK = (const bf16_t*)(p.ws + WS_SUBK);
    int* IDS = (int*)(p.ws + WS_IDS); float* G = (float*)(p.ws + WS_G);
    for (size_t idx = gtid; idx < (size_t)8 * M; idx += gsize) {
        const int row = (int)(idx % M), hh = (int)(idx / M);
        float tv0[16], tv1[16]; int ti0[16], ti1[16];
#pragma unroll
        for (int j = 0; j < 16; ++j) { tv0[j] = -INFINITY; tv1[j] = -INFINITY; ti0[j] = 0; ti1[j] = 0; }
#pragma unroll
        for (int pp = 0; pp < 2; ++pp) {
            unsigned qp[64];
#pragma unroll
            for (int d = 0; d < 64; ++d) qp[d] = *(const unsigned*)(QP + (size_t)row * 2048 + (hh * 2 + pp) * 128 + 2 * d);
            for (int n = 0; n < 128; ++n) {
                const bf16_t* kr = SK + ((size_t)(hh * 2 + pp) * 128 + n) * 128;
                float y = 0.f;
#pragma unroll
                for (int d8 = 0; d8 < 16; ++d8) { const u32x4 kk = *(const u32x4*)(kr + d8 * 8);
                    y += bf2f(qp[d8 * 4 + 0] & 0xffffu) * bf2f(kk.x & 0xffffu) + bf2f(qp[d8 * 4 + 0] >> 16) * bf2f(kk.x >> 16)
                       + bf2f(qp[d8 * 4 + 1] & 0xffffu) * bf2f(kk.y & 0xffffu) + bf2f(qp[d8 * 4 + 1] >> 16) * bf2f(kk.y >> 16)
                       + bf2f(qp[d8 * 4 + 2] & 0xffffu) * bf2f(kk.z & 0xffffu) + bf2f(qp[d8 * 4 + 2] >> 16) * bf2f(kk.z >> 16)
                       + bf2f(qp[d8 * 4 + 3] & 0xffffu) * bf2f(kk.w & 0xffffu) + bf2f(qp[d8 * 4 + 3] >> 16) * bf2f(kk.w >> 16); }
                if (pp == 0) TOPK_INSERT(tv0, ti0, y, n); else TOPK_INSERT(tv1, ti1, y, n);
            }
        }
        float bv[16]; int bi[16];
#pragma unroll
        for (int j = 0; j < 16; ++j) { bv[j] = -INFINITY; bi[j] = 0; }
#pragma unroll
        for (int k0 = 0; k0 < 16; ++k0)
#pragma unroll
            for (int k1 = 0; k1 < 16; ++k1)
                if ((k0 + 1) * (k1 + 1) <= 16) TOPK_INSERT(bv, bi, tv0[k0] + tv1[k1], ti0[k0] * 128 + ti1[k1]);
        float e[16], sum = 0.f;
#pragma unroll
        for (int j = 0; j < 16; ++j) { e[j] = __expf(bv[j] - bv[0]); sum += e[j]; }
        const float rs = 1.0f / sum;
#pragma unroll
        for (int j = 0; j < 16; ++j) { IDS[(size_t)row * 128 + hh * 16 + j] = bi[j]; G[(size_t)row * 128 + hh * 16 + j] = e[j] * rs; }
    }
}
__device__ __forceinline__ void naive_peer(const Params& p, int gw, int ngw, int lane) {
    const bf16_t* UT = (const bf16_t*)(p.ws + WS_UTB); const bf16_t* VT = (const bf16_t*)(p.ws + WS_VTB);
    const int* IDS = (const int*)(p.ws + WS_IDS); const float* G = (const float*)(p.ws + WS_G);
    for (int row = gw; row < M; row += ngw) {
        f32x4* xr = (f32x4*)(p.out + (size_t)row * 1024) + lane;
        f32x4 xv[4], acc[4];
#pragma unroll
        for (int j = 0; j < 4; ++j) { xv[j] = xr[64 * j]; acc[j] = (f32x4){0.f, 0.f, 0.f, 0.f}; }
        for (int e = 0; e < 128; ++e) {
            const int id = IDS[(size_t)row * 128 + e]; const float gg = G[(size_t)row * 128 + e];
            const u32x2* ur = (const u32x2*)(UT + (size_t)id * 1024) + lane;
            float part = 0.f;
#pragma unroll
            for (int j = 0; j < 4; ++j) { const u32x2 u = ur[64 * j];
                part += xv[j].x * bf2f(u.x & 0xffffu) + xv[j].y * bf2f(u.x >> 16) + xv[j].z * bf2f(u.y & 0xffffu) + xv[j].w * bf2f(u.y >> 16); }
            const float hsum = wave_sum(part);
            const float a = gelu_exact(hsum) * gg;
            const u32x2* vr = (const u32x2*)(VT + (size_t)id * 1024) + lane;
#pragma unroll
            for (int j = 0; j < 4; ++j) { const u32x2 u = vr[64 * j];
                acc[j].x += a * bf2f(u.x & 0xffffu); acc[j].y += a * bf2f(u.x >> 16); acc[j].z += a * bf2f(u.y & 0xffffu); acc[j].w += a * bf2f(u.y >> 16); }
        }
        float s = 0.f;
#pragma unroll
        for (int j = 0; j < 4; ++j) { acc[j] = ALPHA * xv[j] + acc[j]; s += (acc[j].x + acc[j].y) + (acc[j].z + acc[j].w); }
        const float mean = wave_sum(s) * (1.f / 1024.f); float s2 = 0.f;
#pragma unroll
        for (int j = 0; j < 4; ++j) { acc[j] = acc[j] - mean; s2 += (acc[j].x * acc[j].x + acc[j].y * acc[j].y) + (acc[j].z * acc[j].z + acc[j].w * acc[j].w); }
        const float rstd = 1.f / sqrtf(wave_sum(s2) * (1.f / 1024.f) + LN_EPS);
#pragma unroll
        for (int j = 0; j < 4; ++j) { const f32x4 g = ((const f32x4*)p.ln2_g)[lane + 64 * j], bb = ((const f32x4*)p.ln2_b)[lane + 64 * j];
            xr[64 * j] = acc[j] * rstd * g + bb; }
    }
}

namespace pg8 {
#define PG8_LAS __attribute__((address_space(3)))
typedef unsigned short bf16_t;
typedef short bf16x8 __attribute__((ext_vector_type(8)));
typedef float f32x4 __attribute__((ext_vector_type(4)));
typedef unsigned u32x4 __attribute__((ext_vector_type(4)));
constexpr int BM = 256, BK = 64, HALF = 128, HTB = HALF * BK * 2  , STAGE_BYTES = 8 * HTB, NXCD = 8, WGM = 8;

__host__ __device__ __forceinline__ int lds_byte(int r, int c) { const int st = (r >> 4) * 2 + (c >> 5), rr = r & 15, cc = c & 31, ob = rr * 64 + cc * 2; return st * 1024 + (ob ^ (((ob >> 9) & 1) << 5)); }
__host__ __device__ __forceinline__ void stage_rc(int b, int& R, int& C) { const int st = b / 1024, sb = b % 1024, swz = sb ^ (((sb >> 9) & 1) << 5); R = (st >> 1) * 16 + swz / 64; C = (st & 1) * 32 + (swz % 64) / 2; }
__host__ __device__ __forceinline__ int perm32(int rho) { const int n = rho >> 4, i = rho & 15; return 8 * (i >> 2) + 4 * n + (i & 3); }

struct Unit { int pm, pn; };
struct Gemm { const bf16_t* A; const bf16_t* Bt; int M, N, K; };

struct StaticOrder {
    int nM, nN, nwg, G, c;
    __host__ __device__ void init(int M, int N, int G_, int c_) { nM = M / BM; nN = N / BM; nwg = nM * nN; G = G_; c = c_; }
    __host__ __device__ bool next(int i, Unit& u) const {
        const long L = (long)i * G + c; if (L >= nwg) return false;
        int wgid = (int)L; { const int q = nwg / NXCD, r = nwg % NXCD, xcd = wgid % NXCD, off = wgid / NXCD; wgid = (xcd < r ? xcd * (q + 1) : r * (q + 1) + (xcd - r) * q) + off; }
        const int nig = WGM * nN, gid = wgid / nig, fm = gid * WGM, gsz = (nM - fm) < WGM ? (nM - fm) : WGM;
        u.pm = fm + ((wgid % nig) % gsz); u.pn = (wgid % nig) / gsz; return true;
    }
    __device__ __forceinline__ void a_ready(const Unit&) const {}
    __device__ __forceinline__ void done(const Unit&) const {}
};

typedef float f32x2c_t __attribute__((ext_vector_type(2))); typedef __bf16 bf16x2c_t __attribute__((ext_vector_type(2)));
__device__ __forceinline__ unsigned cvt_pk_bf16(float lo, float hi) { f32x2c_t v = {lo, hi}; bf16x2c_t b = __builtin_convertvector(v, bf16x2c_t); return __builtin_bit_cast(unsigned, b); }
typedef float f32x2 __attribute__((ext_vector_type(2)));
__device__ __forceinline__ f32x2 gelu_pk(f32x2 v) {
    const f32x2 av = __builtin_elementwise_abs(v), d = av * 0.2316418882f + 1.0f;
    f32x2 t; t.x = __builtin_amdgcn_rcpf(d.x); t.y = __builtin_amdgcn_rcpf(d.y);
    f32x2 q = t * 0.5307027145f + (-0.7265760135f); q = q * t + 0.7107068705f; q = q * t + (-0.142248368f); q = q * t + 0.127414796f; q = q * t;
    const f32x2 s = (v * v) * (-0.72134752044f);
    f32x2 e; e.x = __builtin_amdgcn_exp2f(s.x); e.y = __builtin_amdgcn_exp2f(s.y);
    const f32x2 m = v * (q * e), r = v - m;
    f32x2 o; o.x = v.x < 0.f ? m.x : r.x; o.y = v.y < 0.f ? m.y : r.y; return o;
}

template <int ACT  > struct EpiBf16 {
    static constexpr bool PERM = true, AFTER_DRAIN = false; static_assert(ACT == 0 || ACT == 1, "EpiBf16: ACT is 0 (none) or 1 (gelu_pk)");
    bf16_t* O; int ldc; const float* bias; int split_cols; size_t split_stride; float scale0;
    __device__ __forceinline__ void operator()(const f32x4 (&acc)[2][2][4][2], const Unit& u, int wr, int wc, int fr, int fq) const {
        const int row0 = u.pm * BM + wr * 64 + fr; int colt = u.pn * BM; bf16_t* base = O;
        float sc = 1.f; if (split_cols) { const int t = colt / split_cols; base += (size_t)t * split_stride; colt -= t * split_cols; if (t == 0) sc = scale0; }
        const int col0 = colt + wc * 32 + 8 * fq, bcol0 = u.pn * BM + wc * 32 + 8 * fq;
        f32x4 bv[2][2];
#pragma unroll
        for (int bj = 0; bj < 2; ++bj)
#pragma unroll
            for (int n = 0; n < 2; ++n) bv[bj][n] = bias ? *(const f32x4*)(bias + bcol0 + bj * HALF + 4 * n) : (f32x4){0.f, 0.f, 0.f, 0.f};
#pragma unroll
        for (int ai = 0; ai < 2; ++ai)
#pragma unroll
            for (int m = 0; m < 4; ++m) { bf16_t* rowp = base + (size_t)(row0 + ai * HALF + m * 16) * ldc + col0;
#pragma unroll
                for (int bj = 0; bj < 2; ++bj) { f32x4 v0 = acc[ai][bj][m][0] + bv[bj][0], v1 = acc[ai][bj][m][1] + bv[bj][1];
                    if (ACT == 1) { f32x2 a = gelu_pk((f32x2){v0[0], v0[1]}), b = gelu_pk((f32x2){v0[2], v0[3]}), c = gelu_pk((f32x2){v1[0], v1[1]}), d = gelu_pk((f32x2){v1[2], v1[3]});
                        v0 = (f32x4){a.x, a.y, b.x, b.y}; v1 = (f32x4){c.x, c.y, d.x, d.y}; }
                    v0 = v0 * sc; v1 = v1 * sc; u32x4 w; w.x = cvt_pk_bf16(v0[0], v0[1]); w.y = cvt_pk_bf16(v0[2], v0[3]); w.z = cvt_pk_bf16(v1[0], v1[1]); w.w = cvt_pk_bf16(v1[2], v1[3]);
                    *(u32x4*)(rowp + bj * HALF) = w; } }
    }
};


__device__ __forceinline__ float fast_sigmoid(float z) { return __builtin_amdgcn_rcpf(1.0f + __builtin_amdgcn_exp2f(-1.4426950408889634f * z)); }
#define PG8_EPI_LOOP(row0) _Pragma("unroll") for (int ai = 0; ai < 2; ++ai) _Pragma("unroll") for (int m = 0; m < 4; ++m) { const int row = (row0) + ai * HALF + m * 16; _Pragma("unroll") for (int bj = 0; bj < 2; ++bj) { f32x4 v0 = acc[ai][bj][m][0], v1 = acc[ai][bj][m][1];
#define PG8_EPI_END } asm volatile("" ::: "memory"); }
struct EpiProjF {
    static constexpr bool PERM = true, AFTER_DRAIN = false;
    unsigned char* ws;
    __device__ __forceinline__ void operator()(const f32x4 (&acc)[2][2][4][2], const Unit& u, int wr, int wc, int fr, int fq) const {
        const int region = u.pn >> 1;
        const size_t offs[7] = {WS_SBQ, WS_SBK, WS_SBV, WS_DFQ, WS_DFK, WS_DFV, WS_MXQ};
        size_t off = offs[0];
#pragma unroll
        for (int q = 1; q < 7; ++q) off = (region == q) ? offs[q] : off;
        bf16_t* dst = (bf16_t*)(ws + off);
        const float sc = (region == 0 || region == 3) ? C2_64 : (region == 6 ? C2_128 : 1.0f);
        const bool rot = (region == 3 || region == 4) && ((wc & 1) == 0);
        const float sgn = (fq == 0) ? -1.0f : 1.0f;
        const int row0 = u.pm * BM + wr * 64 + fr, colt = (u.pn & 1) * BM + wc * 32 + 8 * fq;
        const f32x4* rope = (const f32x4*)(ws + WS_ROPE);
        PG8_EPI_LOOP(row0)
            if (rot) {
                f32x4 p0, p1;
#pragma unroll
                for (int j = 0; j < 4; ++j) { p0[j] = __shfl_xor(v0[j], 16); p1[j] = __shfl_xor(v1[j], 16); }
                if (fq < 2) {
                    const f32x4 c01 = rope[(size_t)row * 4 + 0], c23 = rope[(size_t)row * 4 + 1], c45 = rope[(size_t)row * 4 + 2], c67 = rope[(size_t)row * 4 + 3];
                    v0[0] = v0[0] * c01[0] + sgn * p0[0] * c01[1]; v0[1] = v0[1] * c01[2] + sgn * p0[1] * c01[3];
                    v0[2] = v0[2] * c23[0] + sgn * p0[2] * c23[1]; v0[3] = v0[3] * c23[2] + sgn * p0[3] * c23[3];
                    v1[0] = v1[0] * c45[0] + sgn * p1[0] * c45[1]; v1[1] = v1[1] * c45[2] + sgn * p1[1] * c45[3];
                    v1[2] = v1[2] * c67[0] + sgn * p1[2] * c67[1]; v1[3] = v1[3] * c67[2] + sgn * p1[3] * c67[3];
                }
            }
            v0 = v0 * sc; v1 = v1 * sc;
            u32x4 w; w.x = cvt_pk_bf16(v0[0], v0[1]); w.y = cvt_pk_bf16(v0[2], v0[3]); w.z = cvt_pk_bf16(v1[0], v1[1]); w.w = cvt_pk_bf16(v1[2], v1[3]);
            *(u32x4*)(dst + (size_t)row * 512 + colt + bj * HALF) = w;
        PG8_EPI_END
    }
};
struct EpiGateF {
    static constexpr bool PERM = true, AFTER_DRAIN = false;
    bf16_t* dst; const float* bias;
    __device__ __forceinline__ void operator()(const f32x4 (&acc)[2][2][4][2], const Unit& u, int wr, int wc, int fr, int fq) const {
        const int row0 = u.pm * BM + wr * 64 + fr, col0 = u.pn * BM + wc * 32 + 8 * fq;
        f32x4 bv[2][2];
#pragma unroll
        for (int bj = 0; bj < 2; ++bj)
#pragma unroll
            for (int n = 0; n < 2; ++n) bv[bj][n] = *(const f32x4*)(bias + col0 + bj * HALF + 4 * n);
        PG8_EPI_LOOP(row0)
            v0 = v0 + bv[bj][0]; v1 = v1 + bv[bj][1];
#pragma unroll
            for (int j = 0; j < 4; ++j) { v0[j] = fast_sigmoid(v0[j]); v1[j] = fast_sigmoid(v1[j]); }
            u32x4 w; w.x = cvt_pk_bf16(v0[0], v0[1]); w.y = cvt_pk_bf16(v0[2], v0[3]); w.z = cvt_pk_bf16(v1[0], v1[1]); w.w = cvt_pk_bf16(v1[2], v1[3]);
            *(u32x4*)(dst + (size_t)row * 3072 + col0 + bj * HALF) = w;
        PG8_EPI_END
    }
};
template <int MODE> struct EpiBranchF {
    static constexpr bool PERM = true, AFTER_DRAIN = false;
    const bf16_t* gates; int gcol; float* m32; bf16_t* mb;
    __device__ __forceinline__ void operator()(const f32x4 (&acc)[2][2][4][2], const Unit& u, int wr, int wc, int fr, int fq) const {
        const int row0 = u.pm * BM + wr * 64 + fr, col0 = u.pn * BM + wc * 32 + 8 * fq;
        PG8_EPI_LOOP(row0)
            const int c = col0 + bj * HALF;
            const u32x4 g = *(const u32x4*)(gates + (size_t)row * 3072 + gcol + c);
            v0[0] *= __uint_as_float(g.x << 16); v0[1] *= __uint_as_float(g.x & 0xffff0000u); v0[2] *= __uint_as_float(g.y << 16); v0[3] *= __uint_as_float(g.y & 0xffff0000u);
            v1[0] *= __uint_as_float(g.z << 16); v1[1] *= __uint_as_float(g.z & 0xffff0000u); v1[2] *= __uint_as_float(g.w << 16); v1[3] *= __uint_as_float(g.w & 0xffff0000u);
            float* mp = m32 + (size_t)row * 1024 + c;
            if (MODE > 0) { v0 = v0 + *(const f32x4*)mp; v1 = v1 + *(const f32x4*)(mp + 4); }
            if (MODE < 2) { *(f32x4*)mp = v0; *(f32x4*)(mp + 4) = v1; }
            else { u32x4 w; w.x = cvt_pk_bf16(v0[0], v0[1]); w.y = cvt_pk_bf16(v0[2], v0[3]); w.z = cvt_pk_bf16(v1[0], v1[1]); w.w = cvt_pk_bf16(v1[2], v1[3]);
                   *(u32x4*)(mb + (size_t)row * 1024 + c) = w; }
        PG8_EPI_END
    }
};
struct EpiOutF {
    static constexpr bool PERM = true, AFTER_DRAIN = false;
    const float* x; float* y;
    __device__ __forceinline__ void operator()(const f32x4 (&acc)[2][2][4][2], const Unit& u, int wr, int wc, int fr, int fq) const {
        const int row0 = u.pm * BM + wr * 64 + fr, col0 = u.pn * BM + wc * 32 + 8 * fq;
        PG8_EPI_LOOP(row0)
            const size_t o = (size_t)row * 1024 + col0 + bj * HALF;
            v0 = v0 + ALPHA * *(const f32x4*)(x + o); v1 = v1 + ALPHA * *(const f32x4*)(x + o + 4);
            *(f32x4*)(y + o) = v0; *(f32x4*)(y + o + 4) = v1;
        PG8_EPI_END
    }
};
struct GateOrder { Unit base;
    __device__ bool next(int i, Unit& u) const { if (i >= 3) return false; u.pm = base.pm; u.pn = 4 * i + base.pn; return true; }
    __device__ __forceinline__ void a_ready(const Unit&) const {} __device__ __forceinline__ void done(const Unit&) const {} };
struct OneOrder { int pm, pn;
    __device__ __forceinline__ bool next(int i, Unit& u) const { if (i >= 1) return false; u.pm = pm; u.pn = pn; return true; }
    __device__ __forceinline__ void a_ready(const Unit&) const {} __device__ __forceinline__ void done(const Unit&) const {} };
struct MemOrder { int c;
    __device__ bool next(int i, Unit& u) const { if (i >= 1 || c < 128 || c >= 136) return false; u.pm = (c - 128) >> 2; u.pn = (c - 128) & 3; return true; }
    __device__ __forceinline__ void a_ready(const Unit&) const {} __device__ __forceinline__ void done(const Unit&) const {} };

template <class Epi, class Sched, bool ALIGN_EPI = false, bool SP2 = false>
__device__ __forceinline__ void gemm_phase(PG8_LAS unsigned char* lds, const Gemm g, const Sched& S, const Epi& E) {
    int tid = threadIdx.x; asm volatile("" : "+v"(tid));
    const int wid = __builtin_amdgcn_readfirstlane(tid >> 6), lane = tid & 63, wr = wid >> 2, wc = wid & 3, fr = lane & 15, fq = lane >> 4;
    const int K = g.K, nt = K / BK;
    unsigned voffA[2], voffB[2];
#pragma unroll
    for (int i = 0; i < 2; ++i) { int R, C; stage_rc(tid * 16 + i * 8192, R, C); const int Rb = Epi::PERM ? ((R & ~31) + perm32(R & 31)) : R;
        voffA[i] = (unsigned)(R * K + C) * 2u; voffB[i] = (unsigned)(Rb * K + C) * 2u; }
    const size_t kstep = (size_t)(BK * 2);
    const size_t hstep = (size_t)HALF * K * 2;
    const size_t tstep = 2 * hstep;
    const unsigned ldsw = (unsigned)wid * 1024u;
    const int aoff = lds_byte(wr * 64 + fr, fq * 8), boff = lds_byte(wc * 32 + fr, fq * 8);
#define PG8_SA(b, h) (((b) * 2 + (h)) * HTB)
#define PG8_SB(b, h) ((4 + (b) * 2 + (h)) * HTB)
#define PG8_STAGE(bufoff, gbase, voff) do { _Pragma("unroll") for (int _i = 0; _i < 2; ++_i) \
        __builtin_amdgcn_global_load_lds((const unsigned*)((const char*)(gbase) + (voff)[_i]), (PG8_LAS unsigned*)(lds + (bufoff) + ldsw + _i * 8192), 16, 0, 0); } while (0)
#define PG8_LDA(dst, b, h) do { _Pragma("unroll") for (int m = 0; m < 4; ++m) _Pragma("unroll") for (int k = 0; k < 2; ++k) dst[m][k] = *(const PG8_LAS bf16x8*)(lds + PG8_SA(b, h) + aoff + m * 2048 + k * 1024); } while (0)
#define PG8_LDB(dst, b, h) do { _Pragma("unroll") for (int n = 0; n < 2; ++n) _Pragma("unroll") for (int k = 0; k < 2; ++k) dst[n][k] = *(const PG8_LAS bf16x8*)(lds + PG8_SB(b, h) + boff + n * 2048 + k * 1024); } while (0)
#define PG8_MMA(ai, bj, At, Bt) do { __builtin_amdgcn_s_setprio(1); _Pragma("unroll") for (int m = 0; m < 4; ++m) _Pragma("unroll") for (int n = 0; n < 2; ++n) _Pragma("unroll") for (int k = 0; k < 2; ++k) \
        acc[ai][bj][m][n] = __builtin_amdgcn_mfma_f32_16x16x32_bf16(Bt[n][k], At[m][k], acc[ai][bj][m][n], 0, 0, 0); __builtin_amdgcn_s_setprio(0); } while (0)
#define PG8_WAIT_V(n) asm volatile("s_waitcnt vmcnt(" #n ")" ::: "memory")
#define PG8_WAIT_L(n) asm volatile("s_waitcnt lgkmcnt(" #n ")" ::: "memory")
#define PG8_BAR __builtin_amdgcn_s_barrier()
#define PG8_SCHED __builtin_amdgcn_sched_barrier(0)
    Unit cur, nxt; int ui = 0;
    if (!S.next(0, cur)) return;
    f32x4 acc[2][2][4][2];
#pragma unroll
    for (int a = 0; a < 2; ++a)
#pragma unroll
        for (int b = 0; b < 2; ++b)
#pragma unroll
            for (int m = 0; m < 4; ++m)
#pragma unroll
                for (int n = 0; n < 2; ++n) acc[a][b][m][n] = (f32x4){0.f, 0.f, 0.f, 0.f};
    bf16x8 At[4][2], B0[2][2], B1[2][2];
    const char* cA = (const char*)g.A + (size_t)cur.pm * tstep; const char* cB = (const char*)g.Bt + (size_t)cur.pn * tstep;
    S.a_ready(cur);
    if constexpr (SP2) {
        PG8_STAGE(PG8_SB(0, 0), cB, voffB); PG8_STAGE(PG8_SB(0, 1), cB + hstep, voffB); PG8_STAGE(PG8_SA(0, 0), cA, voffA); PG8_STAGE(PG8_SA(0, 1), cA + hstep, voffA);
        if (wr == 1) PG8_BAR;
        PG8_WAIT_V(2); PG8_BAR;
        PG8_STAGE(PG8_SB(1, 0), cB + kstep, voffB); PG8_STAGE(PG8_SA(1, 0), cA + kstep, voffA); PG8_STAGE(PG8_SB(1, 1), cB + hstep + kstep, voffB);
        PG8_WAIT_V(6); PG8_BAR;
    } else {
        PG8_STAGE(PG8_SB(0, 0), cB, voffB); PG8_STAGE(PG8_SA(0, 0), cA, voffA); PG8_STAGE(PG8_SB(0, 1), cB + hstep, voffB); PG8_STAGE(PG8_SA(0, 1), cA + hstep, voffA);
        if (wr == 1) PG8_BAR;
        PG8_WAIT_V(4); PG8_BAR;
        PG8_STAGE(PG8_SB(1, 0), cB + kstep, voffB); PG8_STAGE(PG8_SA(1, 0), cA + kstep, voffA); PG8_STAGE(PG8_SB(1, 1), cB + hstep + kstep, voffB);
        PG8_WAIT_V(6); PG8_BAR;
    }
    for (;;) {
        const bool has_next = S.next(ui + 1, nxt);
        const char* nA = has_next ? (const char*)g.A + (size_t)nxt.pm * tstep : cA; const char* nB = has_next ? (const char*)g.Bt + (size_t)nxt.pn * tstep : cB;
        for (int t = 0; t < nt; t += 2) {
            const bool last = (t == nt - 2);
            const char* a1 = cA + (size_t)(t + 1) * kstep;
            const char* a2 = last ? nA : cA + (size_t)(t + 2) * kstep; const char* b2 = last ? nB : cB + (size_t)(t + 2) * kstep;
            const char* a3 = a2 + kstep; const char* b3 = b2 + kstep;
            if (last && has_next) S.a_ready(nxt);
            if constexpr (SP2) {
            PG8_LDB(B0, 0, 0); PG8_LDB(B1, 0, 1); PG8_SCHED; PG8_LDA(At, 0, 0); PG8_STAGE(PG8_SA(1, 1), a1 + hstep, voffA);
            PG8_WAIT_V(8); PG8_WAIT_L(0); PG8_BAR; PG8_MMA(0, 0, At, B0); PG8_MMA(0, 1, At, B1); PG8_BAR; PG8_SCHED;
            PG8_LDA(At, 0, 1); PG8_STAGE(PG8_SB(0, 0), b2, voffB); PG8_STAGE(PG8_SB(0, 1), b2 + hstep, voffB); PG8_STAGE(PG8_SA(0, 0), a2, voffA);
            PG8_WAIT_V(8); PG8_WAIT_L(0); PG8_BAR; PG8_MMA(1, 0, At, B0); PG8_MMA(1, 1, At, B1); PG8_BAR; PG8_SCHED;
            PG8_LDB(B0, 1, 0); PG8_LDB(B1, 1, 1); PG8_SCHED; PG8_LDA(At, 1, 0); PG8_STAGE(PG8_SA(0, 1), a2 + hstep, voffA);
            PG8_WAIT_V(8); PG8_WAIT_L(0); PG8_BAR; PG8_MMA(0, 0, At, B0); PG8_MMA(0, 1, At, B1); PG8_BAR; PG8_SCHED;
            PG8_LDA(At, 1, 1); PG8_STAGE(PG8_SB(1, 0), b3, voffB); PG8_STAGE(PG8_SB(1, 1), b3 + hstep, voffB); PG8_STAGE(PG8_SA(1, 0), a3, voffA);
            PG8_WAIT_V(8); PG8_WAIT_L(0); PG8_BAR; PG8_MMA(1, 0, At, B0); PG8_MMA(1, 1, At, B1); PG8_BAR; PG8_SCHED;
            } else {
            PG8_LDB(B0, 0, 0); PG8_SCHED; PG8_LDA(At, 0, 0); PG8_STAGE(PG8_SA(1, 1), a1 + hstep, voffA);
            PG8_WAIT_L(8); PG8_BAR; PG8_WAIT_L(0); PG8_MMA(0, 0, At, B0); PG8_BAR; PG8_SCHED;
            PG8_LDB(B1, 0, 1); PG8_STAGE(PG8_SB(0, 0), b2, voffB);
            PG8_BAR; PG8_WAIT_L(0); PG8_MMA(0, 1, At, B1); PG8_BAR;
            PG8_LDA(At, 0, 1); PG8_STAGE(PG8_SA(0, 0), a2, voffA);
            PG8_BAR; PG8_WAIT_L(0); PG8_MMA(1, 0, At, B0); PG8_BAR; PG8_SCHED;
            PG8_STAGE(PG8_SB(0, 1), b2 + hstep, voffB);
            PG8_WAIT_V(6); PG8_BAR; PG8_MMA(1, 1, At, B1); PG8_BAR;
            PG8_LDB(B0, 1, 0); PG8_SCHED; PG8_LDA(At, 1, 0); PG8_STAGE(PG8_SA(0, 1), a2 + hstep, voffA);
            PG8_WAIT_L(8); PG8_BAR; PG8_WAIT_L(0); PG8_MMA(0, 0, At, B0); PG8_BAR; PG8_SCHED;
            PG8_LDB(B1, 1, 1); PG8_STAGE(PG8_SB(1, 0), b3, voffB);
            PG8_BAR; PG8_WAIT_L(0); PG8_MMA(0, 1, At, B1); PG8_BAR;
            PG8_LDA(At, 1, 1); PG8_STAGE(PG8_SA(1, 0), a3, voffA);
            PG8_BAR; PG8_WAIT_L(0); PG8_MMA(1, 0, At, B0); PG8_BAR; PG8_SCHED;
            PG8_STAGE(PG8_SB(1, 1), b3 + hstep, voffB);
            PG8_WAIT_V(6); PG8_BAR; PG8_MMA(1, 1, At, B1); PG8_BAR;
            }
        }
        if constexpr (ALIGN_EPI) { if (wr == 0) PG8_BAR; }
        if constexpr (!Epi::AFTER_DRAIN) { E(acc, cur, wr, wc, fr, fq); S.done(cur); }
        if (!has_next) break;
#pragma unroll
        for (int a = 0; a < 2; ++a)
#pragma unroll
            for (int b = 0; b < 2; ++b)
#pragma unroll
                for (int m = 0; m < 4; ++m)
#pragma unroll
                    for (int n = 0; n < 2; ++n) acc[a][b][m][n] = (f32x4){0.f, 0.f, 0.f, 0.f};
        cur = nxt; cA = nA; cB = nB; ++ui;
        if constexpr (ALIGN_EPI) { if (wr == 1) PG8_BAR; }
    }
    PG8_WAIT_V(0);
    if constexpr (!ALIGN_EPI) { if (wr == 0) PG8_BAR; }
    PG8_BAR;
    if constexpr (Epi::AFTER_DRAIN) { E.fused(acc, cur, wr, wc, fr, fq, lds, wid, lane); S.done(cur); }
#undef PG8_SA
#undef PG8_SB
#undef PG8_STAGE
#undef PG8_LDA
#undef PG8_LDB
#undef PG8_MMA
#undef PG8_WAIT_V
#undef PG8_WAIT_L
#undef PG8_BAR
#undef PG8_SCHED
}
}

#ifndef PG8_SP2
#define PG8_SP2 true
#endif
#ifndef PG8_ALIGN
#define PG8_ALIGN true
#endif

#include <hip/hip_bf16.h>
#include <cmath>
namespace attn_body {
using bf16=__hip_bfloat16;
using bf16x8=__attribute__((ext_vector_type(8)))short;
using s16x4=__attribute__((ext_vector_type(4)))short;
using f32x16=__attribute__((ext_vector_type(16)))float;
using u32x4=__attribute__((ext_vector_type(4)))unsigned;
constexpr int BATCH=2,NHEAD=16,SEQ=8192,D=64,DM=NHEAD*D,PQ=512,PO=1024;
constexpr int NW=8,QBLK=32,QB=QBLK*NW,KVBLK=64,NQB=SEQ/QB;
constexpr int ATTN_PITCH=DM, ATTN_UNIT_ROWS=QB;
__device__ __forceinline__ int crow(int r,int hi){return (r&3)+8*(r>>2)+4*hi;}
#define SBAR() __builtin_amdgcn_sched_barrier(0)
__device__ __forceinline__ void cmask(f32x16&p0,f32x16&p1,int jb,int qrel,int hi){
  const float NEG=-INFINITY; int kb=64*jb+4*hi;
  #pragma unroll
  for(int r=0;r<16;++r){int kv=kb+(r&3)+8*(r>>2); if(kv>qrel)p0[r]=NEG; if(kv+32>qrel)p1[r]=NEG;}
}

constexpr int NSLOT=3, SLOTB=8192;
constexpr int LDS_K=0, LDS_V=NSLOT*SLOTB, LDS_WS=2*NSLOT*SLOTB, LDS_OST=LDS_WS+NW*64*4, LDS_BYTES=LDS_OST+NW*4096;
constexpr float C2=0.125f*1.4426950408889634f;
__device__ __forceinline__ void glds16(const void*gsrc,unsigned lds_dst){unsigned keep;
  asm volatile("s_mov_b32 %0, m0\n\ts_mov_b32 m0, %2\n\ts_nop 0\n\tglobal_load_lds_dwordx4 %1, off\n\ts_mov_b32 m0, %0":"=&s"(keep):"v"(gsrc),"s"(lds_dst):"memory");}
__device__ __forceinline__ float max3f(float a,float b,float c){float r;asm("v_max3_f32 %0, %1, %2, %3":"=v"(r):"v"(a),"v"(b),"v"(c));return r;}
__device__ __forceinline__ float max2f(float a,float b){float r;asm("v_max_f32_e32 %0, %1, %2":"=v"(r):"v"(a),"v"(b));return r;}
__device__ __forceinline__ float fadd_s(float a,float b){float r;asm("v_add_f32_e32 %0, %1, %2":"=v"(r):"v"(a),"v"(b));return r;}
__device__ __forceinline__ float fsub_s(float a,float b){float r;asm("v_sub_f32_e32 %0, %1, %2":"=v"(r):"v"(a),"v"(b));return r;}
typedef float f32x2_t __attribute__((ext_vector_type(2))); typedef __bf16 bf16x2_t __attribute__((ext_vector_type(2)));
__device__ __forceinline__ unsigned cvtpk_s(float lo,float hi){f32x2_t v={lo,hi};bf16x2_t b=__builtin_convertvector(v,bf16x2_t);return __builtin_bit_cast(unsigned,b);}
#define WAIT_BAR(N) asm volatile("s_waitcnt vmcnt(" #N ") lgkmcnt(0)\n\ts_barrier":::"memory")

__device__ __forceinline__ void qkt(f32x16&p0,f32x16&p1,const char*Kslot,const bf16x8*qr,const f32x16&negm,int r32,int hi){
  const char*kb=Kslot+hi*1024+r32*16;
  #pragma unroll
  for(int d0=0;d0<4;++d0){
    const bf16x8 b0=*reinterpret_cast<const bf16x8*>(kb+d0*2048);
    const bf16x8 b1=*reinterpret_cast<const bf16x8*>(kb+d0*2048+512);
    if(d0==0){p0=__builtin_amdgcn_mfma_f32_32x32x16_bf16(b0,qr[0],negm,0,0,0);p1=__builtin_amdgcn_mfma_f32_32x32x16_bf16(b1,qr[0],negm,0,0,0);}
    else{p0=__builtin_amdgcn_mfma_f32_32x32x16_bf16(b0,qr[d0],p0,0,0,0);p1=__builtin_amdgcn_mfma_f32_32x32x16_bf16(b1,qr[d0],p1,0,0,0);}}
}
typedef __attribute__((address_space(3))) const char* lds_cptr;
typedef short v4i16_t __attribute__((ext_vector_type(4)));
__device__ __forceinline__ void kload8(bf16x8*kf,lds_cptr kp){
  kf[0]=*(const __attribute__((address_space(3))) bf16x8*)(kp);      kf[1]=*(const __attribute__((address_space(3))) bf16x8*)(kp+512);
  kf[2]=*(const __attribute__((address_space(3))) bf16x8*)(kp+2048); kf[3]=*(const __attribute__((address_space(3))) bf16x8*)(kp+2560);
  kf[4]=*(const __attribute__((address_space(3))) bf16x8*)(kp+4096); kf[5]=*(const __attribute__((address_space(3))) bf16x8*)(kp+4608);
  kf[6]=*(const __attribute__((address_space(3))) bf16x8*)(kp+6144); kf[7]=*(const __attribute__((address_space(3))) bf16x8*)(kp+6656);
}
__device__ __forceinline__ void kload2(bf16x8*kf,lds_cptr kp,int j){ kf[2*j]=*(const __attribute__((address_space(3))) bf16x8*)(kp+j*2048); kf[2*j+1]=*(const __attribute__((address_space(3))) bf16x8*)(kp+j*2048+512); }
__device__ __forceinline__ s16x4 vtr(lds_cptr p){ return __builtin_bit_cast(s16x4,__builtin_amdgcn_ds_read_tr16_b64_v4i16((__attribute__((address_space(3))) v4i16_t*)p)); }
__device__ __forceinline__ float rowmax(const f32x16&p0,const f32x16&p1){
  float a=max3f(p0[0],p0[1],p1[0]),b=max3f(p0[2],p0[3],p1[1]);a=max3f(a,p1[2],p1[3]);
  #pragma unroll
  for(int r=4;r<16;r+=4){a=max3f(a,p0[r],p0[r+1]);b=max3f(b,p0[r+2],p0[r+3]);a=max3f(a,p1[r],p1[r+1]);b=max3f(b,p1[r+2],p1[r+3]);}
  const float m=max2f(a,b);
  auto rr=__builtin_amdgcn_permlane32_swap(__float_as_uint(m),__float_as_uint(m),false,false);
  return max2f(__uint_as_float(rr[0]),__uint_as_float(rr[1]));
}
__device__ __forceinline__ void pv(f32x16*o,int vb,bf16x8 pa0,bf16x8 pa1,bf16x8 pa2,bf16x8 pa3){
  #pragma unroll
  for(int d0=0;d0<2;++d0){s16x4 lo[4],hi[4];
    #pragma unroll
    for(int ks=0;ks<4;++ks){
      asm volatile("ds_read_b64_tr_b16 %0,%1 offset:%c2":"=&v"(lo[ks]):"v"(vb),"i"(d0*4096+ks*1024):"memory");
      asm volatile("ds_read_b64_tr_b16 %0,%1 offset:%c2":"=&v"(hi[ks]):"v"(vb),"i"(d0*4096+ks*1024+512):"memory");}
    asm volatile("s_waitcnt lgkmcnt(0)":::"memory");SBAR();
    #define PK(k) (bf16x8){lo[k][0],lo[k][1],lo[k][2],lo[k][3],hi[k][0],hi[k][1],hi[k][2],hi[k][3]}
    o[d0]=__builtin_amdgcn_mfma_f32_32x32x16_bf16(pa0,PK(0),o[d0],0,0,0);
    o[d0]=__builtin_amdgcn_mfma_f32_32x32x16_bf16(pa1,PK(1),o[d0],0,0,0);
    o[d0]=__builtin_amdgcn_mfma_f32_32x32x16_bf16(pa2,PK(2),o[d0],0,0,0);
    o[d0]=__builtin_amdgcn_mfma_f32_32x32x16_bf16(pa3,PK(3),o[d0],0,0,0);
    #undef PK
  }
}

#ifndef ATTN_STORE16
#define ATTN_STORE16(p,v) (*(u32x4*)(p)=(v))
#endif
template<int THRL> __device__ __forceinline__ void attn_unit(int b,int h,int qb,const bf16*Q,const bf16*__restrict__ K,const bf16*__restrict__ V,bf16*O,char*shm){
  int tid=threadIdx.x; asm volatile("":"+v"(tid)); const int lane=tid&63,r32=lane&31,hi=lane>>5; const int wid=__builtin_amdgcn_readfirstlane(tid>>6);
  const long rowbase=(long)b*SEQ; const int q0=qb*QB;
  const bf16*Qw=Q+(rowbase+q0+wid*QBLK)*PQ;
  const bf16*Kh=K+rowbase*PQ,*Vh=V+rowbase*PQ;
  const unsigned lds0=(unsigned)(uintptr_t)shm;
  float*wsf=(float*)(shm+LDS_WS)+wid*64;
  const bf16*ksrc=Kh+(long)lane*PQ+wid*8;
  const bf16*vsrc=Vh+(long)(16*(wid&3)+(lane>>2))*PQ+(wid>>2)*32+(lane&3)*8;
  const unsigned kdst=lds0+LDS_K+wid*1024, vdst=lds0+LDS_V+wid*1024;
  #define DMA_K(t,slot) glds16(ksrc+(long)(t)*KVBLK*PQ,(unsigned)__builtin_amdgcn_readfirstlane(kdst+(slot)))
  #define DMA_V(t,slot) glds16(vsrc+(long)(t)*KVBLK*PQ,(unsigned)__builtin_amdgcn_readfirstlane(vdst+(slot)))
  const int vb0=(int)(lds0+LDS_V)+((lane>>4)&1)*32+(lane&3)*8+(4*hi+((lane&15)>>2))*64;
  const char*Kbase=shm+LDS_K; bf16x8 kf[8];
  const lds_cptr shm3=(lds_cptr)shm; const lds_cptr kp0=shm3+LDS_K+hi*1024+r32*16; const lds_cptr vp0=shm3+LDS_V+((lane>>4)&1)*32+(lane&3)*8+(4*hi+((lane&15)>>2))*64;
  const int NT=(q0+QB)/KVBLK;
  DMA_K(0,0);DMA_V(0,0);DMA_K(1,SLOTB);
  bf16x8 qr[4];
  #pragma unroll
  for(int d0=0;d0<4;++d0)qr[d0]=*reinterpret_cast<const bf16x8*>(&Qw[(long)r32*PQ+d0*16+hi*8]);
  float mhat=0.f,l_reg=0.f;f32x16 o[2];o[0]=f32x16{};o[1]=f32x16{};f32x16 negm=f32x16{};asm volatile("":"+v"(negm));
  const int qrel=wid*QBLK+r32;
  #define CMASK(P0,P1,t) do{int jb_=(t)-(NT-4); if(jb_>=0)cmask(P0,P1,jb_,qrel,hi);}while(0)
  bool resc=false;
  #define START(P0,P1) do{ const float rm=rowmax(P0,P1); resc=false; \
    { const float dl=rm; mhat=fadd_s(mhat,dl); \
      _Pragma("unroll") for(int r=0;r<16;++r){P0[r]=fsub_s(P0[r],dl);P1[r]=fsub_s(P1[r],dl);} \
      _Pragma("unroll") for(int r=0;r<16;++r)negm[r]=-mhat; asm volatile("":"+v"(negm)); } \
    _Pragma("unroll") for(int r=0;r<16;++r)P0[r]=__builtin_amdgcn_exp2f(P0[r]); }while(0)
  #define RESC() do{ if(resc){ asm volatile("s_waitcnt lgkmcnt(0)":::"memory"); \
      _Pragma("unroll") for(int d_=0;d_<2;++d_) _Pragma("unroll") for(int r=0;r<16;++r)o[d_][r]*=wsf[crow(r,hi)]; } }while(0)
  f32x16 pA0,pA1,pB0,pB1;
  int sl_prev=0,sl_cur=0,sl_next=SLOTB;
  #define ROT() do{sl_prev=sl_cur;sl_cur=sl_next;sl_next=(sl_next==(NSLOT-1)*SLOTB)?0:sl_next+SLOTB;}while(0)
  DMA_K(2,2*SLOTB);
  WAIT_BAR(3);
  qkt(pA0,pA1,Kbase,qr,negm,r32,hi);asm volatile("s_nop 15\n\ts_nop 7":"+v"(pA0),"+v"(pA1));CMASK(pA0,pA1,0);
  START(pA0,pA1);
  _Pragma("unroll") for(int r=0;r<16;++r)pA1[r]=__builtin_amdgcn_exp2f(pA1[r]);
  WAIT_BAR(0);
  DMA_K(3,0);DMA_V(1,SLOTB);
  ROT();
  kload8(kf,kp0+sl_cur);
  WAIT_BAR(2);
  s16x4 vlo[8],vhi[8]; u32x4 pw0,pw1,pw2,pw3;
  #define PKW(P,B) cvtpk_s(P[B],P[B+1])
  #define PAF(k) __builtin_bit_cast(bf16x8,pw##k)
  #define VFR(i) (bf16x8){vlo[i][0],vlo[i][1],vlo[i][2],vlo[i][3],vhi[i][0],vhi[i][1],vhi[i][2],vhi[i][3]}
  #define PIN(x) asm volatile("":"+v"(x))
  #define MX3(a,b,c) __builtin_fmaxf(__builtin_fmaxf((a),(b)),(c))
  #define GAPA(MF,A0,A1,A2,A3,W0,W1,PW) do{ MF; sacc+=A0; sacc+=A1; sacc+=A2; sacc+=A3; PIN(sacc); W0; W1; PIN(PW); SBAR(); }while(0)
  #define EX(v) __builtin_amdgcn_exp2f(v)
  #define GAPB(MF,X,B) do{ MF; X[B]=EX(X[B]); X[B+1]=EX(X[B+1]); X[B+2]=EX(X[B+2]); X[B+3]=EX(X[B+3]); PIN(X); SBAR(); }while(0)
  #define VRD(i) do{ vlo[i]=vtr(vp_+(((i)>>2)*4096+((i)&3)*1024)); vhi[i]=vtr(vp_+(((i)>>2)*4096+((i)&3)*1024+512)); }while(0)
  #define KRD(G,j) do{ if(G){ kload2(kf,kp0+sl_next,j); SBAR(); } }while(0)
  #define STEP(C0,C1,P0,P1,t,GK,GV,GL) do{ SBAR(); \
    const lds_cptr vp_=vp0+sl_prev; \
    VRD(0); SBAR(); float sacc=(P0[0]+P0[1]); \
    GAPA(C0=__builtin_amdgcn_mfma_f32_32x32x16_bf16(kf[0],qr[0],negm,0,0,0), P0[2],P0[3],P0[4],P0[5],     pw0[0]=PKW(P0,0), pw0[1]=PKW(P0,2), pw0); \
    VRD(4); SBAR(); GAPA(C1=__builtin_amdgcn_mfma_f32_32x32x16_bf16(kf[1],qr[0],negm,0,0,0), P0[6],P0[7],P0[8],P0[9],     pw0[2]=PKW(P0,4), pw0[3]=PKW(P0,6), pw0); \
    VRD(1); SBAR(); GAPA(C0=__builtin_amdgcn_mfma_f32_32x32x16_bf16(kf[2],qr[1],C0,0,0,0),   P0[10],P0[11],P0[12],P0[13], pw1[0]=PKW(P0,8), pw1[1]=PKW(P0,10), pw1); \
    VRD(5); SBAR(); GAPA(C1=__builtin_amdgcn_mfma_f32_32x32x16_bf16(kf[3],qr[1],C1,0,0,0),   P0[14],P0[15],P1[0],P1[1],   pw1[2]=PKW(P0,12),pw1[3]=PKW(P0,14), pw1); \
    VRD(2); SBAR(); GAPA(C0=__builtin_amdgcn_mfma_f32_32x32x16_bf16(kf[4],qr[2],C0,0,0,0),   P1[2],P1[3],P1[4],P1[5],     pw2[0]=PKW(P1,0), pw2[1]=PKW(P1,2), pw2); \
    VRD(6); SBAR(); GAPA(C1=__builtin_amdgcn_mfma_f32_32x32x16_bf16(kf[5],qr[2],C1,0,0,0),   P1[6],P1[7],P1[8],P1[9],     pw2[2]=PKW(P1,4), pw2[3]=PKW(P1,6), pw2); \
    VRD(3); SBAR(); GAPA(C0=__builtin_amdgcn_mfma_f32_32x32x16_bf16(kf[6],qr[3],C0,0,0,0),   P1[10],P1[11],P1[12],P1[13], pw3[0]=PKW(P1,8), pw3[1]=PKW(P1,10), pw3); \
    VRD(7); SBAR(); GAPA(C1=__builtin_amdgcn_mfma_f32_32x32x16_bf16(kf[7],qr[3],C1,0,0,0),   P1[14],P1[15],0.f,0.f,       pw3[2]=PKW(P1,12),pw3[3]=PKW(P1,14), pw3); \
    l_reg+=sacc; \
    if(GK){DMA_K((t)+3,sl_cur);} if(GV){DMA_V((t)+1,sl_next);} \
    CMASK(C0,C1,t); \
    { float a=MX3(C0[0],C0[1],C1[0]),b=MX3(C0[2],C0[3],C1[1]); a=MX3(a,C1[2],C1[3]); \
      _Pragma("unroll") for(int r=4;r<16;r+=4){a=MX3(a,C0[r],C0[r+1]);b=MX3(b,C0[r+2],C0[r+3]);a=MX3(a,C1[r],C1[r+1]);b=MX3(b,C1[r+2],C1[r+3]);} \
      float rm=__builtin_fmaxf(a,b); { auto rr=__builtin_amdgcn_permlane32_swap(__float_as_uint(rm),__float_as_uint(rm),false,false); rm=__builtin_fmaxf(__uint_as_float(rr[0]),__uint_as_float(rr[1])); } \
      resc=false; \
      if(__builtin_expect(__any(rm>(float)THRL),0)){ const float dl=__builtin_fmaxf(rm,0.f); mhat+=dl; \
        _Pragma("unroll") for(int r=0;r<16;++r){C0[r]-=dl;C1[r]-=dl;} \
        _Pragma("unroll") for(int r=0;r<16;++r)negm[r]=-mhat; asm volatile("":"+v"(negm)); \
        const float f=__builtin_amdgcn_exp2f(-dl); l_reg*=f; if(hi==0)wsf[r32]=f; resc=true; } } \
    SBAR(); \
    GAPB(o[0]=__builtin_amdgcn_mfma_f32_32x32x16_bf16(PAF(0),VFR(0),o[0],0,0,0), C0,0); \
    GAPB(o[1]=__builtin_amdgcn_mfma_f32_32x32x16_bf16(PAF(0),VFR(4),o[1],0,0,0), C0,4); \
    KRD(GL,0); GAPB(o[0]=__builtin_amdgcn_mfma_f32_32x32x16_bf16(PAF(1),VFR(1),o[0],0,0,0), C0,8); \
    KRD(GL,1); GAPB(o[1]=__builtin_amdgcn_mfma_f32_32x32x16_bf16(PAF(1),VFR(5),o[1],0,0,0), C0,12); \
    KRD(GL,2); GAPB(o[0]=__builtin_amdgcn_mfma_f32_32x32x16_bf16(PAF(2),VFR(2),o[0],0,0,0), C1,0); \
    KRD(GL,3); GAPB(o[1]=__builtin_amdgcn_mfma_f32_32x32x16_bf16(PAF(2),VFR(6),o[1],0,0,0), C1,4); \
    GAPB(o[0]=__builtin_amdgcn_mfma_f32_32x32x16_bf16(PAF(3),VFR(3),o[0],0,0,0), C1,8); \
    GAPB(o[1]=__builtin_amdgcn_mfma_f32_32x32x16_bf16(PAF(3),VFR(7),o[1],0,0,0), C1,12); \
    }while(0)
  int t=1;
  #undef CMASK
  #define CMASK(P0,P1,t) do{}while(0)
  for(;t+5<NT;t+=2){
    STEP(pB0,pB1,pA0,pA1,t,true,true,true);     WAIT_BAR(2); RESC(); ROT();
    STEP(pA0,pA1,pB0,pB1,t+1,true,true,true);   WAIT_BAR(2); RESC(); ROT();
  }
  #undef CMASK
  #define CMASK(P0,P1,t) do{int jb_=(t)-(NT-4); if(jb_>=0)cmask(P0,P1,jb_,qrel,hi);}while(0)
  #define ENDW(tt) do{ if((tt)+3<NT){WAIT_BAR(2);} else if((tt)+2<NT){WAIT_BAR(1);} else {WAIT_BAR(0);} }while(0)
  for(;t+1<NT;t+=2){
    STEP(pB0,pB1,pA0,pA1,t,(t+3<NT),(t+1<NT),(t+1<NT));       ENDW(t);   RESC(); ROT();
    STEP(pA0,pA1,pB0,pB1,t+1,(t+4<NT),(t+2<NT),(t+2<NT));     ENDW(t+1); RESC(); ROT();
  }
  STEP(pB0,pB1,pA0,pA1,NT-1,false,false,false); RESC();
  { float sacc=pB0[0]+pB0[1]; _Pragma("unroll") for(int r=2;r<16;++r)sacc+=pB0[r]; _Pragma("unroll") for(int r=0;r<16;++r)sacc+=pB1[r]; l_reg+=sacc;
    pw0=(u32x4){PKW(pB0,0),PKW(pB0,2),PKW(pB0,4),PKW(pB0,6)};pw1=(u32x4){PKW(pB0,8),PKW(pB0,10),PKW(pB0,12),PKW(pB0,14)};pw2=(u32x4){PKW(pB1,0),PKW(pB1,2),PKW(pB1,4),PKW(pB1,6)};pw3=(u32x4){PKW(pB1,8),PKW(pB1,10),PKW(pB1,12),PKW(pB1,14)};
    SBAR(); pv(o,vb0+sl_cur,PAF(0),PAF(1),PAF(2),PAF(3)); }
  #undef PKW
  #undef PAF
  #undef VFR
  #undef PIN
  #undef MX3
  #undef GAPA
  #undef GAPB
  #undef EX
  #undef VRD
  #undef KRD
  #undef STEP
  #undef ENDW
  {auto rr=__builtin_amdgcn_permlane32_swap(__float_as_uint(l_reg),__float_as_uint(l_reg),false,false);l_reg=__uint_as_float(rr[0])+__uint_as_float(rr[1]);}
  if(hi==0)wsf[32+r32]=l_reg;asm volatile("s_waitcnt lgkmcnt(0)":::"memory");
  float rli[16];
  #pragma unroll
  for(int r=0;r<16;++r)rli[r]=__builtin_amdgcn_rcpf(wsf[32+crow(r,hi)]);
  bf16*Ow=O+(rowbase+q0+wid*QBLK)*PO;
  { bf16*stg=(bf16*)(shm+LDS_OST)+wid*2048;
    #pragma unroll
    for(int r=0;r<16;++r){const int orow=crow(r,hi);
      #pragma unroll
      for(int d0=0;d0<2;++d0)stg[orow*64+d0*32+r32]=__float2bfloat16(o[d0][r]*rli[r]);}
    asm volatile("s_waitcnt lgkmcnt(0)":::"memory");
    #pragma unroll
    for(int i=0;i<4;++i){const int row=i*8+(lane>>3),ch=lane&7; const u32x4 v=*(const u32x4*)(stg+row*64+ch*8); ATTN_STORE16(Ow+(long)row*PO+ch*8,v);} }
  asm volatile("s_waitcnt lgkmcnt(0)\n\ts_barrier":::"memory");
  #undef DMA_K
  #undef DMA_V
  #undef CMASK
  #undef START
  #undef RESC
  #undef ROT
}
constexpr int ATTN_LDS_BYTES=LDS_BYTES;
struct AttnTensors { const bf16* Q; const bf16* K; const bf16* V; bf16* O; };
struct AttnUnit { int bh; int qb; };
struct StaticOrder {
  int vcu;
  __device__ __forceinline__ explicit StaticOrder(int grid,int block):vcu((block%8)*(grid/8)+block/8){}
  __device__ __forceinline__ bool next(int i,AttnUnit&u)const{ if(i>=4)return false; const int s=vcu&7; u.bh=vcu>>3; u.qb=(i==0)?s:(i==1)?15-s:(i==2)?16+s:31-s; return true; }
  __device__ __forceinline__ void a_ready(const AttnUnit&)const{}
  __device__ __forceinline__ void done(const AttnUnit&)const{}
};
template<class Sched,int THRL=8> __device__ __forceinline__ void attn_phase(char*lds,const AttnTensors&T,const Sched&S){
  AttnUnit u;
  for(int i=0;S.next(i,u);++i){ S.a_ready(u); const int b=u.bh/NHEAD,g=u.bh%NHEAD,hh=g>>2,mm=(g>>1)&1,vh=g&1;
    attn_unit<THRL>(b,0,u.qb,T.Q+(hh*2+mm)*64,T.K+(hh*2+mm)*64,T.V+(hh*2+vh)*64,T.O+g*64,lds); S.done(u); }
}
#undef SBAR
#undef WAIT_BAR
}


constexpr size_t WS_PART = 64 * MiB;
constexpr size_t WS_ACO = 144 * MiB;
constexpr size_t WS_FFN = 64 * MiB;
typedef __bf16 bf16x2v __attribute__((ext_vector_type(2)));
__device__ __forceinline__ float dot8_bf16(const u32x4& a, const u32x4& b) {
    float r = __uint_as_float(a.x << 16) * __uint_as_float(b.x << 16) + __uint_as_float(a.x & 0xffff0000u) * __uint_as_float(b.x & 0xffff0000u);
    r += __uint_as_float(a.y << 16) * __uint_as_float(b.y << 16) + __uint_as_float(a.y & 0xffff0000u) * __uint_as_float(b.y & 0xffff0000u);
    r += __uint_as_float(a.z << 16) * __uint_as_float(b.z << 16) + __uint_as_float(a.z & 0xffff0000u) * __uint_as_float(b.z & 0xffff0000u);
    r += __uint_as_float(a.w << 16) * __uint_as_float(b.w << 16) + __uint_as_float(a.w & 0xffff0000u) * __uint_as_float(b.w & 0xffff0000u);
    return r;
}
__device__ __forceinline__ void peer_sddmm(const Params& p, int bx, int wave, int lane) {
    const int x = bx & 7, j = bx >> 3, c = lane & 15, q = lane >> 4;
    const bf16_t* UT = (const bf16_t*)(p.ws + WS_UTB) + 128 * x + 8 * c;
    const bf16_t* XS = (const bf16_t*)(p.ws + WS_X1B) + 128 * x + 8 * c;
    const int* IDS = (const int*)(p.ws + WS_IDS);
    float* PART = (float*)(p.ws + WS_PART) + (size_t)x * M * 128;
    for (int tt = 0; tt < 64; ++tt) {
        const int t = 512 * j + 64 * wave + tt;
        const u32x4 xv = *(const u32x4*)(XS + (size_t)t * 1024);
        const int* idp = IDS + (size_t)t * 128 + 32 * q;
        float s[32];
#pragma unroll
        for (int g = 0; g < 8; ++g) {
            const int4 id4 = *(const int4*)(idp + 4 * g);
            const u32x4 u0 = *(const u32x4*)(UT + (size_t)id4.x * 1024), u1 = *(const u32x4*)(UT + (size_t)id4.y * 1024);
            const u32x4 u2 = *(const u32x4*)(UT + (size_t)id4.z * 1024), u3 = *(const u32x4*)(UT + (size_t)id4.w * 1024);
            s[4 * g + 0] = dot8_bf16(xv, u0); s[4 * g + 1] = dot8_bf16(xv, u1); s[4 * g + 2] = dot8_bf16(xv, u2); s[4 * g + 3] = dot8_bf16(xv, u3);
        }
        float r16[16], r8[8], r4[4], r2[2];
        { const bool up = (c & 8) != 0;
#pragma unroll
          for (int i = 0; i < 16; ++i) { const float snd = up ? s[i] : s[i + 16], kp = up ? s[i + 16] : s[i]; r16[i] = kp + __shfl_xor(snd, 8); } }
        { const bool up = (c & 4) != 0;
#pragma unroll
          for (int i = 0; i < 8; ++i) { const float snd = up ? r16[i] : r16[i + 8], kp = up ? r16[i + 8] : r16[i]; r8[i] = kp + __shfl_xor(snd, 4); } }
        { const bool up = (c & 2) != 0;
#pragma unroll
          for (int i = 0; i < 4; ++i) { const float snd = up ? r8[i] : r8[i + 4], kp = up ? r8[i + 4] : r8[i]; r4[i] = kp + __shfl_xor(snd, 2); } }
        { const bool up = (c & 1) != 0;
#pragma unroll
          for (int i = 0; i < 2; ++i) { const float snd = up ? r4[i] : r4[i + 2], kp = up ? r4[i + 2] : r4[i]; r2[i] = kp + __shfl_xor(snd, 1); } }
        *(float2*)(PART + (size_t)t * 128 + 2 * lane) = make_float2(r2[0], r2[1]);
    }
}
__device__ __forceinline__ void peer_act(const Params& p, size_t gt, size_t gs) {
    const f32x4* PART = (const f32x4*)(p.ws + WS_PART); const f32x4* G = (const f32x4*)(p.ws + WS_G); f32x4* A = (f32x4*)(p.ws + WS_ACO);
    const size_t n4 = (size_t)M * 128 / 4;
    for (size_t i = gt; i < n4; i += gs) {
        f32x4 h = PART[i];
#pragma unroll
        for (int x = 1; x < 8; ++x) h = h + PART[i + (size_t)x * n4];
        const f32x4 g = G[i];
        f32x4 a; a.x = gelu_exact(h.x) * g.x; a.y = gelu_exact(h.y) * g.y; a.z = gelu_exact(h.z) * g.z; a.w = gelu_exact(h.w) * g.w;
        A[i] = a;
    }
}
__device__ __forceinline__ void peer_spmm(const Params& p, int bx, int wave, int lane) {
    const int x = bx & 7, j = bx >> 3, c = lane & 15, q = lane >> 4;
    const bf16_t* VT = (const bf16_t*)(p.ws + WS_VTB) + 128 * x + 8 * c;
    const int* IDS = (const int*)(p.ws + WS_IDS); const float* A = (const float*)(p.ws + WS_ACO);
    float* FFN = (float*)(p.ws + WS_FFN) + 128 * x + 8 * c;
    for (int tt = 0; tt < 64; ++tt) {
        const int t = 512 * j + 64 * wave + tt;
        const int* idp = IDS + (size_t)t * 128 + 32 * q; const float* ap = A + (size_t)t * 128 + 32 * q;
        float acc[8];
#pragma unroll
        for (int i = 0; i < 8; ++i) acc[i] = 0.f;
#pragma unroll
        for (int g = 0; g < 8; ++g) {
            const int4 id4 = *(const int4*)(idp + 4 * g); const f32x4 a4 = *(const f32x4*)(ap + 4 * g);
            const u32x4 v0 = *(const u32x4*)(VT + (size_t)id4.x * 1024), v1 = *(const u32x4*)(VT + (size_t)id4.y * 1024);
            const u32x4 v2 = *(const u32x4*)(VT + (size_t)id4.z * 1024), v3 = *(const u32x4*)(VT + (size_t)id4.w * 1024);
#define PEER_ACC(v, a) do { acc[0] += (a) * __uint_as_float((v).x << 16); acc[1] += (a) * __uint_as_float((v).x & 0xffff0000u); acc[2] += (a) * __uint_as_float((v).y << 16); acc[3] += (a) * __uint_as_float((v).y & 0xffff0000u); \
            acc[4] += (a) * __uint_as_float((v).z << 16); acc[5] += (a) * __uint_as_float((v).z & 0xffff0000u); acc[6] += (a) * __uint_as_float((v).w << 16); acc[7] += (a) * __uint_as_float((v).w & 0xffff0000u); } while (0)
            PEER_ACC(v0, a4.x); PEER_ACC(v1, a4.y); PEER_ACC(v2, a4.z); PEER_ACC(v3, a4.w);
#undef PEER_ACC
        }
#pragma unroll
        for (int i = 0; i < 8; ++i) { acc[i] += __shfl_xor(acc[i], 16); acc[i] += __shfl_xor(acc[i], 32); }
        if (q == 0) { float* o = FFN + (size_t)t * 1024; *(f32x4*)o = (f32x4){acc[0], acc[1], acc[2], acc[3]}; *(f32x4*)(o + 4) = (f32x4){acc[4], acc[5], acc[6], acc[7]}; }
    }
}
__device__ __forceinline__ void stage_ln2(const Params& p, int gw, int ngw, int lane) {
    const float* FFN = (const float*)(p.ws + WS_FFN);
    for (int row = gw; row < M; row += ngw) {
        f32x4* xr = (f32x4*)(p.out + (size_t)row * 1024) + lane; const f32x4* fr = (const f32x4*)(FFN + (size_t)row * 1024) + lane;
        f32x4 v[4]; float s = 0.f;
#pragma unroll
        for (int jj = 0; jj < 4; ++jj) { v[jj] = ALPHA * xr[64 * jj] + fr[64 * jj]; s += (v[jj].x + v[jj].y) + (v[jj].z + v[jj].w); }
        const float mean = wave_sum(s) * (1.f / 1024.f); float s2 = 0.f;
#pragma unroll
        for (int jj = 0; jj < 4; ++jj) { v[jj] = v[jj] - mean; s2 += (v[jj].x * v[jj].x + v[jj].y * v[jj].y) + (v[jj].z * v[jj].z + v[jj].w * v[jj].w); }
        const float rstd = 1.f / sqrtf(wave_sum(s2) * (1.f / 1024.f) + LN_EPS);
#pragma unroll
        for (int jj = 0; jj < 4; ++jj) { const f32x4 g = ((const f32x4*)p.ln2_g)[lane + 64 * jj], bb = ((const f32x4*)p.ln2_b)[lane + 64 * jj];
            xr[64 * jj] = v[jj] * rstd * g + bb; }
    }
}

__device__ __forceinline__ void naive_peer_from_a(const Params& p, int gw, int ngw, int lane) {
    const bf16_t* VT = (const bf16_t*)(p.ws + WS_VTB);
    const int* IDS = (const int*)(p.ws + WS_IDS); const float* A = (const float*)(p.ws + WS_ACO);
    for (int row = gw; row < M; row += ngw) {
        f32x4* xr = (f32x4*)(p.out + (size_t)row * 1024) + lane;
        f32x4 xv[4], acc[4];
#pragma unroll
        for (int j = 0; j < 4; ++j) { xv[j] = xr[64 * j]; acc[j] = (f32x4){0.f, 0.f, 0.f, 0.f}; }
        for (int e = 0; e < 128; ++e) {
            const int id = IDS[(size_t)row * 128 + e]; const float a = A[(size_t)row * 128 + e];
            const u32x2* vr = (const u32x2*)(VT + (size_t)id * 1024) + lane;
#pragma unroll
            for (int j = 0; j < 4; ++j) { const u32x2 u = vr[64 * j];
                acc[j].x += a * bf2f(u.x & 0xffffu); acc[j].y += a * bf2f(u.x >> 16); acc[j].z += a * bf2f(u.y & 0xffffu); acc[j].w += a * bf2f(u.y >> 16); }
        }
        float s = 0.f;
#pragma unroll
        for (int j = 0; j < 4; ++j) { acc[j] = ALPHA * xv[j] + acc[j]; s += (acc[j].x + acc[j].y) + (acc[j].z + acc[j].w); }
        const float mean = wave_sum(s) * (1.f / 1024.f); float s2 = 0.f;
#pragma unroll
        for (int j = 0; j < 4; ++j) { acc[j] = acc[j] - mean; s2 += (acc[j].x * acc[j].x + acc[j].y * acc[j].y) + (acc[j].z * acc[j].z + acc[j].w * acc[j].w); }
        const float rstd = 1.f / sqrtf(wave_sum(s2) * (1.f / 1024.f) + LN_EPS);
#pragma unroll
        for (int j = 0; j < 4; ++j) { const f32x4 g = ((const f32x4*)p.ln2_g)[lane + 64 * j], bb = ((const f32x4*)p.ln2_b)[lane + 64 * j];
            xr[64 * j] = acc[j] * rstd * g + bb; }
    }
}

constexpr int NTHREADS = 512, NWAVES = 8;
constexpr int LDS_BYTES = 147456;

__global__ void __launch_bounds__(NTHREADS, 2) mega(Params p) {
    extern __shared__ __attribute__((aligned(16))) unsigned char lds[];
    cg::grid_group grid = cg::this_grid();
    typedef pg8::bf16_t pbf;
#define PHASE_IDS() int tid = threadIdx.x; asm volatile("" : "+v"(tid)); const int lane = tid & 63, wave = __builtin_amdgcn_readfirstlane(tid >> 6); \
    const int G = gridDim.x, bx = blockIdx.x; const size_t gt = (size_t)bx * NTHREADS + tid, gs = (size_t)G * NTHREADS; const int gw = bx * NWAVES + wave, ngw = G * NWAVES; \
    PG8_LAS unsigned char* ldsl = (PG8_LAS unsigned char*)lds; (void)lane; (void)gt; (void)gs; (void)gw; (void)ngw; (void)ldsl;

#if !defined(SKIP_P0)
    { PHASE_IDS()
    stage_transposes(p, (float*)(lds + wave * 8448), gw, ngw, lane);
    convert_bf16(p.x, (bf16_t*)(p.ws + WS_XB), (size_t)M * 1024, gt, gs);
    convert_bf16(p.mem, (bf16_t*)(p.ws + WS_MEMB), (size_t)512 * 1024, gt, gs);
    convert_bf16(p.sub_keys, (bf16_t*)(p.ws + WS_SUBK), (size_t)16 * 128 * 128, gt, gs);
    stage_rope(p, gt, gs);
    }
#endif
    grid.sync();
#if !defined(SKIP_P1)
    { PHASE_IDS()
#if defined(NAIVE_P1)
    { EpiProj e{p.ws};
      naive_gemm((const bf16_t*)(p.ws + WS_XB), 1024, (const bf16_t*)(p.ws + WS_WIN), 1024, M, INW, 1024, e, gw, ngw, lane);
      EpiPlain e2{(bf16_t*)(p.ws + WS_MEMKV), 1024};
      naive_gemm((const bf16_t*)(p.ws + WS_MEMB), 1024, (const bf16_t*)(p.ws + WS_WMEMKV), 1024, 512, 1024, 1024, e2, gw, ngw, lane); }
#else
    { pg8::Gemm g{(const pbf*)(p.ws + WS_XB), (const pbf*)(p.ws + WS_WIN), M, INW, 1024}; pg8::StaticOrder S; S.init(M, INW, G, bx);
      pg8::EpiProjF E{p.ws};
      pg8::gemm_phase<pg8::EpiProjF, pg8::StaticOrder, PG8_ALIGN, PG8_SP2>(ldsl, g, S, E);
      pg8::Gemm g2{(const pbf*)(p.ws + WS_MEMB), (const pbf*)(p.ws + WS_WMEMKV), 512, 1024, 1024}; pg8::MemOrder S2{bx};
      pg8::EpiBf16<0> E2{(pbf*)(p.ws + WS_MEMKV), 1024, nullptr, 0, 0, 1.f};
      pg8::gemm_phase<pg8::EpiBf16<0>, pg8::MemOrder, PG8_ALIGN, PG8_SP2>(ldsl, g2, S2, E2); }
#endif
    }
#endif
    grid.sync();
#if !defined(SKIP_P2)
    { PHASE_IDS()
    { const attn_body::AttnTensors AT{(const attn_body::bf16*)(p.ws + WS_DFQ), (const attn_body::bf16*)(p.ws + WS_DFK), (const attn_body::bf16*)(p.ws + WS_DFV), (attn_body::bf16*)(p.ws + WS_ODF16)};
      const attn_body::StaticOrder S(G, bx);
#if defined(NAIVE_DF)
      (void)AT; (void)S; naive_df_attn(p, gt, gs);
#else
      attn_body::attn_phase<attn_body::StaticOrder>((char*)lds, AT, S);
#endif
    }
    }
#endif
    grid.sync();
#if !defined(SKIP_P3)
    { PHASE_IDS()
    stage_df_combine(p, gw, ngw, lane);
    naive_sb_attn(p, gt, gs);
    naive_mx_attn(p, gt, gs);
    }
#endif
    grid.sync();
#if !defined(SKIP_P4)
    { PHASE_IDS()
#if defined(NAIVE_P4)
    { EpiGate e{(bf16_t*)(p.ws + WS_GATES), p.b_gate};
      naive_gemm((const bf16_t*)(p.ws + WS_XB), 1024, (const bf16_t*)(p.ws + WS_WGATE), 1024, M, 3072, 1024, e, gw, ngw, lane); }
    grid.sync();
    for (int b = 0; b < 3; ++b) {
        const size_t osrc = (b == 0) ? WS_OSB : (b == 1 ? WS_ODF : WS_OMX);
        EpiBranch e{(const bf16_t*)(p.ws + WS_GATES), b * 1024, p.out, (bf16_t*)(p.ws + WS_MERGEDB), b};
        naive_gemm((const bf16_t*)(p.ws + osrc), 512, (const bf16_t*)(p.ws + WS_WBR + (size_t)b * MiB), 512, M, 1024, 512, e, gw, ngw, lane);
    }
#else
    { pg8::StaticOrder S1; S1.init(M, 1024, G, bx); pg8::Unit base; const bool has = S1.next(0, base);
      if (has) {
#if defined(NAIVE_GATES)
        { EpiGate e{(bf16_t*)(p.ws + WS_GATES), p.b_gate};
          naive_gemm((const bf16_t*)(p.ws + WS_XB), 1024, (const bf16_t*)(p.ws + WS_WGATE), 1024, M, 3072, 1024, e, gw, ngw, lane); }
        grid.sync();
#else
        pg8::Gemm gg{(const pbf*)(p.ws + WS_XB), (const pbf*)(p.ws + WS_WGATE), M, 3072, 1024}; pg8::GateOrder SG{base};
        pg8::EpiGateF EG{(pbf*)(p.ws + WS_GATES), p.b_gate};
        pg8::gemm_phase<pg8::EpiGateF, pg8::GateOrder, PG8_ALIGN, PG8_SP2>(ldsl, gg, SG, EG);
#endif
#define P4_SEAM() do { asm volatile("s_waitcnt vmcnt(0)" ::: "memory"); __syncthreads(); if (tid < 64) { __builtin_amdgcn_fence(__ATOMIC_ACQUIRE, "agent"); asm volatile("s_waitcnt vmcnt(0)" ::: "memory"); } __syncthreads(); } while (0)
        P4_SEAM();
#if defined(NAIVE_BR)
    for (int b = 0; b < 3; ++b) {
        const size_t osrc = (b == 0) ? WS_OSB : (b == 1 ? WS_ODF : WS_OMX);
        EpiBranch e{(const bf16_t*)(p.ws + WS_GATES), b * 1024, p.out, (bf16_t*)(p.ws + WS_MERGEDB), b};
        naive_gemm((const bf16_t*)(p.ws + osrc), 512, (const bf16_t*)(p.ws + WS_WBR + (size_t)b * MiB), 512, M, 1024, 512, e, gw, ngw, lane);
    }
#else
        const pbf* GT_ = (const pbf*)(p.ws + WS_GATES); pbf* MB = (pbf*)(p.ws + WS_MERGEDB);
        { pg8::Gemm g{(const pbf*)(p.ws + WS_OSB), (const pbf*)(p.ws + WS_WBR), M, 1024, 512}; pg8::EpiBranchF<0> E{GT_, 0, p.out, MB};
          pg8::gemm_phase<pg8::EpiBranchF<0>, pg8::StaticOrder, PG8_ALIGN, PG8_SP2>(ldsl, g, S1, E); }
        P4_SEAM();
        { pg8::Gemm g{(const pbf*)(p.ws + WS_ODF), (const pbf*)(p.ws + WS_WBR + 1 * MiB), M, 1024, 512}; pg8::EpiBranchF<1> E{GT_, 1024, p.out, MB};
          pg8::gemm_phase<pg8::EpiBranchF<1>, pg8::StaticOrder, PG8_ALIGN, PG8_SP2>(ldsl, g, S1, E); }
        P4_SEAM();
        { pg8::Gemm g{(const pbf*)(p.ws + WS_OMX), (const pbf*)(p.ws + WS_WBR + 2 * MiB), M, 1024, 512}; pg8::EpiBranchF<2> E{GT_, 2048, p.out, MB};
          pg8::gemm_phase<pg8::EpiBranchF<2>, pg8::StaticOrder, PG8_ALIGN, PG8_SP2>(ldsl, g, S1, E); }
#endif
      } }
#endif
    }
#endif
    grid.sync();
#if !defined(SKIP_P5)
    { PHASE_IDS()
#if defined(NAIVE_P5)
    { EpiOut e{p.x, p.out};
      naive_gemm((const bf16_t*)(p.ws + WS_MERGEDB), 1024, (const bf16_t*)(p.ws + WS_WOUT), 1024, M, 1024, 1024, e, gw, ngw, lane); }
#else
    { pg8::Gemm g{(const pbf*)(p.ws + WS_MERGEDB), (const pbf*)(p.ws + WS_WOUT), M, 1024, 1024}; pg8::StaticOrder S; S.init(M, 1024, G, bx);
      pg8::EpiOutF E{p.x, p.out};
      pg8::gemm_phase<pg8::EpiOutF, pg8::StaticOrder, PG8_ALIGN, PG8_SP2>(ldsl, g, S, E); }
#endif
    }
#endif
    grid.sync();
#if !defined(SKIP_P6)
    { PHASE_IDS()
    stage_ln1(p, gw, ngw, lane);
    convert_bf16(p.u_tab, (bf16_t*)(p.ws + WS_UTB), (size_t)NEXP * 1024, gt, gs);
    convert_bf16(p.v_tab, (bf16_t*)(p.ws + WS_VTB), (size_t)NEXP * 1024, gt, gs);
    }
#endif
    grid.sync();
#if !defined(SKIP_P7)
    { PHASE_IDS()
#if defined(NAIVE_P7)
    { EpiPlain e{(bf16_t*)(p.ws + WS_QP), 2048};
      naive_gemm((const bf16_t*)(p.ws + WS_X1B), 1024, (const bf16_t*)(p.ws + WS_WQUERY), 1024, M, 2048, 1024, e, gw, ngw, lane); }
#else
    { pg8::Gemm g{(const pbf*)(p.ws + WS_X1B), (const pbf*)(p.ws + WS_WQUERY), M, 2048, 1024}; pg8::StaticOrder S; S.init(M, 2048, G, bx);
      pg8::EpiBf16<0> E{(pbf*)(p.ws + WS_QP), 2048, nullptr, 0, 0, 1.f};
      pg8::gemm_phase<pg8::EpiBf16<0>, pg8::StaticOrder, PG8_ALIGN, PG8_SP2>(ldsl, g, S, E); }
#endif
    }
#endif
    grid.sync();
#if !defined(SKIP_P8)
    { PHASE_IDS()
    naive_routing(p, gt, gs);
    }
#endif
    grid.sync();
#if !defined(SKIP_P9)
    { PHASE_IDS()
#if defined(NAIVE_PEER)
    naive_peer(p, gw, ngw, lane);
#else
    if (G == 256) {
        peer_sddmm(p, bx, wave, lane);
        grid.sync();
        peer_act(p, gt, gs);
        grid.sync();
#if defined(DBG_SPMM_NAIVE)
        naive_peer_from_a(p, gw, ngw, lane);
#else
        peer_spmm(p, bx, wave, lane);
        grid.sync();
        stage_ln2(p, gw, ngw, lane);
#endif
    } else naive_peer(p, gw, ngw, lane);
#endif
    }
#endif
}

extern "C" void kernel_launch(void* const* d_in, const int* in_sizes, int n_in, void* d_out, int out_size, void* d_ws, size_t ws_size, hipStream_t stream) {
    static int grid_blocks = 0;
    if (!grid_blocks) {
        int dev = 0, cus = 0, per_cu = 0;
        hipGetDevice(&dev);
        hipDeviceGetAttribute(&cus, hipDeviceAttributeMultiprocessorCount, dev);
        hipFuncSetAttribute((const void*)mega, hipFuncAttributeMaxDynamicSharedMemorySize, LDS_BYTES);
        hipOccupancyMaxActiveBlocksPerMultiprocessor(&per_cu, (const void*)mega, NTHREADS, LDS_BYTES);
        if (per_cu < 1) per_cu = 1;
        grid_blocks = cus * per_cu;
    }
    Params p{};
    p.x = (const float*)d_in[0]; p.mem = (const float*)d_in[1]; p.pos = (const int*)d_in[2];
    p.w_in = (const float*)d_in[3]; p.w_memkv = (const float*)d_in[4]; p.df_lambda = (const float*)d_in[5]; p.df_norm_g = (const float*)d_in[6];
    p.w_gate = (const float*)d_in[7]; p.b_gate = (const float*)d_in[8]; p.w_br_sb = (const float*)d_in[9]; p.w_br_df = (const float*)d_in[10]; p.w_br_mx = (const float*)d_in[11];
    p.w_out = (const float*)d_in[12]; p.ln1_g = (const float*)d_in[13]; p.ln1_b = (const float*)d_in[14]; p.w_query = (const float*)d_in[15]; p.sub_keys = (const float*)d_in[16];
    p.u_tab = (const float*)d_in[17]; p.v_tab = (const float*)d_in[18]; p.ln2_g = (const float*)d_in[19]; p.ln2_b = (const float*)d_in[20];
    p.out = (float*)d_out; p.ws = (unsigned char*)d_ws;
    void* args[] = {&p};
    hipError_t e = hipLaunchCooperativeKernel((const void*)mega, dim3(grid_blocks), dim3(NTHREADS), args, LDS_BYTES, stream);
    if (e != hipSuccess) fprintf(stderr, "cooperative launch failed: %s (grid %d)\n", hipGetErrorString(e), grid_blocks);
}
```

```cpp
#include <hip/hip_runtime.h>
#include <cstdint>
#include <cstdio>
#include <hip/hip_cooperative_groups.h>
namespace cg = cooperative_groups;

typedef unsigned short bf16_t;
typedef short bf16x8 __attribute__((ext_vector_type(8)));
typedef float f32x16 __attribute__((ext_vector_type(16)));
typedef float f32x4 __attribute__((ext_vector_type(4)));
typedef unsigned u32x4 __attribute__((ext_vector_type(4)));
typedef unsigned u32x2 __attribute__((ext_vector_type(2)));

constexpr int BATCH = 2, SEQ = 8192, DM = 1024, M = BATCH * SEQ;
constexpr int MEMLEN = 256;
constexpr int INW = 3584;
constexpr int NEXP = 16384;
constexpr float LOG2E = 1.4426950408889634f;
constexpr float C2_64 = 0.125f * LOG2E;
constexpr float C2_128 = 0.08838834764831845f * LOG2E;
constexpr float ALPHA = 1.189207115002721f;
constexpr float LN_EPS = 1e-5f, RMS_EPS = 1e-5f;
constexpr float LAMBDA_INIT = 0.2f;

constexpr size_t MiB = 1u << 20;
constexpr size_t WS_CTL = 0;
constexpr size_t WS_ROPE = 1 * MiB;
constexpr size_t WS_WIN = 2 * MiB;
constexpr size_t WS_WGATE = 9 * MiB;
constexpr size_t WS_WMEMKV = 15 * MiB;
constexpr size_t WS_WBR = 17 * MiB;
constexpr size_t WS_WOUT = 20 * MiB;
constexpr size_t WS_WQUERY = 22 * MiB;
constexpr size_t WS_SUBK = 26 * MiB;
constexpr size_t WS_MEMB = 27 * MiB;
constexpr size_t WS_MEMKV = 28 * MiB;
constexpr size_t WS_XB = 32 * MiB;
constexpr size_t WS_SBQ = 64 * MiB, WS_SBK = 80 * MiB, WS_SBV = 96 * MiB;
constexpr size_t WS_DFQ = 112 * MiB, WS_DFK = 128 * MiB, WS_DFV = 144 * MiB, WS_MXQ = 160 * MiB;
constexpr size_t WS_ODF16 = 176 * MiB;
constexpr size_t WS_OSB = 208 * MiB, WS_ODF = 224 * MiB, WS_OMX = 240 * MiB;
constexpr size_t WS_GATES = 64 * MiB;
constexpr size_t WS_MERGEDB = 160 * MiB;
constexpr size_t WS_X1B = 32 * MiB;
constexpr size_t WS_QP = 64 * MiB;
constexpr size_t WS_IDS = 128 * MiB;
constexpr size_t WS_G = 136 * MiB;
constexpr size_t WS_UTB = 160 * MiB;
constexpr size_t WS_VTB = 192 * MiB;

struct Params {
    const float *x, *mem; const int* pos;
    const float *w_in, *w_memkv, *df_lambda, *df_norm_g, *w_gate, *b_gate, *w_br_sb, *w_br_df, *w_br_mx, *w_out;
    const float *ln1_g, *ln1_b, *w_query, *sub_keys, *u_tab, *v_tab, *ln2_g, *ln2_b;
    float* out; unsigned char* ws;
};

__device__ __forceinline__ float bf2f(unsigned v) { return __uint_as_float(v << 16); }
__device__ __forceinline__ unsigned f2bf(float f) { unsigned u = __float_as_uint(f); return (u + 0x7fffu + ((u >> 16) & 1u)) >> 16; }
__device__ __forceinline__ unsigned pk2(float lo, float hi) { return f2bf(lo) | (f2bf(hi) << 16); }
__device__ __forceinline__ float wave_sum(float v) {
#pragma unroll
    for (int o = 1; o < 64; o <<= 1) v += __shfl_xor(v, o);
    return v;
}
__device__ __forceinline__ float gelu_exact(float v) { return 0.5f * v * (1.0f + erff(v * 0.70710678118654752f)); }

__device__ __forceinline__ void transpose_item(const float* W, int K, int N, bf16_t* WT, float* scr, int item, int lane) {
    const int nblk = N / 32, kb = item / nblk, nb = item % nblk, k0 = 64 * kb, n0 = 32 * nb;
#pragma unroll 8
    for (int i = 0; i < 32; ++i) { const int kk = 2 * i + (lane >> 5); scr[kk * 33 + (lane & 31)] = W[(size_t)(k0 + kk) * N + n0 + (lane & 31)]; }
    asm volatile("s_waitcnt lgkmcnt(0)" ::: "memory");
    const int c = lane & 7;
#pragma unroll
    for (int j = 0; j < 4; ++j) { const int n = (lane >> 3) + 8 * j; const float* s = scr + (8 * c) * 33 + n;
        u32x4 o; o.x = pk2(s[0 * 33], s[1 * 33]); o.y = pk2(s[2 * 33], s[3 * 33]); o.z = pk2(s[4 * 33], s[5 * 33]); o.w = pk2(s[6 * 33], s[7 * 33]);
        *(u32x4*)(WT + (size_t)(n0 + n) * K + k0 + 8 * c) = o; }
    asm volatile("s_waitcnt lgkmcnt(0)" ::: "memory");
}
__device__ __forceinline__ void stage_transposes(const Params& p, float* scr, int gw, int ngw, int lane) {
    struct TJ { const float* W; int K, N; size_t off; };
    const TJ jobs[8] = {
        {p.w_in, 1024, 3584, WS_WIN}, {p.w_gate, 1024, 3072, WS_WGATE}, {p.w_memkv, 1024, 1024, WS_WMEMKV},
        {p.w_br_sb, 512, 1024, WS_WBR}, {p.w_br_df, 512, 1024, WS_WBR + 1 * MiB}, {p.w_br_mx, 512, 1024, WS_WBR + 2 * MiB},
        {p.w_out, 1024, 1024, WS_WOUT}, {p.w_query, 1024, 2048, WS_WQUERY}};
    int base = 0;
#pragma unroll
    for (int j = 0; j < 8; ++j) {
        const int items = (jobs[j].K / 64) * (jobs[j].N / 32);
        int first = ((gw - base) % ngw + ngw) % ngw;
        for (int it = first; it < items; it += ngw) transpose_item(jobs[j].W, jobs[j].K, jobs[j].N, (bf16_t*)(p.ws + jobs[j].off), scr, it, lane);
        base += items;
    }
}
__device__ __forceinline__ void convert_bf16(const float* src, bf16_t* dst, size_t n, size_t gtid, size_t gsize) {
    const size_t n4 = n / 4;
    for (size_t i = gtid; i < n4; i += gsize) { const f32x4 v = ((const f32x4*)src)[i]; u32x2 o; o.x = pk2(v.x, v.y); o.y = pk2(v.z, v.w); ((u32x2*)dst)[i] = o; }
}
__device__ __forceinline__ void stage_rope(const Params& p, size_t gtid, size_t gsize) {
    const double inv[8] = {1.0, 0.19392274474868576, 0.03760603093086393, 0.007292664737217109, 0.001414213562373095, 0.0002742481756762073, 5.318295896944988e-05, 1.031338537721246e-05};
    float2* tab = (float2*)(p.ws + WS_ROPE);
    for (size_t i = gtid; i < (size_t)M * 8; i += gsize) {
        const int row = (int)(i >> 3), j = (int)(i & 7);
        double iv = inv[0];
#pragma unroll
        for (int q = 1; q < 8; ++q) iv = (j == q) ? inv[q] : iv;
        const double a = (double)p.pos[row] * iv;
        double rev = a * 0.15915494309189535;
        rev -= floor(rev);
        const float rf = (float)rev;
        tab[i] = make_float2(__builtin_amdgcn_cosf(rf), __builtin_amdgcn_sinf(rf));
    }
}

template <class Epi>
__device__ __forceinline__ void naive_gemm(const bf16_t* A, int lda, const bf16_t* Bt, int ldb, int Mr, int N, int K, const Epi& epi, int gw, int ngw, int lane) {
    const int r = lane & 31, h = lane >> 5;
    const int tnc = N / 32, ntiles = (Mr / 32) * tnc;
    for (int t = gw; t < ntiles; t += ngw) {
        const int tm = t / tnc, tn = t % tnc;
        const bf16_t* ap = A + (size_t)(tm * 32 + r) * lda + 8 * h;
        const bf16_t* bp = Bt + (size_t)(tn * 32 + r) * ldb + 8 * h;
        f32x16 acc;
#pragma unroll
        for (int i = 0; i < 16; ++i) acc[i] = 0.f;
        for (int k = 0; k < K; k += 16) {
            const bf16x8 a = *(const bf16x8*)(ap + k); const bf16x8 b = *(const bf16x8*)(bp + k);
            acc = __builtin_amdgcn_mfma_f32_32x32x16_bf16(a, b, acc, 0, 0, 0);
        }
        epi(acc, tm * 32, tn * 32, r, h);
    }
}
#define ACC_ROW(row0, i, h) ((row0) + ((i) & 3) + 8 * ((i) >> 2) + 4 * (h))

struct EpiProj {
    unsigned char* ws;
    __device__ __forceinline__ void operator()(const f32x16& acc, int row0, int col0, int r, int h) const {
        const int region = col0 >> 9;
        const int cc = (col0 & 511) + r;
        const size_t offs[7] = {WS_SBQ, WS_SBK, WS_SBV, WS_DFQ, WS_DFK, WS_DFV, WS_MXQ};
        size_t off = offs[0];
#pragma unroll
        for (int q = 1; q < 7; ++q) off = (region == q) ? offs[q] : off;
        bf16_t* dst = (bf16_t*)(ws + off);
        const float2* rope = (const float2*)(ws + WS_ROPE);
        const float scale = (region == 0 || region == 3) ? C2_64 : (region == 6 ? C2_128 : 1.0f);
        const bool rot = (region == 3 || region == 4);
        const int d = cc & 63;
#pragma unroll
        for (int i = 0; i < 16; ++i) {
            const int row = ACC_ROW(row0, i, h);
            float v = acc[i];
            const float partner = __shfl_xor(v, 8);
            if (rot && d < 16) {
                const float2 cs = rope[(size_t)row * 8 + (d & 7)];
                v = (d < 8) ? (v * cs.x - partner * cs.y) : (v * cs.x + partner * cs.y);
            }
            dst[(size_t)row * 512 + cc] = (bf16_t)f2bf(v * scale);
        }
    }
};
struct EpiPlain {
    bf16_t* dst; int ldc;
    __device__ __forceinline__ void operator()(const f32x16& acc, int row0, int col0, int r, int h) const {
#pragma unroll
        for (int i = 0; i < 16; ++i) dst[(size_t)ACC_ROW(row0, i, h) * ldc + col0 + r] = (bf16_t)f2bf(acc[i]);
    }
};
struct EpiGate {
    bf16_t* dst; const float* bias;
    __device__ __forceinline__ void operator()(const f32x16& acc, int row0, int col0, int r, int h) const {
        const float b = bias[col0 + r];
#pragma unroll
        for (int i = 0; i < 16; ++i) { const float z = acc[i] + b; dst[(size_t)ACC_ROW(row0, i, h) * 3072 + col0 + r] = (bf16_t)f2bf(1.0f / (1.0f + __expf(-z))); }
    }
};
struct EpiBranch {
    const bf16_t* gates; int gcol; float* m32; bf16_t* mb; int mode;
    __device__ __forceinline__ void operator()(const f32x16& acc, int row0, int col0, int r, int h) const {
#pragma unroll
        for (int i = 0; i < 16; ++i) { const size_t row = ACC_ROW(row0, i, h); const int c = col0 + r;
            const float g = bf2f(gates[row * 3072 + gcol + c]); float v = g * acc[i];
            if (mode > 0) v += m32[row * 1024 + c];
            if (mode < 2) m32[row * 1024 + c] = v; else mb[row * 1024 + c] = (bf16_t)f2bf(v); }
    }
};
struct EpiOut {
    const float* x; float* y;
    __device__ __forceinline__ void operator()(const f32x16& acc, int row0, int col0, int r, int h) const {
#pragma unroll
        for (int i = 0; i < 16; ++i) { const size_t o = (size_t)ACC_ROW(row0, i, h) * 1024 + col0 + r; y[o] = ALPHA * x[o] + acc[i]; }
    }
};

__device__ __forceinline__ void naive_df_attn(const Params& p, size_t gtid, size_t gsize) {
    const bf16_t* Q = (const bf16_t*)(p.ws + WS_DFQ); const bf16_t* Kb = (const bf16_t*)(p.ws + WS_DFK); const bf16_t* Vb = (const bf16_t*)(p.ws + WS_DFV);
    bf16_t* O = (bf16_t*)(p.ws + WS_ODF16);
    for (size_t idx = gtid; idx < (size_t)16 * M; idx += gsize) {
        const int t = (int)(idx % SEQ); const int bg = (int)(idx / SEQ); const int g = bg % 16, b = bg / 16;
        const int hh = g >> 2, mm = (g >> 1) & 1, vh = g & 1;
        const int qcol = (hh * 2 + mm) * 64, vcol = (hh * 2 + vh) * 64;
        const size_t row = (size_t)b * SEQ + t;
        float q[64], o[64];
#pragma unroll
        for (int d = 0; d < 64; ++d) { q[d] = bf2f(Q[row * 512 + qcol + d]); o[d] = 0.f; }
        float mx = -1e30f, l = 0.f;
        const int tmax = __shfl(t, 63);
        for (int s = 0; s <= tmax; ++s) {
            const bf16_t* kr = Kb + ((size_t)b * SEQ + s) * 512 + qcol;
            float y = 0.f;
#pragma unroll
            for (int d8 = 0; d8 < 8; ++d8) { const u32x4 kk = *(const u32x4*)(kr + d8 * 8);
                y += q[d8 * 8 + 0] * bf2f(kk.x & 0xffffu) + q[d8 * 8 + 1] * bf2f(kk.x >> 16) + q[d8 * 8 + 2] * bf2f(kk.y & 0xffffu) + q[d8 * 8 + 3] * bf2f(kk.y >> 16)
                   + q[d8 * 8 + 4] * bf2f(kk.z & 0xffffu) + q[d8 * 8 + 5] * bf2f(kk.z >> 16) + q[d8 * 8 + 6] * bf2f(kk.w & 0xffffu) + q[d8 * 8 + 7] * bf2f(kk.w >> 16); }
            if (s > t) y = -INFINITY;
            const float mn = fmaxf(mx, y), al = exp2f(mx - mn), pp = exp2f(y - mn);
            mx = mn; l = l * al + pp;
            const bf16_t* vr = Vb + ((size_t)b * SEQ + s) * 512 + vcol;
#pragma unroll
            for (int d8 = 0; d8 < 8; ++d8) { const u32x4 vv = *(const u32x4*)(vr + d8 * 8);
                o[d8 * 8 + 0] = o[d8 * 8 + 0] * al + pp * bf2f(vv.x & 0xffffu); o[d8 * 8 + 1] = o[d8 * 8 + 1] * al + pp * bf2f(vv.x >> 16);
                o[d8 * 8 + 2] = o[d8 * 8 + 2] * al + pp * bf2f(vv.y & 0xffffu); o[d8 * 8 + 3] = o[d8 * 8 + 3] * al + pp * bf2f(vv.y >> 16);
                o[d8 * 8 + 4] = o[d8 * 8 + 4] * al + pp * bf2f(vv.z & 0xffffu); o[d8 * 8 + 5] = o[d8 * 8 + 5] * al + pp * bf2f(vv.z >> 16);
                o[d8 * 8 + 6] = o[d8 * 8 + 6] * al + pp * bf2f(vv.w & 0xffffu); o[d8 * 8 + 7] = o[d8 * 8 + 7] * al + pp * bf2f(vv.w >> 16); }
        }
        const float rl = 1.0f / l;
#pragma unroll
        for (int d = 0; d < 64; d += 2) *(unsigned*)(O + row * 1024 + g * 64 + d) = pk2(o[d] * rl, o[d + 1] * rl);
    }
}
constexpr float SB_EXIT_BITS = 48.0f;
__device__ __forceinline__ void naive_sb_attn(const Params& p, size_t gtid, size_t gsize) {
    const bf16_t* Q = (const bf16_t*)(p.ws + WS_SBQ); const bf16_t* Kb = (const bf16_t*)(p.ws + WS_SBK); const bf16_t* Vb = (const bf16_t*)(p.ws + WS_SBV);
    bf16_t* O = (bf16_t*)(p.ws + WS_OSB);
    for (size_t idx = gtid; idx < (size_t)8 * M; idx += gsize) {
        const int t = (int)(idx % SEQ); const int bh = (int)(idx / SEQ); const int hh = bh % 8, b = bh / 8;
        const int col = hh * 64;
        const size_t row = (size_t)b * SEQ + t;
        float q[64], o[64];
#pragma unroll
        for (int d = 0; d < 64; ++d) { q[d] = bf2f(Q[row * 512 + col + d]); o[d] = 0.f; }
        float R = 0.f;
        const int tmax = __shfl(t, 63);
        for (int s = tmax - 1; s >= 0; --s) {
            const bf16_t* kr = Kb + ((size_t)b * SEQ + s) * 512 + col;
            float y = 0.f;
#pragma unroll
            for (int d8 = 0; d8 < 8; ++d8) { const u32x4 kk = *(const u32x4*)(kr + d8 * 8);
                y += q[d8 * 8 + 0] * bf2f(kk.x & 0xffffu) + q[d8 * 8 + 1] * bf2f(kk.x >> 16) + q[d8 * 8 + 2] * bf2f(kk.y & 0xffffu) + q[d8 * 8 + 3] * bf2f(kk.y >> 16)
                   + q[d8 * 8 + 4] * bf2f(kk.z & 0xffffu) + q[d8 * 8 + 5] * bf2f(kk.z >> 16) + q[d8 * 8 + 6] * bf2f(kk.w & 0xffffu) + q[d8 * 8 + 7] * bf2f(kk.w >> 16); }
            const bool act = s < t;
            const float sp = fmaxf(y, 0.f) + log2f(1.0f + exp2f(-fabsf(y)));
            float a = 0.f;
            if (act) { R += sp; a = exp2f(y - R); }
            const bf16_t* vr = Vb + ((size_t)b * SEQ + s) * 512 + col;
#pragma unroll
            for (int d8 = 0; d8 < 8; ++d8) { const u32x4 vv = *(const u32x4*)(vr + d8 * 8);
                o[d8 * 8 + 0] += a * bf2f(vv.x & 0xffffu); o[d8 * 8 + 1] += a * bf2f(vv.x >> 16);
                o[d8 * 8 + 2] += a * bf2f(vv.y & 0xffffu); o[d8 * 8 + 3] += a * bf2f(vv.y >> 16);
                o[d8 * 8 + 4] += a * bf2f(vv.z & 0xffffu); o[d8 * 8 + 5] += a * bf2f(vv.z >> 16);
                o[d8 * 8 + 6] += a * bf2f(vv.w & 0xffffu); o[d8 * 8 + 7] += a * bf2f(vv.w >> 16); }
            if (__all(R > SB_EXIT_BITS)) break;
        }
#pragma unroll
        for (int d = 0; d < 64; d += 2) *(unsigned*)(O + row * 512 + col + d) = pk2(o[d], o[d + 1]);
    }
}
__device__ __forceinline__ void naive_mx_attn(const Params& p, size_t gtid, size_t gsize) {
    const bf16_t* Q = (const bf16_t*)(p.ws + WS_MXQ); const bf16_t* KV = (const bf16_t*)(p.ws + WS_MEMKV);
    bf16_t* O = (bf16_t*)(p.ws + WS_OMX);
    for (size_t idx = gtid; idx < (size_t)8 * M; idx += gsize) {
        const int t = (int)(idx % SEQ); const int bq = (int)(idx / SEQ); const int vh = bq & 1, hh = (bq >> 1) & 3, b = bq >> 3;
        const size_t row = (size_t)b * SEQ + t;
        unsigned qp[64]; float o[64];
#pragma unroll
        for (int d = 0; d < 64; ++d) { qp[d] = *(const unsigned*)(Q + row * 512 + hh * 128 + 2 * d); o[d] = 0.f; }
        float mx = -1e30f, l = 0.f;
        for (int m = 0; m < MEMLEN; ++m) {
            const bf16_t* kr = KV + ((size_t)b * MEMLEN + m) * 1024 + hh * 128;
            float y = 0.f;
#pragma unroll
            for (int d8 = 0; d8 < 16; ++d8) { const u32x4 kk = *(const u32x4*)(kr + d8 * 8);
                y += bf2f(qp[d8 * 4 + 0] & 0xffffu) * bf2f(kk.x & 0xffffu) + bf2f(qp[d8 * 4 + 0] >> 16) * bf2f(kk.x >> 16)
                   + bf2f(qp[d8 * 4 + 1] & 0xffffu) * bf2f(kk.y & 0xffffu) + bf2f(qp[d8 * 4 + 1] >> 16) * bf2f(kk.y >> 16)
                   + bf2f(qp[d8 * 4 + 2] & 0xffffu) * bf2f(kk.z & 0xffffu) + bf2f(qp[d8 * 4 + 2] >> 16) * bf2f(kk.z >> 16)
                   + bf2f(qp[d8 * 4 + 3] & 0xffffu) * bf2f(kk.w & 0xffffu) + bf2f(qp[d8 * 4 + 3] >> 16) * bf2f(kk.w >> 16); }
            const float mn = fmaxf(mx, y), al = exp2f(mx - mn), pp = exp2f(y - mn);
            mx = mn; l = l * al + pp;
            const bf16_t* vr = KV + ((size_t)b * MEMLEN + m) * 1024 + 512 + hh * 128 + vh * 64;
#pragma unroll
            for (int d8 = 0; d8 < 8; ++d8) { const u32x4 vv = *(const u32x4*)(vr + d8 * 8);
                o[d8 * 8 + 0] = o[d8 * 8 + 0] * al + pp * bf2f(vv.x & 0xffffu); o[d8 * 8 + 1] = o[d8 * 8 + 1] * al + pp * bf2f(vv.x >> 16);
                o[d8 * 8 + 2] = o[d8 * 8 + 2] * al + pp * bf2f(vv.y & 0xffffu); o[d8 * 8 + 3] = o[d8 * 8 + 3] * al + pp * bf2f(vv.y >> 16);
                o[d8 * 8 + 4] = o[d8 * 8 + 4] * al + pp * bf2f(vv.z & 0xffffu); o[d8 * 8 + 5] = o[d8 * 8 + 5] * al + pp * bf2f(vv.z >> 16);
                o[d8 * 8 + 6] = o[d8 * 8 + 6] * al + pp * bf2f(vv.w & 0xffffu); o[d8 * 8 + 7] = o[d8 * 8 + 7] * al + pp * bf2f(vv.w >> 16); }
        }
        const float rl = 1.0f / l;
#pragma unroll
        for (int d = 0; d < 64; d += 2) *(unsigned*)(O + row * 512 + hh * 128 + vh * 64 + d) = pk2(o[d] * rl, o[d + 1] * rl);
    }
}
__device__ __forceinline__ void stage_df_combine(const Params& p, int gw, int ngw, int lane) {
    const bf16_t* O16 = (const bf16_t*)(p.ws + WS_ODF16); bf16_t* O = (bf16_t*)(p.ws + WS_ODF);
    const float s01 = wave_sum(p.df_lambda[lane] * p.df_lambda[64 + lane]), s23 = wave_sum(p.df_lambda[128 + lane] * p.df_lambda[192 + lane]);
    const float lam = __expf(s01) - __expf(s23) + LAMBDA_INIT;
    const int hh = lane >> 4, dv = (lane & 15) * 8, vh = dv >> 6, d = dv & 63;
    float gn[8];
#pragma unroll
    for (int j = 0; j < 8; ++j) gn[j] = p.df_norm_g[dv + j] * (1.0f - LAMBDA_INIT);
    for (int row = gw; row < M; row += ngw) {
        const u32x4 a = *(const u32x4*)(O16 + (size_t)row * 1024 + (hh * 4 + vh) * 64 + d);
        const u32x4 b = *(const u32x4*)(O16 + (size_t)row * 1024 + (hh * 4 + 2 + vh) * 64 + d);
        float v[8];
        v[0] = bf2f(a.x & 0xffffu) - lam * bf2f(b.x & 0xffffu); v[1] = bf2f(a.x >> 16) - lam * bf2f(b.x >> 16);
        v[2] = bf2f(a.y & 0xffffu) - lam * bf2f(b.y & 0xffffu); v[3] = bf2f(a.y >> 16) - lam * bf2f(b.y >> 16);
        v[4] = bf2f(a.z & 0xffffu) - lam * bf2f(b.z & 0xffffu); v[5] = bf2f(a.z >> 16) - lam * bf2f(b.z >> 16);
        v[6] = bf2f(a.w & 0xffffu) - lam * bf2f(b.w & 0xffffu); v[7] = bf2f(a.w >> 16) - lam * bf2f(b.w >> 16);
        float ss = 0.f;
#pragma unroll
        for (int j = 0; j < 8; ++j) ss += v[j] * v[j];
        ss += __shfl_xor(ss, 1); ss += __shfl_xor(ss, 2); ss += __shfl_xor(ss, 4); ss += __shfl_xor(ss, 8);
        const float rs = 1.0f / sqrtf(ss * (1.0f / 128.0f) + RMS_EPS);
        u32x4 o; o.x = pk2(v[0] * rs * gn[0], v[1] * rs * gn[1]); o.y = pk2(v[2] * rs * gn[2], v[3] * rs * gn[3]);
        o.z = pk2(v[4] * rs * gn[4], v[5] * rs * gn[5]); o.w = pk2(v[6] * rs * gn[6], v[7] * rs * gn[7]);
        *(u32x4*)(O + (size_t)row * 512 + hh * 128 + dv) = o;
    }
}
__device__ __forceinline__ void stage_ln1(const Params& p, int gw, int ngw, int lane) {
    bf16_t* X1B = (bf16_t*)(p.ws + WS_X1B);
    for (int row = gw; row < M; row += ngw) {
        f32x4* yr = (f32x4*)(p.out + (size_t)row * 1024) + lane;
        f32x4 v[4]; float s = 0.f;
#pragma unroll
        for (int j = 0; j < 4; ++j) { v[j] = yr[64 * j]; s += (v[j].x + v[j].y) + (v[j].z + v[j].w); }
        const float mean = wave_sum(s) * (1.f / 1024.f); float s2 = 0.f;
#pragma unroll
        for (int j = 0; j < 4; ++j) { v[j] = v[j] - mean; s2 += (v[j].x * v[j].x + v[j].y * v[j].y) + (v[j].z * v[j].z + v[j].w * v[j].w); }
        const float rstd = 1.f / sqrtf(wave_sum(s2) * (1.f / 1024.f) + LN_EPS);
#pragma unroll
        for (int j = 0; j < 4; ++j) { const f32x4 g = ((const f32x4*)p.ln1_g)[lane + 64 * j], bb = ((const f32x4*)p.ln1_b)[lane + 64 * j];
            const f32x4 o = v[j] * rstd * g + bb; yr[64 * j] = o;
            u32x2 w; w.x = pk2(o.x, o.y); w.y = pk2(o.z, o.w); ((u32x2*)(X1B + (size_t)row * 1024))[lane + 64 * j] = w; }
    }
}
#define TOPK_INSERT(tv, ti, val, id) do { float v_ = (val); int vi_ = (id); \
    _Pragma("unroll") for (int j_ = 0; j_ < 16; ++j_) { const bool gt_ = v_ > tv[j_]; const float t1_ = gt_ ? tv[j_] : v_; const int t2_ = gt_ ? ti[j_] : vi_; \
        tv[j_] = gt_ ? v_ : tv[j_]; ti[j_] = gt_ ? vi_ : ti[j_]; v_ = t1_; vi_ = t2_; } } while (0)
__device__ __forceinline__ void naive_routing(const Params& p, size_t gtid, size_t gsize) {
    const bf16_t* QP = (const bf16_t*)(p.ws + WS_QP); const bf16_t* SK = (const bf16_t*)(p.ws + WS_SUBK);
    int* IDS = (int*)(p.ws + WS_IDS); float* G = (float*)(p.ws + WS_G);
    for (size_t idx = gtid; idx < (size_t)8 * M; idx += gsize) {
        const int row = (int)(idx % M), hh = (int)(idx / M);
        float tv0[16], tv1[16]; int ti0[16], ti1[16];
#pragma unroll
        for (int j = 0; j < 16; ++j) { tv0[j] = -INFINITY; tv1[j] = -INFINITY; ti0[j] = 0; ti1[j] = 0; }
#pragma unroll
        for (int pp = 0; pp < 2; ++pp) {
            unsigned qp[64];
#pragma unroll
            for (int d = 0; d < 64; ++d) qp[d] = *(const unsigned*)(QP + (size_t)row * 2048 + (hh * 2 + pp) * 128 + 2 * d);
            for (int n = 0; n < 128; ++n) {
                const bf16_t* kr = SK + ((size_t)(hh * 2 + pp) * 128 + n) * 128;
                float y = 0.f;
#pragma unroll
                for (int d8 = 0; d8 < 16; ++d8) { const u32x4 kk = *(const u32x4*)(kr + d8 * 8);
                    y += bf2f(qp[d8 * 4 + 0] & 0xffffu) * bf2f(kk.x & 0xffffu) + bf2f(qp[d8 * 4 + 0] >> 16) * bf2f(kk.x >> 16)
                       + bf2f(qp[d8 * 4 + 1] & 0xffffu) * bf2f(kk.y & 0xffffu) + bf2f(qp[d8 * 4 + 1] >> 16) * bf2f(kk.y >> 16)
                       + bf2f(qp[d8 * 4 + 2] & 0xffffu) * bf2f(kk.z & 0xffffu) + bf2f(qp[d8 * 4 + 2] >> 16) * bf2f(kk.z >> 16)
                       + bf2f(qp[d8 * 4 + 3] & 0xffffu) * bf2f(kk.w & 0xffffu) + bf2f(qp[d8 * 4 + 3] >> 16) * bf2f(kk.w >> 16); }
                if (pp == 0) TOPK_INSERT(tv0, ti0, y, n); else TOPK_INSERT(tv1, ti1, y, n);
            }
        }
        float bv[16]; int bi[16];
#pragma unroll
        for (int j = 0; j < 16; ++j) { bv[j] = -INFINITY; bi[j] = 0; }
#pragma unroll
        for (int k0 = 0; k0 < 16; ++k0)
#pragma unroll
            for (int k1 = 0; k1 < 16; ++k1)
                if ((k0 + 1) * (k1 + 1) <= 16) TOPK_INSERT(bv, bi, tv0[k0] + tv1[k1], ti0[k0] * 128 + ti1[k1]);
        float e[16], sum = 0.f;
#pragma unroll
        for (int j = 0; j < 16; ++j) { e[j] = __expf(bv[j] - bv[0]); sum += e[j]; }
        const float rs = 1.0f / sum;
#pragma unroll
        for (int j = 0; j < 16; ++j) { IDS[(size_t)row * 128 + hh * 16 + j] = bi[j]; G[(size_t)row * 128 + hh * 16 + j] = e[j] * rs; }
    }
}
__device__ __forceinline__ void naive_peer(const Params& p, int gw, int ngw, int lane) {
    const bf16_t* UT = (const bf16_t*)(p.ws + WS_UTB); const bf16_t* VT = (const bf16_t*)(p.ws + WS_VTB);
    const int* IDS = (const int*)(p.ws + WS_IDS); const float* G = (const float*)(p.ws + WS_G);
    for (int row = gw; row < M; row += ngw) {
        f32x4* xr = (f32x4*)(p.out + (size_t)row * 1024) + lane;
        f32x4 xv[4], acc[4];
#pragma unroll
        for (int j = 0; j < 4; ++j) { xv[j] = xr[64 * j]; acc[j] = (f32x4){0.f, 0.f, 0.f, 0.f}; }
        for (int e = 0; e < 128; ++e) {
            const int id = IDS[(size_t)row * 128 + e]; const float gg = G[(size_t)row * 128 + e];
            const u32x2* ur = (const u32x2*)(UT + (size_t)id * 1024) + lane;
            float part = 0.f;
#pragma unroll
            for (int j = 0; j < 4; ++j) { const u32x2 u = ur[64 * j];
                part += xv[j].x * bf2f(u.x & 0xffffu) + xv[j].y * bf2f(u.x >> 16) + xv[j].z * bf2f(u.y & 0xffffu) + xv[j].w * bf2f(u.y >> 16); }
            const float hsum = wave_sum(part);
            const float a = gelu_exact(hsum) * gg;
            const u32x2* vr = (const u32x2*)(VT + (size_t)id * 1024) + lane;
#pragma unroll
            for (int j = 0; j < 4; ++j) { const u32x2 u = vr[64 * j];
                acc[j].x += a * bf2f(u.x & 0xffffu); acc[j].y += a * bf2f(u.x >> 16); acc[j].z += a * bf2f(u.y & 0xffffu); acc[j].w += a * bf2f(u.y >> 16); }
        }
        float s = 0.f;
#pragma unroll
        for (int j = 0; j < 4; ++j) { acc[j] = ALPHA * xv[j] + acc[j]; s += (acc[j].x + acc[j].y) + (acc[j].z + acc[j].w); }
        const float mean = wave_sum(s) * (1.f / 1024.f); float s2 = 0.f;
#pragma unroll
        for (int j = 0; j < 4; ++j) { acc[j] = acc[j] - mean; s2 += (acc[j].x * acc[j].x + acc[j].y * acc[j].y) + (acc[j].z * acc[j].z + acc[j].w * acc[j].w); }
        const float rstd = 1.f / sqrtf(wave_sum(s2) * (1.f / 1024.f) + LN_EPS);
#pragma unroll
        for (int j = 0; j < 4; ++j) { const f32x4 g = ((const f32x4*)p.ln2_g)[lane + 64 * j], bb = ((const f32x4*)p.ln2_b)[lane + 64 * j];
            xr[64 * j] = acc[j] * rstd * g + bb; }
    }
}

namespace pg8 {
#define PG8_LAS __attribute__((address_space(3)))
typedef unsigned short bf16_t;
typedef short bf16x8 __attribute__((ext_vector_type(8)));
typedef float f32x4 __attribute__((ext_vector_type(4)));
typedef unsigned u32x4 __attribute__((ext_vector_type(4)));
constexpr int BM = 256, BK = 64, HALF = 128, HTB = HALF * BK * 2  , STAGE_BYTES = 8 * HTB, NXCD = 8, WGM = 8;

__host__ __device__ __forceinline__ int lds_byte(int r, int c) { const int st = (r >> 4) * 2 + (c >> 5), rr = r & 15, cc = c & 31, ob = rr * 64 + cc * 2; return st * 1024 + (ob ^ (((ob >> 9) & 1) << 5)); }
__host__ __device__ __forceinline__ void stage_rc(int b, int& R, int& C) { const int st = b / 1024, sb = b % 1024, swz = sb ^ (((sb >> 9) & 1) << 5); R = (st >> 1) * 16 + swz / 64; C = (st & 1) * 32 + (swz % 64) / 2; }
__host__ __device__ __forceinline__ int perm32(int rho) { const int n = rho >> 4, i = rho & 15; return 8 * (i >> 2) + 4 * n + (i & 3); }

struct Unit { int pm, pn; };
struct Gemm { const bf16_t* A; const bf16_t* Bt; int M, N, K; };

struct StaticOrder {
    int nM, nN, nwg, G, c;
    __host__ __device__ void init(int M, int N, int G_, int c_) { nM = M / BM; nN = N / BM; nwg = nM * nN; G = G_; c = c_; }
    __host__ __device__ bool next(int i, Unit& u) const {
        const long L = (long)i * G + c; if (L >= nwg) return false;
        int wgid = (int)L; { const int q = nwg / NXCD, r = nwg % NXCD, xcd = wgid % NXCD, off = wgid / NXCD; wgid = (xcd < r ? xcd * (q + 1) : r * (q + 1) + (xcd - r) * q) + off; }
        const int nig = WGM * nN, gid = wgid / nig, fm = gid * WGM, gsz = (nM - fm) < WGM ? (nM - fm) : WGM;
        u.pm = fm + ((wgid % nig) % gsz); u.pn = (wgid % nig) / gsz; return true;
    }
    __device__ __forceinline__ void a_ready(const Unit&) const {}
    __device__ __forceinline__ void done(const Unit&) const {}
};

typedef float f32x2c_t __attribute__((ext_vector_type(2))); typedef __bf16 bf16x2c_t __attribute__((ext_vector_type(2)));
__device__ __forceinline__ unsigned cvt_pk_bf16(float lo, float hi) { f32x2c_t v = {lo, hi}; bf16x2c_t b = __builtin_convertvector(v, bf16x2c_t); return __builtin_bit_cast(unsigned, b); }
typedef float f32x2 __attribute__((ext_vector_type(2)));
__device__ __forceinline__ f32x2 gelu_pk(f32x2 v) {
    const f32x2 av = __builtin_elementwise_abs(v), d = av * 0.2316418882f + 1.0f;
    f32x2 t; t.x = __builtin_amdgcn_rcpf(d.x); t.y = __builtin_amdgcn_rcpf(d.y);
    f32x2 q = t * 0.5307027145f + (-0.7265760135f); q = q * t + 0.7107068705f; q = q * t + (-0.142248368f); q = q * t + 0.127414796f; q = q * t;
    const f32x2 s = (v * v) * (-0.72134752044f);
    f32x2 e; e.x = __builtin_amdgcn_exp2f(s.x); e.y = __builtin_amdgcn_exp2f(s.y);
    const f32x2 m = v * (q * e), r = v - m;
    f32x2 o; o.x = v.x < 0.f ? m.x : r.x; o.y = v.y < 0.f ? m.y : r.y; return o;
}

template <int ACT  > struct EpiBf16 {
    static constexpr bool PERM = true, AFTER_DRAIN = false; static_assert(ACT == 0 || ACT == 1, "EpiBf16: ACT is 0 (none) or 1 (gelu_pk)");
    bf16_t* O; int ldc; const float* bias; int split_cols; size_t split_stride; float scale0;
    __device__ __forceinline__ void operator()(const f32x4 (&acc)[2][2][4][2], const Unit& u, int wr, int wc, int fr, int fq) const {
        const int row0 = u.pm * BM + wr * 64 + fr; int colt = u.pn * BM; bf16_t* base = O;
        float sc = 1.f; if (split_cols) { const int t = colt / split_cols; base += (size_t)t * split_stride; colt -= t * split_cols; if (t == 0) sc = scale0; }
        const int col0 = colt + wc * 32 + 8 * fq, bcol0 = u.pn * BM + wc * 32 + 8 * fq;
        f32x4 bv[2][2];
#pragma unroll
        for (int bj = 0; bj < 2; ++bj)
#pragma unroll
            for (int n = 0; n < 2; ++n) bv[bj][n] = bias ? *(const f32x4*)(bias + bcol0 + bj * HALF + 4 * n) : (f32x4){0.f, 0.f, 0.f, 0.f};
#pragma unroll
        for (int ai = 0; ai < 2; ++ai)
#pragma unroll
            for (int m = 0; m < 4; ++m) { bf16_t* rowp = base + (size_t)(row0 + ai * HALF + m * 16) * ldc + col0;
#pragma unroll
                for (int bj = 0; bj < 2; ++bj) { f32x4 v0 = acc[ai][bj][m][0] + bv[bj][0], v1 = acc[ai][bj][m][1] + bv[bj][1];
                    if (ACT == 1) { f32x2 a = gelu_pk((f32x2){v0[0], v0[1]}), b = gelu_pk((f32x2){v0[2], v0[3]}), c = gelu_pk((f32x2){v1[0], v1[1]}), d = gelu_pk((f32x2){v1[2], v1[3]});
                        v0 = (f32x4){a.x, a.y, b.x, b.y}; v1 = (f32x4){c.x, c.y, d.x, d.y}; }
                    v0 = v0 * sc; v1 = v1 * sc; u32x4 w; w.x = cvt_pk_bf16(v0[0], v0[1]); w.y = cvt_pk_bf16(v0[2], v0[3]); w.z = cvt_pk_bf16(v1[0], v1[1]); w.w = cvt_pk_bf16(v1[2], v1[3]);
                    *(u32x4*)(rowp + bj * HALF) = w; } }
    }
};


__device__ __forceinline__ float fast_sigmoid(float z) { return __builtin_amdgcn_rcpf(1.0f + __builtin_amdgcn_exp2f(-1.4426950408889634f * z)); }
#define PG8_EPI_LOOP(row0) _Pragma("unroll") for (int ai = 0; ai < 2; ++ai) _Pragma("unroll") for (int m = 0; m < 4; ++m) { const int row = (row0) + ai * HALF + m * 16; _Pragma("unroll") for (int bj = 0; bj < 2; ++bj) { f32x4 v0 = acc[ai][bj][m][0], v1 = acc[ai][bj][m][1];
#define PG8_EPI_END } asm volatile("" ::: "memory"); }
struct EpiProjF {
    static constexpr bool PERM = true, AFTER_DRAIN = false;
    unsigned char* ws;
    __device__ __forceinline__ void operator()(const f32x4 (&acc)[2][2][4][2], const Unit& u, int wr, int wc, int fr, int fq) const {
        const int region = u.pn >> 1;
        const size_t offs[7] = {WS_SBQ, WS_SBK, WS_SBV, WS_DFQ, WS_DFK, WS_DFV, WS_MXQ};
        size_t off = offs[0];
#pragma unroll
        for (int q = 1; q < 7; ++q) off = (region == q) ? offs[q] : off;
        bf16_t* dst = (bf16_t*)(ws + off);
        const float sc = (region == 0 || region == 3) ? C2_64 : (region == 6 ? C2_128 : 1.0f);
        const bool rot = (region == 3 || region == 4) && ((wc & 1) == 0);
        const float sgn = (fq == 0) ? -1.0f : 1.0f;
        const int row0 = u.pm * BM + wr * 64 + fr, colt = (u.pn & 1) * BM + wc * 32 + 8 * fq;
        const f32x4* rope = (const f32x4*)(ws + WS_ROPE);
        PG8_EPI_LOOP(row0)
            if (rot) {
                f32x4 p0, p1;
#pragma unroll
                for (int j = 0; j < 4; ++j) { p0[j] = __shfl_xor(v0[j], 16); p1[j] = __shfl_xor(v1[j], 16); }
                if (fq < 2) {
                    const f32x4 c01 = rope[(size_t)row * 4 + 0], c23 = rope[(size_t)row * 4 + 1], c45 = rope[(size_t)row * 4 + 2], c67 = rope[(size_t)row * 4 + 3];
                    v0[0] = v0[0] * c01[0] + sgn * p0[0] * c01[1]; v0[1] = v0[1] * c01[2] + sgn * p0[1] * c01[3];
                    v0[2] = v0[2] * c23[0] + sgn * p0[2] * c23[1]; v0[3] = v0[3] * c23[2] + sgn * p0[3] * c23[3];
                    v1[0] = v1[0] * c45[0] + sgn * p1[0] * c45[1]; v1[1] = v1[1] * c45[2] + sgn * p1[1] * c45[3];
                    v1[2] = v1[2] * c67[0] + sgn * p1[2] * c67[1]; v1[3] = v1[3] * c67[2] + sgn * p1[3] * c67[3];
                }
            }
            v0 = v0 * sc; v1 = v1 * sc;
            u32x4 w; w.x = cvt_pk_bf16(v0[0], v0[1]); w.y = cvt_pk_bf16(v0[2], v0[3]); w.z = cvt_pk_bf16(v1[0], v1[1]); w.w = cvt_pk_bf16(v1[2], v1[3]);
            *(u32x4*)(dst + (size_t)row * 512 + colt + bj * HALF) = w;
        PG8_EPI_END
    }
};
struct EpiGateF {
    static constexpr bool PERM = true, AFTER_DRAIN = false;
    bf16_t* dst; const float* bias;
    __device__ __forceinline__ void operator()(const f32x4 (&acc)[2][2][4][2], const Unit& u, int wr, int wc, int fr, int fq) const {
        const int row0 = u.pm * BM + wr * 64 + fr, col0 = u.pn * BM + wc * 32 + 8 * fq;
        f32x4 bv[2][2];
#pragma unroll
        for (int bj = 0; bj < 2; ++bj)
#pragma unroll
            for (int n = 0; n < 2; ++n) bv[bj][n] = *(const f32x4*)(bias + col0 + bj * HALF + 4 * n);
        PG8_EPI_LOOP(row0)
            v0 = v0 + bv[bj][0]; v1 = v1 + bv[bj][1];
#pragma unroll
            for (int j = 0; j < 4; ++j) { v0[j] = fast_sigmoid(v0[j]); v1[j] = fast_sigmoid(v1[j]); }
            u32x4 w; w.x = cvt_pk_bf16(v0[0], v0[1]); w.y = cvt_pk_bf16(v0[2], v0[3]); w.z = cvt_pk_bf16(v1[0], v1[1]); w.w = cvt_pk_bf16(v1[2], v1[3]);
            *(u32x4*)(dst + (size_t)row * 3072 + col0 + bj * HALF) = w;
        PG8_EPI_END
    }
};
template <int MODE> struct EpiBranchF {
    static constexpr bool PERM = true, AFTER_DRAIN = false;
    const bf16_t* gates; int gcol; float* m32; bf16_t* mb;
    __device__ __forceinline__ void operator()(const f32x4 (&acc)[2][2][4][2], const Unit& u, int wr, int wc, int fr, int fq) const {
        const int row0 = u.pm * BM + wr * 64 + fr, col0 = u.pn * BM + wc * 32 + 8 * fq;
        PG8_EPI_LOOP(row0)
            const int c = col0 + bj * HALF;
            const u32x4 g = *(const u32x4*)(gates + (size_t)row * 3072 + gcol + c);
            v0[0] *= __uint_as_float(g.x << 16); v0[1] *= __uint_as_float(g.x & 0xffff0000u); v0[2] *= __uint_as_float(g.y << 16); v0[3] *= __uint_as_float(g.y & 0xffff0000u);
            v1[0] *= __uint_as_float(g.z << 16); v1[1] *= __uint_as_float(g.z & 0xffff0000u); v1[2] *= __uint_as_float(g.w << 16); v1[3] *= __uint_as_float(g.w & 0xffff0000u);
            float* mp = m32 + (size_t)row * 1024 + c;
            if (MODE > 0) { v0 = v0 + *(const f32x4*)mp; v1 = v1 + *(const f32x4*)(mp + 4); }
            if (MODE < 2) { *(f32x4*)mp = v0; *(f32x4*)(mp + 4) = v1; }
            else { u32x4 w; w.x = cvt_pk_bf16(v0[0], v0[1]); w.y = cvt_pk_bf16(v0[2], v0[3]); w.z = cvt_pk_bf16(v1[0], v1[1]); w.w = cvt_pk_bf16(v1[2], v1[3]);
                   *(u32x4*)(mb + (size_t)row * 1024 + c) = w; }
        PG8_EPI_END
    }
};
struct EpiOutF {
    static constexpr bool PERM = true, AFTER_DRAIN = false;
    const float* x; float* y;
    __device__ __forceinline__ void operator()(const f32x4 (&acc)[2][2][4][2], const Unit& u, int wr, int wc, int fr, int fq) const {
        const int row0 = u.pm * BM + wr * 64 + fr, col0 = u.pn * BM + wc * 32 + 8 * fq;
        PG8_EPI_LOOP(row0)
            const size_t o = (size_t)row * 1024 + col0 + bj * HALF;
            v0 = v0 + ALPHA * *(const f32x4*)(x + o); v1 = v1 + ALPHA * *(const f32x4*)(x + o + 4);
            *(f32x4*)(y + o) = v0; *(f32x4*)(y + o + 4) = v1;
        PG8_EPI_END
    }
};
struct GateOrder { Unit base;
    __device__ bool next(int i, Unit& u) const { if (i >= 3) return false; u.pm = base.pm; u.pn = 4 * i + base.pn; return true; }
    __device__ __forceinline__ void a_ready(const Unit&) const {} __device__ __forceinline__ void done(const Unit&) const {} };
struct OneOrder { int pm, pn;
    __device__ __forceinline__ bool next(int i, Unit& u) const { if (i >= 1) return false; u.pm = pm; u.pn = pn; return true; }
    __device__ __forceinline__ void a_ready(const Unit&) const {} __device__ __forceinline__ void done(const Unit&) const {} };
struct MemOrder { int c;
    __device__ bool next(int i, Unit& u) const { if (i >= 1 || c < 128 || c >= 136) return false; u.pm = (c - 128) >> 2; u.pn = (c - 128) & 3; return true; }
    __device__ __forceinline__ void a_ready(const Unit&) const {} __device__ __forceinline__ void done(const Unit&) const {} };

template <class Epi, class Sched, bool ALIGN_EPI = false, bool SP2 = false>
__device__ __forceinline__ void gemm_phase(PG8_LAS unsigned char* lds, const Gemm g, const Sched& S, const Epi& E) {
    int tid = threadIdx.x; asm volatile("" : "+v"(tid));
    const int wid = __builtin_amdgcn_readfirstlane(tid >> 6), lane = tid & 63, wr = wid >> 2, wc = wid & 3, fr = lane & 15, fq = lane >> 4;
    const int K = g.K, nt = K / BK;
    unsigned voffA[2], voffB[2];
#pragma unroll
    for (int i = 0; i < 2; ++i) { int R, C; stage_rc(tid * 16 + i * 8192, R, C); const int Rb = Epi::PERM ? ((R & ~31) + perm32(R & 31)) : R;
        voffA[i] = (unsigned)(R * K + C) * 2u; voffB[i] = (unsigned)(Rb * K + C) * 2u; }
    const size_t kstep = (size_t)(BK * 2);
    const size_t hstep = (size_t)HALF * K * 2;
    const size_t tstep = 2 * hstep;
    const unsigned ldsw = (unsigned)wid * 1024u;
    const int aoff = lds_byte(wr * 64 + fr, fq * 8), boff = lds_byte(wc * 32 + fr, fq * 8);
#define PG8_SA(b, h) (((b) * 2 + (h)) * HTB)
#define PG8_SB(b, h) ((4 + (b) * 2 + (h)) * HTB)
#define PG8_STAGE(bufoff, gbase, voff) do { _Pragma("unroll") for (int _i = 0; _i < 2; ++_i) \
        __builtin_amdgcn_global_load_lds((const unsigned*)((const char*)(gbase) + (voff)[_i]), (PG8_LAS unsigned*)(lds + (bufoff) + ldsw + _i * 8192), 16, 0, 0); } while (0)
#define PG8_LDA(dst, b, h) do { _Pragma("unroll") for (int m = 0; m < 4; ++m) _Pragma("unroll") for (int k = 0; k < 2; ++k) dst[m][k] = *(const PG8_LAS bf16x8*)(lds + PG8_SA(b, h) + aoff + m * 2048 + k * 1024); } while (0)
#define PG8_LDB(dst, b, h) do { _Pragma("unroll") for (int n = 0; n < 2; ++n) _Pragma("unroll") for (int k = 0; k < 2; ++k) dst[n][k] = *(const PG8_LAS bf16x8*)(lds + PG8_SB(b, h) + boff + n * 2048 + k * 1024); } while (0)
#define PG8_MMA(ai, bj, At, Bt) do { __builtin_amdgcn_s_setprio(1); _Pragma("unroll") for (int m = 0; m < 4; ++m) _Pragma("unroll") for (int n = 0; n < 2; ++n) _Pragma("unroll") for (int k = 0; k < 2; ++k) \
        acc[ai][bj][m][n] = __builtin_amdgcn_mfma_f32_16x16x32_bf16(Bt[n][k], At[m][k], acc[ai][bj][m][n], 0, 0, 0); __builtin_amdgcn_s_setprio(0); } while (0)
#define PG8_WAIT_V(n) asm volatile("s_waitcnt vmcnt(" #n ")" ::: "memory")
#define PG8_WAIT_L(n) asm volatile("s_waitcnt lgkmcnt(" #n ")" ::: "memory")
#define PG8_BAR __builtin_amdgcn_s_barrier()
#define PG8_SCHED __builtin_amdgcn_sched_barrier(0)
    Unit cur, nxt; int ui = 0;
    if (!S.next(0, cur)) return;
    f32x4 acc[2][2][4][2];
#pragma unroll
    for (int a = 0; a < 2; ++a)
#pragma unroll
        for (int b = 0; b < 2; ++b)
#pragma unroll
            for (int m = 0; m < 4; ++m)
#pragma unroll
                for (int n = 0; n < 2; ++n) acc[a][b][m][n] = (f32x4){0.f, 0.f, 0.f, 0.f};
    bf16x8 At[4][2], B0[2][2], B1[2][2];
    const char* cA = (const char*)g.A + (size_t)cur.pm * tstep; const char* cB = (const char*)g.Bt + (size_t)cur.pn * tstep;
    S.a_ready(cur);
    if constexpr (SP2) {
        PG8_STAGE(PG8_SB(0, 0), cB, voffB); PG8_STAGE(PG8_SB(0, 1), cB + hstep, voffB); PG8_STAGE(PG8_SA(0, 0), cA, voffA); PG8_STAGE(PG8_SA(0, 1), cA + hstep, voffA);
        if (wr == 1) PG8_BAR;
        PG8_WAIT_V(2); PG8_BAR;
        PG8_STAGE(PG8_SB(1, 0), cB + kstep, voffB); PG8_STAGE(PG8_SA(1, 0), cA + kstep, voffA); PG8_STAGE(PG8_SB(1, 1), cB + hstep + kstep, voffB);
        PG8_WAIT_V(6); PG8_BAR;
    } else {
        PG8_STAGE(PG8_SB(0, 0), cB, voffB); PG8_STAGE(PG8_SA(0, 0), cA, voffA); PG8_STAGE(PG8_SB(0, 1), cB + hstep, voffB); PG8_STAGE(PG8_SA(0, 1), cA + hstep, voffA);
        if (wr == 1) PG8_BAR;
        PG8_WAIT_V(4); PG8_BAR;
        PG8_STAGE(PG8_SB(1, 0), cB + kstep, voffB); PG8_STAGE(PG8_SA(1, 0), cA + kstep, voffA); PG8_STAGE(PG8_SB(1, 1), cB + hstep + kstep, voffB);
        PG8_WAIT_V(6); PG8_BAR;
    }
    for (;;) {
        const bool has_next = S.next(ui + 1, nxt);
        const char* nA = has_next ? (const char*)g.A + (size_t)nxt.pm * tstep : cA; const char* nB = has_next ? (const char*)g.Bt + (size_t)nxt.pn * tstep : cB;
        for (int t = 0; t < nt; t += 2) {
            const bool last = (t == nt - 2);
            const char* a1 = cA + (size_t)(t + 1) * kstep;
            const char* a2 = last ? nA : cA + (size_t)(t + 2) * kstep; const char* b2 = last ? nB : cB + (size_t)(t + 2) * kstep;
            const char* a3 = a2 + kstep; const char* b3 = b2 + kstep;
            if (last && has_next) S.a_ready(nxt);
            if constexpr (SP2) {
            PG8_LDB(B0, 0, 0); PG8_LDB(B1, 0, 1); PG8_SCHED; PG8_LDA(At, 0, 0); PG8_STAGE(PG8_SA(1, 1), a1 + hstep, voffA);
            PG8_WAIT_V(8); PG8_WAIT_L(0); PG8_BAR; PG8_MMA(0, 0, At, B0); PG8_MMA(0, 1, At, B1); PG8_BAR; PG8_SCHED;
            PG8_LDA(At, 0, 1); PG8_STAGE(PG8_SB(0, 0), b2, voffB); PG8_STAGE(PG8_SB(0, 1), b2 + hstep, voffB); PG8_STAGE(PG8_SA(0, 0), a2, voffA);
            PG8_WAIT_V(8); PG8_WAIT_L(0); PG8_BAR; PG8_MMA(1, 0, At, B0); PG8_MMA(1, 1, At, B1); PG8_BAR; PG8_SCHED;
            PG8_LDB(B0, 1, 0); PG8_LDB(B1, 1, 1); PG8_SCHED; PG8_LDA(At, 1, 0); PG8_STAGE(PG8_SA(0, 1), a2 + hstep, voffA);
            PG8_WAIT_V(8); PG8_WAIT_L(0); PG8_BAR; PG8_MMA(0, 0, At, B0); PG8_MMA(0, 1, At, B1); PG8_BAR; PG8_SCHED;
            PG8_LDA(At, 1, 1); PG8_STAGE(PG8_SB(1, 0), b3, voffB); PG8_STAGE(PG8_SB(1, 1), b3 + hstep, voffB); PG8_STAGE(PG8_SA(1, 0), a3, voffA);
            PG8_WAIT_V(8); PG8_WAIT_L(0); PG8_BAR; PG8_MMA(1, 0, At, B0); PG8_MMA(1, 1, At, B1); PG8_BAR; PG8_SCHED;
            } else {
            PG8_LDB(B0, 0, 0); PG8_SCHED; PG8_LDA(At, 0, 0); PG8_STAGE(PG8_SA(1, 1), a1 + hstep, voffA);
            PG8_WAIT_L(8); PG8_BAR; PG8_WAIT_L(0); PG8_MMA(0, 0, At, B0); PG8_BAR; PG8_SCHED;
            PG8_LDB(B1, 0, 1); PG8_STAGE(PG8_SB(0, 0), b2, voffB);
            PG8_BAR; PG8_WAIT_L(0); PG8_MMA(0, 1, At, B1); PG8_BAR;
            PG8_LDA(At, 0, 1); PG8_STAGE(PG8_SA(0, 0), a2, voffA);
            PG8_BAR; PG8_WAIT_L(0); PG8_MMA(1, 0, At, B0); PG8_BAR; PG8_SCHED;
            PG8_STAGE(PG8_SB(0, 1), b2 + hstep, voffB);
            PG8_WAIT_V(6); PG8_BAR; PG8_MMA(1, 1, At, B1); PG8_BAR;
            PG8_LDB(B0, 1, 0); PG8_SCHED; PG8_LDA(At, 1, 0); PG8_STAGE(PG8_SA(0, 1), a2 + hstep, voffA);
            PG8_WAIT_L(8); PG8_BAR; PG8_WAIT_L(0); PG8_MMA(0, 0, At, B0); PG8_BAR; PG8_SCHED;
            PG8_LDB(B1, 1, 1); PG8_STAGE(PG8_SB(1, 0), b3, voffB);
            PG8_BAR; PG8_WAIT_L(0); PG8_MMA(0, 1, At, B1); PG8_BAR;
            PG8_LDA(At, 1, 1); PG8_STAGE(PG8_SA(1, 0), a3, voffA);
            PG8_BAR; PG8_WAIT_L(0); PG8_MMA(1, 0, At, B0); PG8_BAR; PG8_SCHED;
            PG8_STAGE(PG8_SB(1, 1), b3 + hstep, voffB);
            PG8_WAIT_V(6); PG8_BAR; PG8_MMA(1, 1, At, B1); PG8_BAR;
            }
        }
        if constexpr (ALIGN_EPI) { if (wr == 0) PG8_BAR; }
        if constexpr (!Epi::AFTER_DRAIN) { E(acc, cur, wr, wc, fr, fq); S.done(cur); }
        if (!has_next) break;
#pragma unroll
        for (int a = 0; a < 2; ++a)
#pragma unroll
            for (int b = 0; b < 2; ++b)
#pragma unroll
                for (int m = 0; m < 4; ++m)
#pragma unroll
                    for (int n = 0; n < 2; ++n) acc[a][b][m][n] = (f32x4){0.f, 0.f, 0.f, 0.f};
        cur = nxt; cA = nA; cB = nB; ++ui;
        if constexpr (ALIGN_EPI) { if (wr == 1) PG8_BAR; }
    }
    PG8_WAIT_V(0);
    if constexpr (!ALIGN_EPI) { if (wr == 0) PG8_BAR; }
    PG8_BAR;
    if constexpr (Epi::AFTER_DRAIN) { E.fused(acc, cur, wr, wc, fr, fq, lds, wid, lane); S.done(cur); }
#undef PG8_SA
#undef PG8_SB
#undef PG8_STAGE
#undef PG8_LDA
#undef PG8_LDB
#undef PG8_MMA
#undef PG8_WAIT_V
#undef PG8_WAIT_L
#undef PG8_BAR
#undef PG8_SCHED
}
}

#ifndef PG8_SP2
#define PG8_SP2 true
#endif
#ifndef PG8_ALIGN
#define PG8_ALIGN true
#endif

#include <hip/hip_bf16.h>
#include <cmath>
namespace attn_body {
using bf16=__hip_bfloat16;
using bf16x8=__attribute__((ext_vector_type(8)))short;
using s16x4=__attribute__((ext_vector_type(4)))short;
using f32x16=__attribute__((ext_vector_type(16)))float;
using u32x4=__attribute__((ext_vector_type(4)))unsigned;
constexpr int BATCH=2,NHEAD=16,SEQ=8192,D=64,DM=NHEAD*D,PQ=512,PO=1024;
constexpr int NW=8,QBLK=32,QB=QBLK*NW,KVBLK=64,NQB=SEQ/QB;
constexpr int ATTN_PITCH=DM, ATTN_UNIT_ROWS=QB;
__device__ __forceinline__ int crow(int r,int hi){return (r&3)+8*(r>>2)+4*hi;}
#define SBAR() __builtin_amdgcn_sched_barrier(0)
__device__ __forceinline__ void cmask(f32x16&p0,f32x16&p1,int jb,int qrel,int hi){
  const float NEG=-INFINITY; int kb=64*jb+4*hi;
  #pragma unroll
  for(int r=0;r<16;++r){int kv=kb+(r&3)+8*(r>>2); if(kv>qrel)p0[r]=NEG; if(kv+32>qrel)p1[r]=NEG;}
}

constexpr int NSLOT=3, SLOTB=8192;
constexpr int LDS_K=0, LDS_V=NSLOT*SLOTB, LDS_WS=2*NSLOT*SLOTB, LDS_OST=LDS_WS+NW*64*4, LDS_BYTES=LDS_OST+NW*4096;
constexpr float C2=0.125f*1.4426950408889634f;
__device__ __forceinline__ void glds16(const void*gsrc,unsigned lds_dst){unsigned keep;
  asm volatile("s_mov_b32 %0, m0\n\ts_mov_b32 m0, %2\n\ts_nop 0\n\tglobal_load_lds_dwordx4 %1, off\n\ts_mov_b32 m0, %0":"=&s"(keep):"v"(gsrc),"s"(lds_dst):"memory");}
__device__ __forceinline__ float max3f(float a,float b,float c){float r;asm("v_max3_f32 %0, %1, %2, %3":"=v"(r):"v"(a),"v"(b),"v"(c));return r;}
__device__ __forceinline__ float max2f(float a,float b){float r;asm("v_max_f32_e32 %0, %1, %2":"=v"(r):"v"(a),"v"(b));return r;}
__device__ __forceinline__ float fadd_s(float a,float b){float r;asm("v_add_f32_e32 %0, %1, %2":"=v"(r):"v"(a),"v"(b));return r;}
__device__ __forceinline__ float fsub_s(float a,float b){float r;asm("v_sub_f32_e32 %0, %1, %2":"=v"(r):"v"(a),"v"(b));return r;}
typedef float f32x2_t __attribute__((ext_vector_type(2))); typedef __bf16 bf16x2_t __attribute__((ext_vector_type(2)));
__device__ __forceinline__ unsigned cvtpk_s(float lo,float hi){f32x2_t v={lo,hi};bf16x2_t b=__builtin_convertvector(v,bf16x2_t);return __builtin_bit_cast(unsigned,b);}
#define WAIT_BAR(N) asm volatile("s_waitcnt vmcnt(" #N ") lgkmcnt(0)\n\ts_barrier":::"memory")

__device__ __forceinline__ void qkt(f32x16&p0,f32x16&p1,const char*Kslot,const bf16x8*qr,const f32x16&negm,int r32,int hi){
  const char*kb=Kslot+hi*1024+r32*16;
  #pragma unroll
  for(int d0=0;d0<4;++d0){
    const bf16x8 b0=*reinterpret_cast<const bf16x8*>(kb+d0*2048);
    const bf16x8 b1=*reinterpret_cast<const bf16x8*>(kb+d0*2048+512);
    if(d0==0){p0=__builtin_amdgcn_mfma_f32_32x32x16_bf16(b0,qr[0],negm,0,0,0);p1=__builtin_amdgcn_mfma_f32_32x32x16_bf16(b1,qr[0],negm,0,0,0);}
    else{p0=__builtin_amdgcn_mfma_f32_32x32x16_bf16(b0,qr[d0],p0,0,0,0);p1=__builtin_amdgcn_mfma_f32_32x32x16_bf16(b1,qr[d0],p1,0,0,0);}}
}
typedef __attribute__((address_space(3))) const char* lds_cptr;
typedef short v4i16_t __attribute__((ext_vector_type(4)));
__device__ __forceinline__ void kload8(bf16x8*kf,lds_cptr kp){
  kf[0]=*(const __attribute__((address_space(3))) bf16x8*)(kp);      kf[1]=*(const __attribute__((address_space(3))) bf16x8*)(kp+512);
  kf[2]=*(const __attribute__((address_space(3))) bf16x8*)(kp+2048); kf[3]=*(const __attribute__((address_space(3))) bf16x8*)(kp+2560);
  kf[4]=*(const __attribute__((address_space(3))) bf16x8*)(kp+4096); kf[5]=*(const __attribute__((address_space(3))) bf16x8*)(kp+4608);
  kf[6]=*(const __attribute__((address_space(3))) bf16x8*)(kp+6144); kf[7]=*(const __attribute__((address_space(3))) bf16x8*)(kp+6656);
}
__device__ __forceinline__ void kload2(bf16x8*kf,lds_cptr kp,int j){ kf[2*j]=*(const __attribute__((address_space(3))) bf16x8*)(kp+j*2048); kf[2*j+1]=*(const __attribute__((address_space(3))) bf16x8*)(kp+j*2048+512); }
__device__ __forceinline__ s16x4 vtr(lds_cptr p){ return __builtin_bit_cast(s16x4,__builtin_amdgcn_ds_read_tr16_b64_v4i16((__attribute__((address_space(3))) v4i16_t*)p)); }
__device__ __forceinline__ float rowmax(const f32x16&p0,const f32x16&p1){
  float a=max3f(p0[0],p0[1],p1[0]),b=max3f(p0[2],p0[3],p1[1]);a=max3f(a,p1[2],p1[3]);
  #pragma unroll
  for(int r=4;r<16;r+=4){a=max3f(a,p0[r],p0[r+1]);b=max3f(b,p0[r+2],p0[r+3]);a=max3f(a,p1[r],p1[r+1]);b=max3f(b,p1[r+2],p1[r+3]);}
  const float m=max2f(a,b);
  auto rr=__builtin_amdgcn_permlane32_swap(__float_as_uint(m),__float_as_uint(m),false,false);
  return max2f(__uint_as_float(rr[0]),__uint_as_float(rr[1]));
}
__device__ __forceinline__ void pv(f32x16*o,int vb,bf16x8 pa0,bf16x8 pa1,bf16x8 pa2,bf16x8 pa3){
  #pragma unroll
  for(int d0=0;d0<2;++d0){s16x4 lo[4],hi[4];
    #pragma unroll
    for(int ks=0;ks<4;++ks){
      asm volatile("ds_read_b64_tr_b16 %0,%1 offset:%c2":"=&v"(lo[ks]):"v"(vb),"i"(d0*4096+ks*1024):"memory");
      asm volatile("ds_read_b64_tr_b16 %0,%1 offset:%c2":"=&v"(hi[ks]):"v"(vb),"i"(d0*4096+ks*1024+512):"memory");}
    asm volatile("s_waitcnt lgkmcnt(0)":::"memory");SBAR();
    #define PK(k) (bf16x8){lo[k][0],lo[k][1],lo[k][2],lo[k][3],hi[k][0],hi[k][1],hi[k][2],hi[k][3]}
    o[d0]=__builtin_amdgcn_mfma_f32_32x32x16_bf16(pa0,PK(0),o[d0],0,0,0);
    o[d0]=__builtin_amdgcn_mfma_f32_32x32x16_bf16(pa1,PK(1),o[d0],0,0,0);
    o[d0]=__builtin_amdgcn_mfma_f32_32x32x16_bf16(pa2,PK(2),o[d0],0,0,0);
    o[d0]=__builtin_amdgcn_mfma_f32_32x32x16_bf16(pa3,PK(3),o[d0],0,0,0);
    #undef PK
  }
}

#ifndef ATTN_STORE16
#define ATTN_STORE16(p,v) (*(u32x4*)(p)=(v))
#endif
template<int THRL> __device__ __forceinline__ void attn_unit(int b,int h,int qb,const bf16*Q,const bf16*__restrict__ K,const bf16*__restrict__ V,bf16*O,char*shm){
  int tid=threadIdx.x; asm volatile("":"+v"(tid)); const int lane=tid&63,r32=lane&31,hi=lane>>5; const int wid=__builtin_amdgcn_readfirstlane(tid>>6);
  const long rowbase=(long)b*SEQ; const int q0=qb*QB;
  const bf16*Qw=Q+(rowbase+q0+wid*QBLK)*PQ;
  const bf16*Kh=K+rowbase*PQ,*Vh=V+rowbase*PQ;
  const unsigned lds0=(unsigned)(uintptr_t)shm;
  float*wsf=(float*)(shm+LDS_WS)+wid*64;
  const bf16*ksrc=Kh+(long)lane*PQ+wid*8;
  const bf16*vsrc=Vh+(long)(16*(wid&3)+(lane>>2))*PQ+(wid>>2)*32+(lane&3)*8;
  const unsigned kdst=lds0+LDS_K+wid*1024, vdst=lds0+LDS_V+wid*1024;
  #define DMA_K(t,slot) glds16(ksrc+(long)(t)*KVBLK*PQ,(unsigned)__builtin_amdgcn_readfirstlane(kdst+(slot)))
  #define DMA_V(t,slot) glds16(vsrc+(long)(t)*KVBLK*PQ,(unsigned)__builtin_amdgcn_readfirstlane(vdst+(slot)))
  const int vb0=(int)(lds0+LDS_V)+((lane>>4)&1)*32+(lane&3)*8+(4*hi+((lane&15)>>2))*64;
  const char*Kbase=shm+LDS_K; bf16x8 kf[8];
  const lds_cptr shm3=(lds_cptr)shm; const lds_cptr kp0=shm3+LDS_K+hi*1024+r32*16; const lds_cptr vp0=shm3+LDS_V+((lane>>4)&1)*32+(lane&3)*8+(4*hi+((lane&15)>>2))*64;
  const int NT=(q0+QB)/KVBLK;
  DMA_K(0,0);DMA_V(0,0);DMA_K(1,SLOTB);
  bf16x8 qr[4];
  #pragma unroll
  for(int d0=0;d0<4;++d0)qr[d0]=*reinterpret_cast<const bf16x8*>(&Qw[(long)r32*PQ+d0*16+hi*8]);
  float mhat=0.f,l_reg=0.f;f32x16 o[2];o[0]=f32x16{};o[1]=f32x16{};f32x16 negm=f32x16{};asm volatile("":"+v"(negm));
  const int qrel=wid*QBLK+r32;
  #define CMASK(P0,P1,t) do{int jb_=(t)-(NT-4); if(jb_>=0)cmask(P0,P1,jb_,qrel,hi);}while(0)
  bool resc=false;
  #define START(P0,P1) do{ const float rm=rowmax(P0,P1); resc=false; \
    { const float dl=rm; mhat=fadd_s(mhat,dl); \
      _Pragma("unroll") for(int r=0;r<16;++r){P0[r]=fsub_s(P0[r],dl);P1[r]=fsub_s(P1[r],dl);} \
      _Pragma("unroll") for(int r=0;r<16;++r)negm[r]=-mhat; asm volatile("":"+v"(negm)); } \
    _Pragma("unroll") for(int r=0;r<16;++r)P0[r]=__builtin_amdgcn_exp2f(P0[r]); }while(0)
  #define RESC() do{ if(resc){ asm volatile("s_waitcnt lgkmcnt(0)":::"memory"); \
      _Pragma("unroll") for(int d_=0;d_<2;++d_) _Pragma("unroll") for(int r=0;r<16;++r)o[d_][r]*=wsf[crow(r,hi)]; } }while(0)
  f32x16 pA0,pA1,pB0,pB1;
  int sl_prev=0,sl_cur=0,sl_next=SLOTB;
  #define ROT() do{sl_prev=sl_cur;sl_cur=sl_next;sl_next=(sl_next==(NSLOT-1)*SLOTB)?0:sl_next+SLOTB;}while(0)
  DMA_K(2,2*SLOTB);
  WAIT_BAR(3);
  qkt(pA0,pA1,Kbase,qr,negm,r32,hi);asm volatile("s_nop 15\n\ts_nop 7":"+v"(pA0),"+v"(pA1));CMASK(pA0,pA1,0);
  START(pA0,pA1);
  _Pragma("unroll") for(int r=0;r<16;++r)pA1[r]=__builtin_amdgcn_exp2f(pA1[r]);
  WAIT_BAR(0);
  DMA_K(3,0);DMA_V(1,SLOTB);
  ROT();
  kload8(kf,kp0+sl_cur);
  WAIT_BAR(2);
  s16x4 vlo[8],vhi[8]; u32x4 pw0,pw1,pw2,pw3;
  #define PKW(P,B) cvtpk_s(P[B],P[B+1])
  #define PAF(k) __builtin_bit_cast(bf16x8,pw##k)
  #define VFR(i) (bf16x8){vlo[i][0],vlo[i][1],vlo[i][2],vlo[i][3],vhi[i][0],vhi[i][1],vhi[i][2],vhi[i][3]}
  #define PIN(x) asm volatile("":"+v"(x))
  #define MX3(a,b,c) __builtin_fmaxf(__builtin_fmaxf((a),(b)),(c))
  #define GAPA(MF,A0,A1,A2,A3,W0,W1,PW) do{ MF; sacc+=A0; sacc+=A1; sacc+=A2; sacc+=A3; PIN(sacc); W0; W1; PIN(PW); SBAR(); }while(0)
  #define EX(v) __builtin_amdgcn_exp2f(v)
  #define GAPB(MF,X,B) do{ MF; X[B]=EX(X[B]); X[B+1]=EX(X[B+1]); X[B+2]=EX(X[B+2]); X[B+3]=EX(X[B+3]); PIN(X); SBAR(); }while(0)
  #define VRD(i) do{ vlo[i]=vtr(vp_+(((i)>>2)*4096+((i)&3)*1024)); vhi[i]=vtr(vp_+(((i)>>2)*4096+((i)&3)*1024+512)); }while(0)
  #define KRD(G,j) do{ if(G){ kload2(kf,kp0+sl_next,j); SBAR(); } }while(0)
  #define STEP(C0,C1,P0,P1,t,GK,GV,GL) do{ SBAR(); \
    const lds_cptr vp_=vp0+sl_prev; \
    VRD(0); SBAR(); float sacc=(P0[0]+P0[1]); \
    GAPA(C0=__builtin_amdgcn_mfma_f32_32x32x16_bf16(kf[0],qr[0],negm,0,0,0), P0[2],P0[3],P0[4],P0[5],     pw0[0]=PKW(P0,0), pw0[1]=PKW(P0,2), pw0); \
    VRD(4); SBAR(); GAPA(C1=__builtin_amdgcn_mfma_f32_32x32x16_bf16(kf[1],qr[0],negm,0,0,0), P0[6],P0[7],P0[8],P0[9],     pw0[2]=PKW(P0,4), pw0[3]=PKW(P0,6), pw0); \
    VRD(1); SBAR(); GAPA(C0=__builtin_amdgcn_mfma_f32_32x32x16_bf16(kf[2],qr[1],C0,0,0,0),   P0[10],P0[11],P0[12],P0[13], pw1[0]=PKW(P0,8), pw1[1]=PKW(P0,10), pw1); \
    VRD(5); SBAR(); GAPA(C1=__builtin_amdgcn_mfma_f32_32x32x16_bf16(kf[3],qr[1],C1,0,0,0),   P0[14],P0[15],P1[0],P1[1],   pw1[2]=PKW(P0,12),pw1[3]=PKW(P0,14), pw1); \
    VRD(2); SBAR(); GAPA(C0=__builtin_amdgcn_mfma_f32_32x32x16_bf16(kf[4],qr[2],C0,0,0,0),   P1[2],P1[3],P1[4],P1[5],     pw2[0]=PKW(P1,0), pw2[1]=PKW(P1,2), pw2); \
    VRD(6); SBAR(); GAPA(C1=__builtin_amdgcn_mfma_f32_32x32x16_bf16(kf[5],qr[2],C1,0,0,0),   P1[6],P1[7],P1[8],P1[9],     pw2[2]=PKW(P1,4), pw2[3]=PKW(P1,6), pw2); \
    VRD(3); SBAR(); GAPA(C0=__builtin_amdgcn_mfma_f32_32x32x16_bf16(kf[6],qr[3],C0,0,0,0),   P1[10],P1[11],P1[12],P1[13], pw3[0]=PKW(P1,8), pw3[1]=PKW(P1,10), pw3); \
    VRD(7); SBAR(); GAPA(C1=__builtin_amdgcn_mfma_f32_32x32x16_bf16(kf[7],qr[3],C1,0,0,0),   P1[14],P1[15],0.f,0.f,       pw3[2]=PKW(P1,12),pw3[3]=PKW(P1,14), pw3); \
    l_reg+=sacc; \
    if(GK){DMA_K((t)+3,sl_cur);} if(GV){DMA_V((t)+1,sl_next);} \
    CMASK(C0,C1,t); \
    { float a=MX3(C0[0],C0[1],C1[0]),b=MX3(C0[2],C0[3],C1[1]); a=MX3(a,C1[2],C1[3]); \
      _Pragma("unroll") for(int r=4;r<16;r+=4){a=MX3(a,C0[r],C0[r+1]);b=MX3(b,C0[r+2],C0[r+3]);a=MX3(a,C1[r],C1[r+1]);b=MX3(b,C1[r+2],C1[r+3]);} \
      float rm=__builtin_fmaxf(a,b); { auto rr=__builtin_amdgcn_permlane32_swap(__float_as_uint(rm),__float_as_uint(rm),false,false); rm=__builtin_fmaxf(__uint_as_float(rr[0]),__uint_as_float(rr[1])); } \
      resc=false; \
      if(__builtin_expect(__any(rm>(float)THRL),0)){ const float dl=__builtin_fmaxf(rm,0.f); mhat+=dl; \
        _Pragma("unroll") for(int r=0;r<16;++r){C0[r]-=dl;C1[r]-=dl;} \
        _Pragma("unroll") for(int r=0;r<16;++r)negm[r]=-mhat; asm volatile("":"+v"(negm)); \
        const float f=__builtin_amdgcn_exp2f(-dl); l_reg*=f; if(hi==0)wsf[r32]=f; resc=true; } } \
    SBAR(); \
    GAPB(o[0]=__builtin_amdgcn_mfma_f32_32x32x16_bf16(PAF(0),VFR(0),o[0],0,0,0), C0,0); \
    GAPB(o[1]=__builtin_amdgcn_mfma_f32_32x32x16_bf16(PAF(0),VFR(4),o[1],0,0,0), C0,4); \
    KRD(GL,0); GAPB(o[0]=__builtin_amdgcn_mfma_f32_32x32x16_bf16(PAF(1),VFR(1),o[0],0,0,0), C0,8); \
    KRD(GL,1); GAPB(o[1]=__builtin_amdgcn_mfma_f32_32x32x16_bf16(PAF(1),VFR(5),o[1],0,0,0), C0,12); \
    KRD(GL,2); GAPB(o[0]=__builtin_amdgcn_mfma_f32_32x32x16_bf16(PAF(2),VFR(2),o[0],0,0,0), C1,0); \
    KRD(GL,3); GAPB(o[1]=__builtin_amdgcn_mfma_f32_32x32x16_bf16(PAF(2),VFR(6),o[1],0,0,0), C1,4); \
    GAPB(o[0]=__builtin_amdgcn_mfma_f32_32x32x16_bf16(PAF(3),VFR(3),o[0],0,0,0), C1,8); \
    GAPB(o[1]=__builtin_amdgcn_mfma_f32_32x32x16_bf16(PAF(3),VFR(7),o[1],0,0,0), C1,12); \
    }while(0)
  int t=1;
  #undef CMASK
  #define CMASK(P0,P1,t) do{}while(0)
  for(;t+5<NT;t+=2){
    STEP(pB0,pB1,pA0,pA1,t,true,true,true);     WAIT_BAR(2); RESC(); ROT();
    STEP(pA0,pA1,pB0,pB1,t+1,true,true,true);   WAIT_BAR(2); RESC(); ROT();
  }
  #undef CMASK
  #define CMASK(P0,P1,t) do{int jb_=(t)-(NT-4); if(jb_>=0)cmask(P0,P1,jb_,qrel,hi);}while(0)
  #define ENDW(tt) do{ if((tt)+3<NT){WAIT_BAR(2);} else if((tt)+2<NT){WAIT_BAR(1);} else {WAIT_BAR(0);} }while(0)
  for(;t+1<NT;t+=2){
    STEP(pB0,pB1,pA0,pA1,t,(t+3<NT),(t+1<NT),(t+1<NT));       ENDW(t);   RESC(); ROT();
    STEP(pA0,pA1,pB0,pB1,t+1,(t+4<NT),(t+2<NT),(t+2<NT));     ENDW(t+1); RESC(); ROT();
  }
  STEP(pB0,pB1,pA0,pA1,NT-1,false,false,false); RESC();
  { float sacc=pB0[0]+pB0[1]; _Pragma("unroll") for(int r=2;r<16;++r)sacc+=pB0[r]; _Pragma("unroll") for(int r=0;r<16;++r)sacc+=pB1[r]; l_reg+=sacc;
    pw0=(u32x4){PKW(pB0,0),PKW(pB0,2),PKW(pB0,4),PKW(pB0,6)};pw1=(u32x4){PKW(pB0,8),PKW(pB0,10),PKW(pB0,12),PKW(pB0,14)};pw2=(u32x4){PKW(pB1,0),PKW(pB1,2),PKW(pB1,4),PKW(pB1,6)};pw3=(u32x4){PKW(pB1,8),PKW(pB1,10),PKW(pB1,12),PKW(pB1,14)};
    SBAR(); pv(o,vb0+sl_cur,PAF(0),PAF(1),PAF(2),PAF(3)); }
  #undef PKW
  #undef PAF
  #undef VFR
  #undef PIN
  #undef MX3
  #undef GAPA
  #undef GAPB
  #undef EX
  #undef VRD
  #undef KRD
  #undef STEP
  #undef ENDW
  {auto rr=__builtin_amdgcn_permlane32_swap(__float_as_uint(l_reg),__float_as_uint(l_reg),false,false);l_reg=__uint_as_float(rr[0])+__uint_as_float(rr[1]);}
  if(hi==0)wsf[32+r32]=l_reg;asm volatile("s_waitcnt lgkmcnt(0)":::"memory");
  float rli[16];
  #pragma unroll
  for(int r=0;r<16;++r)rli[r]=__builtin_amdgcn_rcpf(wsf[32+crow(r,hi)]);
  bf16*Ow=O+(rowbase+q0+wid*QBLK)*PO;
  { bf16*stg=(bf16*)(shm+LDS_OST)+wid*2048;
    #pragma unroll
    for(int r=0;r<16;++r){const int orow=crow(r,hi);
      #pragma unroll
      for(int d0=0;d0<2;++d0)stg[orow*64+d0*32+r32]=__float2bfloat16(o[d0][r]*rli[r]);}
    asm volatile("s_waitcnt lgkmcnt(0)":::"memory");
    #pragma unroll
    for(int i=0;i<4;++i){const int row=i*8+(lane>>3),ch=lane&7; const u32x4 v=*(const u32x4*)(stg+row*64+ch*8); ATTN_STORE16(Ow+(long)row*PO+ch*8,v);} }
  asm volatile("s_waitcnt lgkmcnt(0)\n\ts_barrier":::"memory");
  #undef DMA_K
  #undef DMA_V
  #undef CMASK
  #undef START
  #undef RESC
  #undef ROT
}
constexpr int ATTN_LDS_BYTES=LDS_BYTES;
struct AttnTensors { const bf16* Q; const bf16* K; const bf16* V; bf16* O; };
struct AttnUnit { int bh; int qb; };
struct StaticOrder {
  int vcu;
  __device__ __forceinline__ explicit StaticOrder(int grid,int block):vcu((block%8)*(grid/8)+block/8){}
  __device__ __forceinline__ bool next(int i,AttnUnit&u)const{ if(i>=4)return false; const int s=vcu&7; u.bh=vcu>>3; u.qb=(i==0)?s:(i==1)?15-s:(i==2)?16+s:31-s; return true; }
  __device__ __forceinline__ void a_ready(const AttnUnit&)const{}
  __device__ __forceinline__ void done(const AttnUnit&)const{}
};
template<class Sched,int THRL=8> __device__ __forceinline__ void attn_phase(char*lds,const AttnTensors&T,const Sched&S){
  AttnUnit u;
  for(int i=0;S.next(i,u);++i){ S.a_ready(u); const int b=u.bh/NHEAD,g=u.bh%NHEAD,hh=g>>2,mm=(g>>1)&1,vh=g&1;
    attn_unit<THRL>(b,0,u.qb,T.Q+(hh*2+mm)*64,T.K+(hh*2+mm)*64,T.V+(hh*2+vh)*64,T.O+g*64,lds); S.done(u); }
}
#undef SBAR
#undef WAIT_BAR
}


constexpr size_t WS_PART = 64 * MiB;
constexpr size_t WS_ACO = 144 * MiB;
constexpr size_t WS_FFN = 64 * MiB;
typedef __bf16 bf16x2v __attribute__((ext_vector_type(2)));
__device__ __forceinline__ float dot8_bf16(const u32x4& a, const u32x4& b) {
    float r = __uint_as_float(a.x << 16) * __uint_as_float(b.x << 16) + __uint_as_float(a.x & 0xffff0000u) * __uint_as_float(b.x & 0xffff0000u);
    r += __uint_as_float(a.y << 16) * __uint_as_float(b.y << 16) + __uint_as_float(a.y & 0xffff0000u) * __uint_as_float(b.y & 0xffff0000u);
    r += __uint_as_float(a.z << 16) * __uint_as_float(b.z << 16) + __uint_as_float(a.z & 0xffff0000u) * __uint_as_float(b.z & 0xffff0000u);
    r += __uint_as_float(a.w << 16) * __uint_as_float(b.w << 16) + __uint_as_float(a.w & 0xffff0000u) * __uint_as_float(b.w & 0xffff0000u);
    return r;
}
__device__ __forceinline__ void peer_sddmm(const Params& p, int bx, int wave, int lane) {
    const int x = bx & 7, j = bx >> 3, c = lane & 15, q = lane >> 4;
    const bf16_t* UT = (const bf16_t*)(p.ws + WS_UTB) + 128 * x + 8 * c;
    const bf16_t* XS = (const bf16_t*)(p.ws + WS_X1B) + 128 * x + 8 * c;
    const int* IDS = (const int*)(p.ws + WS_IDS);
    float* PART = (float*)(p.ws + WS_PART) + (size_t)x * M * 128;
    for (int tt = 0; tt < 64; ++tt) {
        const int t = 512 * j + 64 * wave + tt;
        const u32x4 xv = *(const u32x4*)(XS + (size_t)t * 1024);
        const int* idp = IDS + (size_t)t * 128 + 32 * q;
        float s[32];
#pragma unroll
        for (int g = 0; g < 8; ++g) {
            const int4 id4 = *(const int4*)(idp + 4 * g);
            const u32x4 u0 = *(const u32x4*)(UT + (size_t)id4.x * 1024), u1 = *(const u32x4*)(UT + (size_t)id4.y * 1024);
            const u32x4 u2 = *(const u32x4*)(UT + (size_t)id4.z * 1024), u3 = *(const u32x4*)(UT + (size_t)id4.w * 1024);
            s[4 * g + 0] = dot8_bf16(xv, u0); s[4 * g + 1] = dot8_bf16(xv, u1); s[4 * g + 2] = dot8_bf16(xv, u2); s[4 * g + 3] = dot8_bf16(xv, u3);
        }
        float r16[16], r8[8], r4[4], r2[2];
        { const bool up = (c & 8) != 0;
#pragma unroll
          for (int i = 0; i < 16; ++i) { const float snd = up ? s[i] : s[i + 16], kp = up ? s[i + 16] : s[i]; r16[i] = kp + __shfl_xor(snd, 8); } }
        { const bool up = (c & 4) != 0;
#pragma unroll
          for (int i = 0; i < 8; ++i) { const float snd = up ? r16[i] : r16[i + 8], kp = up ? r16[i + 8] : r16[i]; r8[i] = kp + __shfl_xor(snd, 4); } }
        { const bool up = (c & 2) != 0;
#pragma unroll
          for (int i = 0; i < 4; ++i) { const float snd = up ? r8[i] : r8[i + 4], kp = up ? r8[i + 4] : r8[i]; r4[i] = kp + __shfl_xor(snd, 2); } }
        { const bool up = (c & 1) != 0;
#pragma unroll
          for (int i = 0; i < 2; ++i) { const float snd = up ? r4[i] : r4[i + 2], kp = up ? r4[i + 2] : r4[i]; r2[i] = kp + __shfl_xor(snd, 1); } }
        *(float2*)(PART + (size_t)t * 128 + 2 * lane) = make_float2(r2[0], r2[1]);
    }
}
__device__ __forceinline__ void peer_act(const Params& p, size_t gt, size_t gs) {
    const f32x4* PART = (const f32x4*)(p.ws + WS_PART); const f32x4* G = (const f32x4*)(p.ws + WS_G); f32x4* A = (f32x4*)(p.ws + WS_ACO);
    const size_t n4 = (size_t)M * 128 / 4;
    for (size_t i = gt; i < n4; i += gs) {
        f32x4 h = PART[i];
#pragma unroll
        for (int x = 1; x < 8; ++x) h = h + PART[i + (size_t)x * n4];
        const f32x4 g = G[i];
        f32x4 a; a.x = gelu_exact(h.x) * g.x; a.y = gelu_exact(h.y) * g.y; a.z = gelu_exact(h.z) * g.z; a.w = gelu_exact(h.w) * g.w;
        A[i] = a;
    }
}
__device__ __forceinline__ void peer_spmm(const Params& p, int bx, int wave, int lane) {
    const int x = bx & 7, j = bx >> 3, c = lane & 15, q = lane >> 4;
    const bf16_t* VT = (const bf16_t*)(p.ws + WS_VTB) + 128 * x + 8 * c;
    const int* IDS = (const int*)(p.ws + WS_IDS); const float* A = (const float*)(p.ws + WS_ACO);
    float* FFN = (float*)(p.ws + WS_FFN) + 128 * x + 8 * c;
    for (int tt = 0; tt < 64; ++tt) {
        const int t = 512 * j + 64 * wave + tt;
        const int* idp = IDS + (size_t)t * 128 + 32 * q; const float* ap = A + (size_t)t * 128 + 32 * q;
        float acc[8];
#pragma unroll
        for (int i = 0; i < 8; ++i) acc[i] = 0.f;
#pragma unroll
        for (int g = 0; g < 8; ++g) {
            const int4 id4 = *(const int4*)(idp + 4 * g); const f32x4 a4 = *(const f32x4*)(ap + 4 * g);
            const u32x4 v0 = *(const u32x4*)(VT + (size_t)id4.x * 1024), v1 = *(const u32x4*)(VT + (size_t)id4.y * 1024);
            const u32x4 v2 = *(const u32x4*)(VT + (size_t)id4.z * 1024), v3 = *(const u32x4*)(VT + (size_t)id4.w * 1024);
#define PEER_ACC(v, a) do { acc[0] += (a) * __uint_as_float((v).x << 16); acc[1] += (a) * __uint_as_float((v).x & 0xffff0000u); acc[2] += (a) * __uint_as_float((v).y << 16); acc[3] += (a) * __uint_as_float((v).y & 0xffff0000u); \
            acc[4] += (a) * __uint_as_float((v).z << 16); acc[5] += (a) * __uint_as_float((v).z & 0xffff0000u); acc[6] += (a) * __uint_as_float((v).w << 16); acc[7] += (a) * __uint_as_float((v).w & 0xffff0000u); } while (0)
            PEER_ACC(v0, a4.x); PEER_ACC(v1, a4.y); PEER_ACC(v2, a4.z); PEER_ACC(v3, a4.w);
#undef PEER_ACC
        }
#pragma unroll
        for (int i = 0; i < 8; ++i) { acc[i] += __shfl_xor(acc[i], 16); acc[i] += __shfl_xor(acc[i], 32); }
        if (q == 0) { float* o = FFN + (size_t)t * 1024; *(f32x4*)o = (f32x4){acc[0], acc[1], acc[2], acc[3]}; *(f32x4*)(o + 4) = (f32x4){acc[4], acc[5], acc[6], acc[7]}; }
    }
}
__device__ __forceinline__ void stage_ln2(const Params& p, int gw, int ngw, int lane) {
    const float* FFN = (const float*)(p.ws + WS_FFN);
    for (int row = gw; row < M; row += ngw) {
        f32x4* xr = (f32x4*)(p.out + (size_t)row * 1024) + lane; const f32x4* fr = (const f32x4*)(FFN + (size_t)row * 1024) + lane;
        f32x4 v[4]; float s = 0.f;
#pragma unroll
        for (int jj = 0; jj < 4; ++jj) { v[jj] = ALPHA * xr[64 * jj] + fr[64 * jj]; s += (v[jj].x + v[jj].y) + (v[jj].z + v[jj].w); }
        const float mean = wave_sum(s) * (1.f / 1024.f); float s2 = 0.f;
#pragma unroll
        for (int jj = 0; jj < 4; ++jj) { v[jj] = v[jj] - mean; s2 += (v[jj].x * v[jj].x + v[jj].y * v[jj].y) + (v[jj].z * v[jj].z + v[jj].w * v[jj].w); }
        const float rstd = 1.f / sqrtf(wave_sum(s2) * (1.f / 1024.f) + LN_EPS);
#pragma unroll
        for (int jj = 0; jj < 4; ++jj) { const f32x4 g = ((const f32x4*)p.ln2_g)[lane + 64 * jj], bb = ((const f32x4*)p.ln2_b)[lane + 64 * jj];
            xr[64 * jj] = v[jj] * rstd * g + bb; }
    }
}

__device__ __forceinline__ void naive_peer_from_a(const Params& p, int gw, int ngw, int lane) {
    const bf16_t* VT = (const bf16_t*)(p.ws + WS_VTB);
    const int* IDS = (const int*)(p.ws + WS_IDS); const float* A = (const float*)(p.ws + WS_ACO);
    for (int row = gw; row < M; row += ngw) {
        f32x4* xr = (f32x4*)(p.out + (size_t)row * 1024) + lane;
        f32x4 xv[4], acc[4];
#pragma unroll
        for (int j = 0; j < 4; ++j) { xv[j] = xr[64 * j]; acc[j] = (f32x4){0.f, 0.f, 0.f, 0.f}; }
        for (int e = 0; e < 128; ++e) {
            const int id = IDS[(size_t)row * 128 + e]; const float a = A[(size_t)row * 128 + e];
            const u32x2* vr = (const u32x2*)(VT + (size_t)id * 1024) + lane;
#pragma unroll
            for (int j = 0; j < 4; ++j) { const u32x2 u = vr[64 * j];
                acc[j].x += a * bf2f(u.x & 0xffffu); acc[j].y += a * bf2f(u.x >> 16); acc[j].z += a * bf2f(u.y & 0xffffu); acc[j].w += a * bf2f(u.y >> 16); }
        }
        float s = 0.f;
#pragma unroll
        for (int j = 0; j < 4; ++j) { acc[j] = ALPHA * xv[j] + acc[j]; s += (acc[j].x + acc[j].y) + (acc[j].z + acc[j].w); }
        const float mean = wave_sum(s) * (1.f / 1024.f); float s2 = 0.f;
#pragma unroll
        for (int j = 0; j < 4; ++j) { acc[j] = acc[j] - mean; s2 += (acc[j].x * acc[j].x + acc[j].y * acc[j].y) + (acc[j].z * acc[j].z + acc[j].w * acc[j].w); }
        const float rstd = 1.f / sqrtf(wave_sum(s2) * (1.f / 1024.f) + LN_EPS);
#pragma unroll
        for (int j = 0; j < 4; ++j) { const f32x4 g = ((const f32x4*)p.ln2_g)[lane + 64 * j], bb = ((const f32x4*)p.ln2_b)[lane + 64 * j];
            xr[64 * j] = acc[j] * rstd * g + bb; }
    }
}

__device__ __forceinline__ int crow16(int r, int hi) { return (r & 3) + 8 * (r >> 2) + 4 * hi; }
__device__ __forceinline__ bf16x8 acc_frag(const f32x16& a, int s8) {
    u32x4 w; w.x = pg8::cvt_pk_bf16(a[s8 + 0], a[s8 + 1]); w.y = pg8::cvt_pk_bf16(a[s8 + 2], a[s8 + 3]); w.z = pg8::cvt_pk_bf16(a[s8 + 4], a[s8 + 5]); w.w = pg8::cvt_pk_bf16(a[s8 + 6], a[s8 + 7]);
    return __builtin_bit_cast(bf16x8, w);
}
constexpr int MX_KS = 272, MX_VS = 528, MX_VT_OFF = 256 * MX_KS;
__device__ __forceinline__ void mx_attn_phase(const Params& p, unsigned char* lds, int bx) {
    int tid = threadIdx.x; asm volatile("" : "+v"(tid));
    const int lane = tid & 63, wave = __builtin_amdgcn_readfirstlane(tid >> 6), r32 = lane & 31, h2 = lane >> 5;
    const int b = bx >> 7, hh = (bx >> 5) & 3, qb = bx & 31;
    const bf16_t* KV = (const bf16_t*)(p.ws + WS_MEMKV) + (size_t)b * MEMLEN * 1024 + hh * 128;
#pragma unroll
    for (int i = 0; i < 8; ++i) {
        const int idx = tid + 512 * i, row = idx >> 4, ch = idx & 15;
        const u32x4 kk = *(const u32x4*)(KV + (size_t)row * 1024 + ch * 8);
        *(u32x4*)(lds + row * MX_KS + ch * 16) = kk;
        const u32x4 vv = *(const u32x4*)(KV + (size_t)row * 1024 + 512 + ch * 8);
        bf16_t* vt = (bf16_t*)(lds + MX_VT_OFF) + (ch * 8) * (MX_VS / 2) + row;
        vt[0 * (MX_VS / 2)] = (bf16_t)(vv.x & 0xffffu); vt[1 * (MX_VS / 2)] = (bf16_t)(vv.x >> 16); vt[2 * (MX_VS / 2)] = (bf16_t)(vv.y & 0xffffu); vt[3 * (MX_VS / 2)] = (bf16_t)(vv.y >> 16);
        vt[4 * (MX_VS / 2)] = (bf16_t)(vv.z & 0xffffu); vt[5 * (MX_VS / 2)] = (bf16_t)(vv.z >> 16); vt[6 * (MX_VS / 2)] = (bf16_t)(vv.w & 0xffffu); vt[7 * (MX_VS / 2)] = (bf16_t)(vv.w >> 16);
    }
    __syncthreads();
    const size_t qrow = (size_t)b * SEQ + qb * 256 + wave * 32;
    const bf16_t* Qp = (const bf16_t*)(p.ws + WS_MXQ) + (qrow + r32) * 512 + hh * 128 + 8 * h2;
    bf16x8 qr[8];
#pragma unroll
    for (int ks = 0; ks < 8; ++ks) qr[ks] = *(const bf16x8*)(Qp + 16 * ks);
    f32x16 o[4];
#pragma unroll
    for (int dt = 0; dt < 4; ++dt)
#pragma unroll
        for (int r = 0; r < 16; ++r) o[dt][r] = 0.f;
    float m = -1e30f, l = 0.f;
#pragma unroll 1
    for (int half = 0; half < 2; ++half) {
        f32x16 st[4];
#pragma unroll
        for (int kt = 0; kt < 4; ++kt) {
#pragma unroll
            for (int r = 0; r < 16; ++r) st[kt][r] = 0.f;
            const unsigned char* kp = lds + (half * 128 + kt * 32 + r32) * MX_KS + 16 * h2;
#pragma unroll
            for (int ks = 0; ks < 8; ++ks) st[kt] = __builtin_amdgcn_mfma_f32_32x32x16_bf16(*(const bf16x8*)(kp + 32 * ks), qr[ks], st[kt], 0, 0, 0);
        }
        float mx = st[0][0];
#pragma unroll
        for (int kt = 0; kt < 4; ++kt)
#pragma unroll
            for (int r = 0; r < 16; ++r) mx = fmaxf(mx, st[kt][r]);
        mx = fmaxf(mx, __shfl_xor(mx, 32));
        const float mn = fmaxf(m, mx), alpha = exp2f(m - mn);
        m = mn;
        float ls = 0.f;
#pragma unroll
        for (int kt = 0; kt < 4; ++kt)
#pragma unroll
            for (int r = 0; r < 16; ++r) { st[kt][r] = exp2f(st[kt][r] - mn); ls += st[kt][r]; }
        l = l * alpha + ls;
#pragma unroll
        for (int dt = 0; dt < 4; ++dt)
#pragma unroll
            for (int r = 0; r < 16; ++r) o[dt][r] *= alpha;
#pragma unroll
        for (int kt = 0; kt < 4; ++kt)
#pragma unroll
            for (int s2 = 0; s2 < 2; ++s2) {
                const bf16x8 bfrag = acc_frag(st[kt], 8 * s2);
                const int kbase = half * 128 + kt * 32 + 16 * s2 + 4 * h2;
#pragma unroll
                for (int dt = 0; dt < 4; ++dt) {
                    const unsigned char* vp = lds + MX_VT_OFF + (dt * 32 + r32) * MX_VS + kbase * 2;
                    const u32x2 lo = *(const u32x2*)vp, hi = *(const u32x2*)(vp + 16);
                    const u32x4 av = {lo.x, lo.y, hi.x, hi.y};
                    o[dt] = __builtin_amdgcn_mfma_f32_32x32x16_bf16(__builtin_bit_cast(bf16x8, av), bfrag, o[dt], 0, 0, 0);
                }
            }
    }
    l += __shfl_xor(l, 32);
    const float inv = 1.0f / l;
    __syncthreads();
    unsigned char* stg = lds + wave * (32 * MX_KS);
#pragma unroll
    for (int dt = 0; dt < 4; ++dt)
#pragma unroll
        for (int r4 = 0; r4 < 4; ++r4) {
            u32x2 w; w.x = pg8::cvt_pk_bf16(o[dt][4 * r4 + 0] * inv, o[dt][4 * r4 + 1] * inv); w.y = pg8::cvt_pk_bf16(o[dt][4 * r4 + 2] * inv, o[dt][4 * r4 + 3] * inv);
            *(u32x2*)(stg + r32 * MX_KS + (dt * 32 + 8 * r4 + 4 * h2) * 2) = w;
        }
    asm volatile("s_waitcnt lgkmcnt(0)" ::: "memory");
    bf16_t* Op = (bf16_t*)(p.ws + WS_OMX) + qrow * 512 + hh * 128;
#pragma unroll
    for (int i = 0; i < 8; ++i) { const int row = i * 4 + (lane >> 4), ch = lane & 15;
        *(u32x4*)(Op + (size_t)row * 512 + ch * 8) = *(const u32x4*)(stg + row * MX_KS + ch * 16); }
    __syncthreads();
}
constexpr int SB_VS = 80;
__device__ __forceinline__ void sb_attn_unit(const Params& p, unsigned char* lds, int unit) {
    int tid = threadIdx.x; asm volatile("" : "+v"(tid));
    const int lane = tid & 63, wave = __builtin_amdgcn_readfirstlane(tid >> 6), r32 = lane & 31, h2 = lane >> 5;
    const int b = unit >> 8, hh = (unit >> 5) & 7, qb = unit & 31;
    const int q0 = qb * 256 + wave * 32;
    const bf16_t* Kb = (const bf16_t*)(p.ws + WS_SBK) + (size_t)b * SEQ * 512 + hh * 64;
    const bf16_t* Vb = (const bf16_t*)(p.ws + WS_SBV) + (size_t)b * SEQ * 512 + hh * 64;
    const bf16_t* Qp = (const bf16_t*)(p.ws + WS_SBQ) + ((size_t)b * SEQ + q0 + r32) * 512 + hh * 64 + 8 * h2;
    unsigned char* vt = lds + wave * 5120;
    bf16x8 qr[4];
#pragma unroll
    for (int ks = 0; ks < 4; ++ks) qr[ks] = *(const bf16x8*)(Qp + 16 * ks);
    f32x16 o[2];
#pragma unroll
    for (int dt = 0; dt < 2; ++dt)
#pragma unroll
        for (int r = 0; r < 16; ++r) o[dt][r] = 0.f;
    float R = 0.f;
    const int t = q0 + r32;
    for (int kb = q0; kb >= 0; kb -= 32) {
        f32x16 st;
#pragma unroll
        for (int r = 0; r < 16; ++r) st[r] = 0.f;
        const bf16_t* kp = Kb + (size_t)(kb + r32) * 512 + 8 * h2;
#pragma unroll
        for (int ks = 0; ks < 4; ++ks) st = __builtin_amdgcn_mfma_f32_32x32x16_bf16(*(const bf16x8*)(kp + 16 * ks), qr[ks], st, 0, 0, 0);
#pragma unroll
        for (int i = 0; i < 4; ++i) { const int idx = lane + 64 * i, key = idx >> 3, ch = idx & 7;
            const u32x4 vv = *(const u32x4*)(Vb + (size_t)(kb + key) * 512 + ch * 8);
            bf16_t* d = (bf16_t*)vt + (ch * 8) * (SB_VS / 2) + key;
            d[0 * (SB_VS / 2)] = (bf16_t)(vv.x & 0xffffu); d[1 * (SB_VS / 2)] = (bf16_t)(vv.x >> 16); d[2 * (SB_VS / 2)] = (bf16_t)(vv.y & 0xffffu); d[3 * (SB_VS / 2)] = (bf16_t)(vv.y >> 16);
            d[4 * (SB_VS / 2)] = (bf16_t)(vv.z & 0xffffu); d[5 * (SB_VS / 2)] = (bf16_t)(vv.z >> 16); d[6 * (SB_VS / 2)] = (bf16_t)(vv.w & 0xffffu); d[7 * (SB_VS / 2)] = (bf16_t)(vv.w >> 16); }
        float sp[16];
#pragma unroll
        for (int r = 0; r < 16; ++r) { const float y = st[r]; const bool act = (kb + crow16(r, h2)) < t;
            sp[r] = act ? (fmaxf(y, 0.f) + __builtin_amdgcn_logf(1.0f + __builtin_amdgcn_exp2f(-fabsf(y)))) : 0.f; }
        float suf[16], gs[4], pg[4];
#pragma unroll
        for (int g = 0; g < 4; ++g) { suf[4 * g + 3] = sp[4 * g + 3]; suf[4 * g + 2] = suf[4 * g + 3] + sp[4 * g + 2]; suf[4 * g + 1] = suf[4 * g + 2] + sp[4 * g + 1]; suf[4 * g + 0] = suf[4 * g + 1] + sp[4 * g + 0]; gs[g] = suf[4 * g]; }
#pragma unroll
        for (int g = 0; g < 4; ++g) pg[g] = __shfl_xor(gs[g], 32);
        float off[4];
        {
          const float pe3 = pg[3], pe2 = pe3 + pg[2], pe1 = pe2 + pg[1], pe0 = pe1 + pg[0];
          const float me3 = 0.f, me2 = gs[3], me1 = me2 + gs[2], me0 = me1 + gs[1];
          off[3] = me3 + (h2 ? 0.f : pe3); off[2] = me2 + (h2 ? pe3 : pe2); off[1] = me1 + (h2 ? pe2 : pe1); off[0] = me0 + (h2 ? pe1 : pe0);
          const float T = pe0 + me0 + gs[0];
#pragma unroll
          for (int r = 0; r < 16; ++r) { const bool act = (kb + crow16(r, h2)) < t; const float c = R + off[r >> 2] + suf[r];
              st[r] = act ? __builtin_amdgcn_exp2f(st[r] - c) : 0.f; }
          R += T; }
        asm volatile("s_waitcnt lgkmcnt(0)" ::: "memory");
#pragma unroll
        for (int s2 = 0; s2 < 2; ++s2) {
            const bf16x8 bfrag = acc_frag(st, 8 * s2);
#pragma unroll
            for (int dt = 0; dt < 2; ++dt) {
                const unsigned char* vp = vt + (dt * 32 + r32) * SB_VS + (16 * s2 + 4 * h2) * 2;
                const u32x2 lo = *(const u32x2*)vp, hi = *(const u32x2*)(vp + 16);
                const u32x4 av = {lo.x, lo.y, hi.x, hi.y};
                o[dt] = __builtin_amdgcn_mfma_f32_32x32x16_bf16(__builtin_bit_cast(bf16x8, av), bfrag, o[dt], 0, 0, 0);
            }
        }
        asm volatile("s_waitcnt lgkmcnt(0)" ::: "memory");
        if (__all(R > SB_EXIT_BITS)) break;
    }
#pragma unroll
    for (int dt = 0; dt < 2; ++dt)
#pragma unroll
        for (int r4 = 0; r4 < 4; ++r4) {
            u32x2 w; w.x = pg8::cvt_pk_bf16(o[dt][4 * r4 + 0], o[dt][4 * r4 + 1]); w.y = pg8::cvt_pk_bf16(o[dt][4 * r4 + 2], o[dt][4 * r4 + 3]);
            *(u32x2*)(vt + r32 * 144 + (dt * 32 + 8 * r4 + 4 * h2) * 2) = w;
        }
    asm volatile("s_waitcnt lgkmcnt(0)" ::: "memory");
    bf16_t* Op = (bf16_t*)(p.ws + WS_OSB) + ((size_t)b * SEQ + q0) * 512 + hh * 64;
#pragma unroll
    for (int i = 0; i < 4; ++i) { const int row = i * 8 + (lane >> 3), ch = lane & 7;
        *(u32x4*)(Op + (size_t)row * 512 + ch * 8) = *(const u32x4*)(vt + row * 144 + ch * 16); }
    asm volatile("s_waitcnt lgkmcnt(0)" ::: "memory");
}

#define LAS __attribute__((address_space(3)))
#define XB_TMO      128
#define XB_XCNT(j)  (256  + 64 * (j))
#define XB_XSUB(j)  (1280 + 64 * (j))
#define XB_XGEN(j)  (2304 + 64 * (j))
#define XB_TOP      3328
#define XB_TOPGEN   3392
#define XCD_BAR_WORDS 3456
#define XB_SPIN_CAP (1u << 18)

__device__ __forceinline__ unsigned xb_ld(unsigned* p)              { return __hip_atomic_load(p, __ATOMIC_RELAXED, __HIP_MEMORY_SCOPE_AGENT); }
__device__ __forceinline__ unsigned xb_add(unsigned* p, unsigned v) { return __hip_atomic_fetch_add(p, v, __ATOMIC_RELAXED, __HIP_MEMORY_SCOPE_AGENT); }
__device__ __forceinline__ unsigned xb_xcc_id() { return (unsigned)__builtin_amdgcn_s_getreg((3 << 11) | 20) & 0xFu; }
#define XB_SPIN(cond, bar) do { unsigned _sp = 0; while (cond) { __builtin_amdgcn_s_sleep(1); \
    if ((++_sp & 255u) == 0u) { if (xb_ld(&(bar)[XB_TMO])) break; if (_sp > XB_SPIN_CAP) { atomicAdd(&(bar)[XB_TMO], 1u); break; } } } } while (0)

struct XcdBarrier {
    unsigned* bar; unsigned x;
    volatile LAS unsigned* st;
};

__device__ __forceinline__ XcdBarrier xcd_barrier_post(unsigned* bar, volatile LAS unsigned* st) {
    XcdBarrier b; b.bar = bar; b.x = xb_xcc_id(); b.st = st;
    if (threadIdx.x == 0) (void)xb_add(&bar[XB_XCNT(b.x)], 1u);
    return b;
}
__device__ __forceinline__ void xcd_barrier_complete(unsigned* bar, unsigned x, unsigned& nloc, unsigned& nx) {
    const unsigned G = gridDim.x * gridDim.y * gridDim.z;
    unsigned sum, cnt, mine, sp = 0u;
    for (;;) {
        sum = 0u; cnt = 0u; mine = 0u;
#pragma unroll
        for (unsigned j = 0; j < 16; ++j) { const unsigned c = xb_ld(&bar[XB_XCNT(j)]); sum += c; cnt += (c > 0u) ? 1u : 0u; mine = (j == x) ? c : mine; }
        if (sum == G) break;
        __builtin_amdgcn_s_sleep(1);
        if ((++sp & 255u) == 0u) { if (xb_ld(&bar[XB_TMO])) break; if (sp > XB_SPIN_CAP) { atomicAdd(&bar[XB_TMO], 1u); break; } }
    }
    nloc = mine > 0u ? mine : 1u; nx = cnt > 0u ? cnt : 1u;
}

__device__ __forceinline__ void xcd_barrier(const XcdBarrier& b) {
    asm volatile("s_waitcnt vmcnt(0)" ::: "memory");
    __syncthreads();
    if (threadIdx.x == 0) {
        unsigned* bar = b.bar;
        __builtin_amdgcn_s_waitcnt(0);
        unsigned nloc = b.st[0], nx = b.st[1];
        if (nloc == 0u) { xcd_barrier_complete(bar, b.x, nloc, nx); b.st[0] = nloc; b.st[1] = nx; }
        const unsigned old = xb_add(&bar[XB_XSUB(b.x)], 1u);
        const unsigned gen = old / nloc;
        if (old + 1u == (gen + 1u) * nloc) {
            __builtin_amdgcn_fence(__ATOMIC_RELEASE, "agent");
            asm volatile("s_waitcnt vmcnt(0)" ::: "memory");
            const unsigned og = xb_add(&bar[XB_TOP], 1u);
            const unsigned tg = og / nx;
            if (og + 1u == (tg + 1u) * nx) xb_add(&bar[XB_TOPGEN], 1u);
            else XB_SPIN(xb_ld(&bar[XB_TOPGEN]) == tg, bar);
            __builtin_amdgcn_fence(__ATOMIC_ACQUIRE, "agent");
            xb_add(&bar[XB_XGEN(b.x)], 1u);
            asm volatile("s_waitcnt vmcnt(0)" ::: "memory");
        } else {
            XB_SPIN(xb_ld(&bar[XB_XGEN(b.x)]) == gen, bar);
            __builtin_amdgcn_fence(__ATOMIC_ACQUIRE, "agent");
            asm volatile("s_waitcnt vmcnt(0)" ::: "memory");
        }
    }
    __syncthreads();
}

constexpr int NTHREADS = 512, NWAVES = 8;
constexpr int LDS_BYTES = 147456;

__global__ void __launch_bounds__(NTHREADS, 2) mega(Params p) {
    extern __shared__ __attribute__((aligned(16))) unsigned char lds[];
    cg::grid_group grid = cg::this_grid();
    typedef pg8::bf16_t pbf;
    volatile LAS unsigned* MISC = (volatile LAS unsigned*)((LAS unsigned char*)lds + 147200);
    if (threadIdx.x < 32) MISC[threadIdx.x] = 0u;
    __syncthreads();
    XcdBarrier xbar = xcd_barrier_post((unsigned*)(p.ws + WS_CTL) + 4096, MISC + 8);
#define GSYNC() xcd_barrier(xbar)
#define PHASE_IDS() int tid = threadIdx.x; asm volatile("" : "+v"(tid)); const int lane = tid & 63, wave = __builtin_amdgcn_readfirstlane(tid >> 6); \
    const int G = gridDim.x, bx = blockIdx.x; const size_t gt = (size_t)bx * NTHREADS + tid, gs = (size_t)G * NTHREADS; const int gw = bx * NWAVES + wave, ngw = G * NWAVES; \
    PG8_LAS unsigned char* ldsl = (PG8_LAS unsigned char*)lds; (void)lane; (void)gt; (void)gs; (void)gw; (void)ngw; (void)ldsl;

#if !defined(SKIP_P0)
    { PHASE_IDS()
    stage_transposes(p, (float*)(lds + wave * 8448), gw, ngw, lane);
    convert_bf16(p.x, (bf16_t*)(p.ws + WS_XB), (size_t)M * 1024, gt, gs);
    convert_bf16(p.mem, (bf16_t*)(p.ws + WS_MEMB), (size_t)512 * 1024, gt, gs);
    convert_bf16(p.sub_keys, (bf16_t*)(p.ws + WS_SUBK), (size_t)16 * 128 * 128, gt, gs);
    stage_rope(p, gt, gs);
    }
#endif
    grid.sync();
#if !defined(SKIP_P1)
    { PHASE_IDS()
#if defined(NAIVE_P1)
    { EpiProj e{p.ws};
      naive_gemm((const bf16_t*)(p.ws + WS_XB), 1024, (const bf16_t*)(p.ws + WS_WIN), 1024, M, INW, 1024, e, gw, ngw, lane);
      EpiPlain e2{(bf16_t*)(p.ws + WS_MEMKV), 1024};
      naive_gemm((const bf16_t*)(p.ws + WS_MEMB), 1024, (const bf16_t*)(p.ws + WS_WMEMKV), 1024, 512, 1024, 1024, e2, gw, ngw, lane); }
#else
    { pg8::Gemm g{(const pbf*)(p.ws + WS_XB), (const pbf*)(p.ws + WS_WIN), M, INW, 1024}; pg8::StaticOrder S; S.init(M, INW, G, bx);
      pg8::EpiProjF E{p.ws};
      pg8::gemm_phase<pg8::EpiProjF, pg8::StaticOrder, PG8_ALIGN, PG8_SP2>(ldsl, g, S, E);
      pg8::Gemm g2{(const pbf*)(p.ws + WS_MEMB), (const pbf*)(p.ws + WS_WMEMKV), 512, 1024, 1024}; pg8::MemOrder S2{bx};
      pg8::EpiBf16<0> E2{(pbf*)(p.ws + WS_MEMKV), 1024, nullptr, 0, 0, 1.f};
      pg8::gemm_phase<pg8::EpiBf16<0>, pg8::MemOrder, PG8_ALIGN, PG8_SP2>(ldsl, g2, S2, E2); }
#endif
    }
#endif
    GSYNC();
#if !defined(SKIP_P2)
    { PHASE_IDS()
    { const attn_body::AttnTensors AT{(const attn_body::bf16*)(p.ws + WS_DFQ), (const attn_body::bf16*)(p.ws + WS_DFK), (const attn_body::bf16*)(p.ws + WS_DFV), (attn_body::bf16*)(p.ws + WS_ODF16)};
      const attn_body::StaticOrder S(G, bx);
#if defined(NAIVE_DF)
      (void)AT; (void)S; naive_df_attn(p, gt, gs);
#else
      attn_body::attn_phase<attn_body::StaticOrder>((char*)lds, AT, S);
#endif
    }
    }
#endif
    GSYNC();
#if !defined(SKIP_P3)
    { PHASE_IDS()
    stage_df_combine(p, gw, ngw, lane);
#if defined(NAIVE_SB)
    naive_sb_attn(p, gt, gs);
#else
    for (int u = bx; u < 512; u += G) sb_attn_unit(p, lds, u);
    __syncthreads();
#endif
#if defined(NAIVE_MX)
    naive_mx_attn(p, gt, gs);
#else
    if (G == 256) mx_attn_phase(p, lds, bx); else naive_mx_attn(p, gt, gs);
#endif
    }
#endif
    GSYNC();
#if !defined(SKIP_P4)
    { PHASE_IDS()
#if defined(NAIVE_P4)
    { EpiGate e{(bf16_t*)(p.ws + WS_GATES), p.b_gate};
      naive_gemm((const bf16_t*)(p.ws + WS_XB), 1024, (const bf16_t*)(p.ws + WS_WGATE), 1024, M, 3072, 1024, e, gw, ngw, lane); }
    GSYNC();
    for (int b = 0; b < 3; ++b) {
        const size_t osrc = (b == 0) ? WS_OSB : (b == 1 ? WS_ODF : WS_OMX);
        EpiBranch e{(const bf16_t*)(p.ws + WS_GATES), b * 1024, p.out, (bf16_t*)(p.ws + WS_MERGEDB), b};
        naive_gemm((const bf16_t*)(p.ws + osrc), 512, (const bf16_t*)(p.ws + WS_WBR + (size_t)b * MiB), 512, M, 1024, 512, e, gw, ngw, lane);
    }
#else
    { pg8::StaticOrder S1; S1.init(M, 1024, G, bx); pg8::Unit base; const bool has = S1.next(0, base);
      if (has) {
#if defined(NAIVE_GATES)
        { EpiGate e{(bf16_t*)(p.ws + WS_GATES), p.b_gate};
          naive_gemm((const bf16_t*)(p.ws + WS_XB), 1024, (const bf16_t*)(p.ws + WS_WGATE), 1024, M, 3072, 1024, e, gw, ngw, lane); }
        GSYNC();
#else
        pg8::Gemm gg{(const pbf*)(p.ws + WS_XB), (const pbf*)(p.ws + WS_WGATE), M, 3072, 1024}; pg8::GateOrder SG{base};
        pg8::EpiGateF EG{(pbf*)(p.ws + WS_GATES), p.b_gate};
        pg8::gemm_phase<pg8::EpiGateF, pg8::GateOrder, PG8_ALIGN, PG8_SP2>(ldsl, gg, SG, EG);
#endif
#define P4_SEAM() do { asm volatile("s_waitcnt vmcnt(0)" ::: "memory"); __syncthreads(); if (tid < 64) { __builtin_amdgcn_fence(__ATOMIC_ACQUIRE, "agent"); asm volatile("s_waitcnt vmcnt(0)" ::: "memory"); } __syncthreads(); } while (0)
        P4_SEAM();
#if defined(NAIVE_BR)
    for (int b = 0; b < 3; ++b) {
        const size_t osrc = (b == 0) ? WS_OSB : (b == 1 ? WS_ODF : WS_OMX);
        EpiBranch e{(const bf16_t*)(p.ws + WS_GATES), b * 1024, p.out, (bf16_t*)(p.ws + WS_MERGEDB), b};
        naive_gemm((const bf16_t*)(p.ws + osrc), 512, (const bf16_t*)(p.ws + WS_WBR + (size_t)b * MiB), 512, M, 1024, 512, e, gw, ngw, lane);
    }
#else
        const pbf* GT_ = (const pbf*)(p.ws + WS_GATES); pbf* MB = (pbf*)(p.ws + WS_MERGEDB);
        { pg8::Gemm g{(const pbf*)(p.ws + WS_OSB), (const pbf*)(p.ws + WS_WBR), M, 1024, 512}; pg8::EpiBranchF<0> E{GT_, 0, p.out, MB};
          pg8::gemm_phase<pg8::EpiBranchF<0>, pg8::StaticOrder, PG8_ALIGN, PG8_SP2>(ldsl, g, S1, E); }
        P4_SEAM();
        { pg8::Gemm g{(const pbf*)(p.ws + WS_ODF), (const pbf*)(p.ws + WS_WBR + 1 * MiB), M, 1024, 512}; pg8::EpiBranchF<1> E{GT_, 1024, p.out, MB};
          pg8::gemm_phase<pg8::EpiBranchF<1>, pg8::StaticOrder, PG8_ALIGN, PG8_SP2>(ldsl, g, S1, E); }
        P4_SEAM();
        { pg8::Gemm g{(const pbf*)(p.ws + WS_OMX), (const pbf*)(p.ws + WS_WBR + 2 * MiB), M, 1024, 512}; pg8::EpiBranchF<2> E{GT_, 2048, p.out, MB};
          pg8::gemm_phase<pg8::EpiBranchF<2>, pg8::StaticOrder, PG8_ALIGN, PG8_SP2>(ldsl, g, S1, E); }
#endif
      } }
#endif
    }
#endif
    GSYNC();
#if !defined(SKIP_P5)
    { PHASE_IDS()
#if defined(NAIVE_P5)
    { EpiOut e{p.x, p.out};
      naive_gemm((const bf16_t*)(p.ws + WS_MERGEDB), 1024, (const bf16_t*)(p.ws + WS_WOUT), 1024, M, 1024, 1024, e, gw, ngw, lane); }
#else
    { pg8::Gemm g{(const pbf*)(p.ws + WS_MERGEDB), (const pbf*)(p.ws + WS_WOUT), M, 1024, 1024}; pg8::StaticOrder S; S.init(M, 1024, G, bx);
      pg8::EpiOutF E{p.x, p.out};
      pg8::gemm_phase<pg8::EpiOutF, pg8::StaticOrder, PG8_ALIGN, PG8_SP2>(ldsl, g, S, E); }
#endif
    }
#endif
    GSYNC();
#if !defined(SKIP_P6)
    { PHASE_IDS()
    stage_ln1(p, gw, ngw, lane);
    convert_bf16(p.u_tab, (bf16_t*)(p.ws + WS_UTB), (size_t)NEXP * 1024, gt, gs);
    convert_bf16(p.v_tab, (bf16_t*)(p.ws + WS_VTB), (size_t)NEXP * 1024, gt, gs);
    }
#endif
    GSYNC();
#if !defined(SKIP_P7)
    { PHASE_IDS()
#if defined(NAIVE_P7)
    { EpiPlain e{(bf16_t*)(p.ws + WS_QP), 2048};
      naive_gemm((const bf16_t*)(p.ws + WS_X1B), 1024, (const bf16_t*)(p.ws + WS_WQUERY), 1024, M, 2048, 1024, e, gw, ngw, lane); }
#else
    { pg8::Gemm g{(const pbf*)(p.ws + WS_X1B), (const pbf*)(p.ws + WS_WQUERY), M, 2048, 1024}; pg8::StaticOrder S; S.init(M, 2048, G, bx);
      pg8::EpiBf16<0> E{(pbf*)(p.ws + WS_QP), 2048, nullptr, 0, 0, 1.f};
      pg8::gemm_phase<pg8::EpiBf16<0>, pg8::StaticOrder, PG8_ALIGN, PG8_SP2>(ldsl, g, S, E); }
#endif
    }
#endif
    GSYNC();
#if !defined(SKIP_P8)
    { PHASE_IDS()
    naive_routing(p, gt, gs);
    }
#endif
    GSYNC();
#if !defined(SKIP_P9)
    { PHASE_IDS()
#if defined(NAIVE_PEER)
    naive_peer(p, gw, ngw, lane);
#else
    if (G == 256) {
        peer_sddmm(p, bx, wave, lane);
        GSYNC();
        peer_act(p, gt, gs);
        GSYNC();
#if defined(DBG_SPMM_NAIVE)
        naive_peer_from_a(p, gw, ngw, lane);
#else
        peer_spmm(p, bx, wave, lane);
        GSYNC();
        stage_ln2(p, gw, ngw, lane);
#endif
    } else naive_peer(p, gw, ngw, lane);
#endif
    }
#endif
}

extern "C" void kernel_launch(void* const* d_in, const int* in_sizes, int n_in, void* d_out, int out_size, void* d_ws, size_t ws_size, hipStream_t stream) {
    static int grid_blocks = 0;
    if (!grid_blocks) {
        int dev = 0, cus = 0, per_cu = 0;
        hipGetDevice(&dev);
        hipDeviceGetAttribute(&cus, hipDeviceAttributeMultiprocessorCount, dev);
        hipFuncSetAttribute((const void*)mega, hipFuncAttributeMaxDynamicSharedMemorySize, LDS_BYTES);
        hipOccupancyMaxActiveBlocksPerMultiprocessor(&per_cu, (const void*)mega, NTHREADS, LDS_BYTES);
        if (per_cu < 1) per_cu = 1;
        grid_blocks = cus * per_cu;
    }
    Params p{};
    p.x = (const float*)d_in[0]; p.mem = (const float*)d_in[1]; p.pos = (const int*)d_in[2];
    p.w_in = (const float*)d_in[3]; p.w_memkv = (const float*)d_in[4]; p.df_lambda = (const float*)d_in[5]; p.df_norm_g = (const float*)d_in[6];
    p.w_gate = (const float*)d_in[7]; p.b_gate = (const float*)d_in[8]; p.w_br_sb = (const float*)d_in[9]; p.w_br_df = (const float*)d_in[10]; p.w_br_mx = (const float*)d_in[11];
    p.w_out = (const float*)d_in[12]; p.ln1_g = (const float*)d_in[13]; p.ln1_b = (const float*)d_in[14]; p.w_query = (const float*)d_in[15]; p.sub_keys = (const float*)d_in[16];
    p.u_tab = (const float*)d_in[17]; p.v_tab = (const float*)d_in[18]; p.ln2_g = (const float*)d_in[19]; p.ln2_b = (const float*)d_in[20];
    p.out = (float*)d_out; p.ws = (unsigned char*)d_ws;
    hipMemsetAsync((char*)d_ws + WS_CTL, 0, 65536, stream);
    void* args[] = {&p};
    hipError_t e = hipLaunchCooperativeKernel((const void*)mega, dim3(grid_blocks), dim3(NTHREADS), args, LDS_BYTES, stream);
    if (e != hipSuccess) fprintf(stderr, "cooperative launch failed: %s (grid %d)\n", hipGetErrorString(e), grid_blocks);
}
```

```cpp
#include <hip/hip_runtime.h>
#include <cstdint>
#include <cstdio>
#include <hip/hip_cooperative_groups.h>
namespace cg = cooperative_groups;

typedef unsigned short bf16_t;
typedef short bf16x8 __attribute__((ext_vector_type(8)));
typedef float f32x16 __attribute__((ext_vector_type(16)));
typedef float f32x4 __attribute__((ext_vector_type(4)));
typedef unsigned u32x4 __attribute__((ext_vector_type(4)));
typedef unsigned u32x2 __attribute__((ext_vector_type(2)));

constexpr int BATCH = 2, SEQ = 8192, DM = 1024, M = BATCH * SEQ;
constexpr int MEMLEN = 256;
constexpr int INW = 3584;
constexpr int NEXP = 16384;
constexpr float LOG2E = 1.4426950408889634f;
constexpr float C2_64 = 0.125f * LOG2E;
constexpr float C2_128 = 0.08838834764831845f * LOG2E;
constexpr float ALPHA = 1.189207115002721f;
constexpr float LN_EPS = 1e-5f, RMS_EPS = 1e-5f;
constexpr float LAMBDA_INIT = 0.2f;
constexpr float PEER_SU = 128.0f, PEER_SV = 8.0f;

constexpr size_t MiB = 1u << 20;
constexpr size_t WS_CTL = 0;
constexpr size_t WS_ROPE = 1 * MiB;
constexpr size_t WS_WIN = 2 * MiB;
constexpr size_t WS_WGATE = 9 * MiB;
constexpr size_t WS_WMEMKV = 15 * MiB;
constexpr size_t WS_WBR = 17 * MiB;
constexpr size_t WS_WOUT = 20 * MiB;
constexpr size_t WS_WQUERY = 22 * MiB;
constexpr size_t WS_SUBK = 26 * MiB;
constexpr size_t WS_MEMB = 27 * MiB;
constexpr size_t WS_MEMKV = 28 * MiB;
constexpr size_t WS_XB = 32 * MiB;
constexpr size_t WS_SBQ = 64 * MiB, WS_SBK = 80 * MiB, WS_SBV = 96 * MiB;
constexpr size_t WS_DFQ = 112 * MiB, WS_DFK = 128 * MiB, WS_DFV = 144 * MiB, WS_MXQ = 160 * MiB;
constexpr size_t WS_ODF16 = 176 * MiB;
constexpr size_t WS_OSB = 208 * MiB, WS_ODF = 224 * MiB, WS_OMX = 240 * MiB;
constexpr size_t WS_GATES = 64 * MiB;
constexpr size_t WS_MERGEDB = 160 * MiB;
constexpr size_t WS_X1B = 32 * MiB;
constexpr size_t WS_QP = 64 * MiB;
constexpr size_t WS_IDS = 128 * MiB;
constexpr size_t WS_G = 136 * MiB;
constexpr size_t WS_UTB = 160 * MiB;
constexpr size_t WS_VTB = 192 * MiB;

struct Params {
    const float *x, *mem; const int* pos;
    const float *w_in, *w_memkv, *df_lambda, *df_norm_g, *w_gate, *b_gate, *w_br_sb, *w_br_df, *w_br_mx, *w_out;
    const float *ln1_g, *ln1_b, *w_query, *sub_keys, *u_tab, *v_tab, *ln2_g, *ln2_b;
    float* out; unsigned char* ws;
};

__device__ __forceinline__ float bf2f(unsigned v) { return __uint_as_float(v << 16); }
__device__ __forceinline__ unsigned f2bf(float f) { unsigned u = __float_as_uint(f); return (u + 0x7fffu + ((u >> 16) & 1u)) >> 16; }
__device__ __forceinline__ unsigned pk2(float lo, float hi) { return f2bf(lo) | (f2bf(hi) << 16); }
__device__ __forceinline__ float wave_sum(float v) {
#pragma unroll
    for (int o = 1; o < 64; o <<= 1) v += __shfl_xor(v, o);
    return v;
}
__device__ __forceinline__ float gelu_exact(float v) { return 0.5f * v * (1.0f + erff(v * 0.70710678118654752f)); }

__device__ __forceinline__ void transpose_item(const float* W, int K, int N, bf16_t* WT, float* scr, int item, int lane) {
    const int nblk = N / 32, kb = item / nblk, nb = item % nblk, k0 = 64 * kb, n0 = 32 * nb;
#pragma unroll 8
    for (int i = 0; i < 32; ++i) { const int kk = 2 * i + (lane >> 5); scr[kk * 33 + (lane & 31)] = W[(size_t)(k0 + kk) * N + n0 + (lane & 31)]; }
    asm volatile("s_waitcnt lgkmcnt(0)" ::: "memory");
    const int c = lane & 7;
#pragma unroll
    for (int j = 0; j < 4; ++j) { const int n = (lane >> 3) + 8 * j; const float* s = scr + (8 * c) * 33 + n;
        u32x4 o; o.x = pk2(s[0 * 33], s[1 * 33]); o.y = pk2(s[2 * 33], s[3 * 33]); o.z = pk2(s[4 * 33], s[5 * 33]); o.w = pk2(s[6 * 33], s[7 * 33]);
        *(u32x4*)(WT + (size_t)(n0 + n) * K + k0 + 8 * c) = o; }
    asm volatile("s_waitcnt lgkmcnt(0)" ::: "memory");
}
__device__ __forceinline__ void stage_transposes(const Params& p, float* scr, int gw, int ngw, int lane) {
    struct TJ { const float* W; int K, N; size_t off; };
    const TJ jobs[8] = {
        {p.w_in, 1024, 3584, WS_WIN}, {p.w_gate, 1024, 3072, WS_WGATE}, {p.w_memkv, 1024, 1024, WS_WMEMKV},
        {p.w_br_sb, 512, 1024, WS_WBR}, {p.w_br_df, 512, 1024, WS_WBR + 1 * MiB}, {p.w_br_mx, 512, 1024, WS_WBR + 2 * MiB},
        {p.w_out, 1024, 1024, WS_WOUT}, {p.w_query, 1024, 2048, WS_WQUERY}};
    int base = 0;
#pragma unroll
    for (int j = 0; j < 8; ++j) {
        const int items = (jobs[j].K / 64) * (jobs[j].N / 32);
        int first = ((gw - base) % ngw + ngw) % ngw;
        for (int it = first; it < items; it += ngw) transpose_item(jobs[j].W, jobs[j].K, jobs[j].N, (bf16_t*)(p.ws + jobs[j].off), scr, it, lane);
        base += items;
    }
}
__device__ __forceinline__ void convert_bf16(const float* src, bf16_t* dst, size_t n, size_t gtid, size_t gsize) {
    const size_t n4 = n / 4;
    for (size_t i = gtid; i < n4; i += gsize) { const f32x4 v = ((const f32x4*)src)[i]; u32x2 o; o.x = pk2(v.x, v.y); o.y = pk2(v.z, v.w); ((u32x2*)dst)[i] = o; }
}
__device__ __forceinline__ void stage_rope(const Params& p, size_t gtid, size_t gsize) {
    const double inv[8] = {1.0, 0.19392274474868576, 0.03760603093086393, 0.007292664737217109, 0.001414213562373095, 0.0002742481756762073, 5.318295896944988e-05, 1.031338537721246e-05};
    float2* tab = (float2*)(p.ws + WS_ROPE);
    for (size_t i = gtid; i < (size_t)M * 8; i += gsize) {
        const int row = (int)(i >> 3), j = (int)(i & 7);
        double iv = inv[0];
#pragma unroll
        for (int q = 1; q < 8; ++q) iv = (j == q) ? inv[q] : iv;
        const double a = (double)p.pos[row] * iv;
        double rev = a * 0.15915494309189535;
        rev -= floor(rev);
        const float rf = (float)rev;
        tab[i] = make_float2(__builtin_amdgcn_cosf(rf), __builtin_amdgcn_sinf(rf));
    }
}

template <class Epi>
__device__ __forceinline__ void naive_gemm(const bf16_t* A, int lda, const bf16_t* Bt, int ldb, int Mr, int N, int K, const Epi& epi, int gw, int ngw, int lane) {
    const int r = lane & 31, h = lane >> 5;
    const int tnc = N / 32, ntiles = (Mr / 32) * tnc;
    for (int t = gw; t < ntiles; t += ngw) {
        const int tm = t / tnc, tn = t % tnc;
        const bf16_t* ap = A + (size_t)(tm * 32 + r) * lda + 8 * h;
        const bf16_t* bp = Bt + (size_t)(tn * 32 + r) * ldb + 8 * h;
        f32x16 acc;
#pragma unroll
        for (int i = 0; i < 16; ++i) acc[i] = 0.f;
        for (int k = 0; k < K; k += 16) {
            const bf16x8 a = *(const bf16x8*)(ap + k); const bf16x8 b = *(const bf16x8*)(bp + k);
            acc = __builtin_amdgcn_mfma_f32_32x32x16_bf16(a, b, acc, 0, 0, 0);
        }
        epi(acc, tm * 32, tn * 32, r, h);
    }
}
#define ACC_ROW(row0, i, h) ((row0) + ((i) & 3) + 8 * ((i) >> 2) + 4 * (h))

struct EpiProj {
    unsigned char* ws;
    __device__ __forceinline__ void operator()(const f32x16& acc, int row0, int col0, int r, int h) const {
        const int region = col0 >> 9;
        const int cc = (col0 & 511) + r;
        const size_t offs[7] = {WS_SBQ, WS_SBK, WS_SBV, WS_DFQ, WS_DFK, WS_DFV, WS_MXQ};
        size_t off = offs[0];
#pragma unroll
        for (int q = 1; q < 7; ++q) off = (region == q) ? offs[q] : off;
        bf16_t* dst = (bf16_t*)(ws + off);
        const float2* rope = (const float2*)(ws + WS_ROPE);
        const float scale = (region == 0 || region == 3) ? C2_64 : (region == 6 ? C2_128 : 1.0f);
        const bool rot = (region == 3 || region == 4);
        const int d = cc & 63;
#pragma unroll
        for (int i = 0; i < 16; ++i) {
            const int row = ACC_ROW(row0, i, h);
            float v = acc[i];
            const float partner = __shfl_xor(v, 8);
            if (rot && d < 16) {
                const float2 cs = rope[(size_t)row * 8 + (d & 7)];
                v = (d < 8) ? (v * cs.x - partner * cs.y) : (v * cs.x + partner * cs.y);
            }
            dst[(size_t)row * 512 + cc] = (bf16_t)f2bf(v * scale);
        }
    }
};
struct EpiPlain {
    bf16_t* dst; int ldc;
    __device__ __forceinline__ void operator()(const f32x16& acc, int row0, int col0, int r, int h) const {
#pragma unroll
        for (int i = 0; i < 16; ++i) dst[(size_t)ACC_ROW(row0, i, h) * ldc + col0 + r] = (bf16_t)f2bf(acc[i]);
    }
};
struct EpiGate {
    bf16_t* dst; const float* bias;
    __device__ __forceinline__ void operator()(const f32x16& acc, int row0, int col0, int r, int h) const {
        const float b = bias[col0 + r];
#pragma unroll
        for (int i = 0; i < 16; ++i) { const float z = acc[i] + b; dst[(size_t)ACC_ROW(row0, i, h) * 3072 + col0 + r] = (bf16_t)f2bf(1.0f / (1.0f + __expf(-z))); }
    }
};
struct EpiBranch {
    const bf16_t* gates; int gcol; float* m32; bf16_t* mb; int mode;
    __device__ __forceinline__ void operator()(const f32x16& acc, int row0, int col0, int r, int h) const {
#pragma unroll
        for (int i = 0; i < 16; ++i) { const size_t row = ACC_ROW(row0, i, h); const int c = col0 + r;
            const float g = bf2f(gates[row * 3072 + gcol + c]); float v = g * acc[i];
            if (mode > 0) v += m32[row * 1024 + c];
            if (mode < 2) m32[row * 1024 + c] = v; else mb[row * 1024 + c] = (bf16_t)f2bf(v); }
    }
};
struct EpiOut {
    const float* x; float* y;
    __device__ __forceinline__ void operator()(const f32x16& acc, int row0, int col0, int r, int h) const {
#pragma unroll
        for (int i = 0; i < 16; ++i) { const size_t o = (size_t)ACC_ROW(row0, i, h) * 1024 + col0 + r; y[o] = ALPHA * x[o] + acc[i]; }
    }
};

__device__ __forceinline__ void naive_df_attn(const Params& p, size_t gtid, size_t gsize) {
    const bf16_t* Q = (const bf16_t*)(p.ws + WS_DFQ); const bf16_t* Kb = (const bf16_t*)(p.ws + WS_DFK); const bf16_t* Vb = (const bf16_t*)(p.ws + WS_DFV);
    bf16_t* O = (bf16_t*)(p.ws + WS_ODF16);
    for (size_t idx = gtid; idx < (size_t)16 * M; idx += gsize) {
        const int t = (int)(idx % SEQ); const int bg = (int)(idx / SEQ); const int g = bg % 16, b = bg / 16;
        const int hh = g >> 2, mm = (g >> 1) & 1, vh = g & 1;
        const int qcol = (hh * 2 + mm) * 64, vcol = (hh * 2 + vh) * 64;
        const size_t row = (size_t)b * SEQ + t;
        float q[64], o[64];
#pragma unroll
        for (int d = 0; d < 64; ++d) { q[d] = bf2f(Q[row * 512 + qcol + d]); o[d] = 0.f; }
        float mx = -1e30f, l = 0.f;
        const int tmax = __shfl(t, 63);
        for (int s = 0; s <= tmax; ++s) {
            const bf16_t* kr = Kb + ((size_t)b * SEQ + s) * 512 + qcol;
            float y = 0.f;
#pragma unroll
            for (int d8 = 0; d8 < 8; ++d8) { const u32x4 kk = *(const u32x4*)(kr + d8 * 8);
                y += q[d8 * 8 + 0] * bf2f(kk.x & 0xffffu) + q[d8 * 8 + 1] * bf2f(kk.x >> 16) + q[d8 * 8 + 2] * bf2f(kk.y & 0xffffu) + q[d8 * 8 + 3] * bf2f(kk.y >> 16)
                   + q[d8 * 8 + 4] * bf2f(kk.z & 0xffffu) + q[d8 * 8 + 5] * bf2f(kk.z >> 16) + q[d8 * 8 + 6] * bf2f(kk.w & 0xffffu) + q[d8 * 8 + 7] * bf2f(kk.w >> 16); }
            if (s > t) y = -INFINITY;
            const float mn = fmaxf(mx, y), al = exp2f(mx - mn), pp = exp2f(y - mn);
            mx = mn; l = l * al + pp;
            const bf16_t* vr = Vb + ((size_t)b * SEQ + s) * 512 + vcol;
#pragma unroll
            for (int d8 = 0; d8 < 8; ++d8) { const u32x4 vv = *(const u32x4*)(vr + d8 * 8);
                o[d8 * 8 + 0] = o[d8 * 8 + 0] * al + pp * bf2f(vv.x & 0xffffu); o[d8 * 8 + 1] = o[d8 * 8 + 1] * al + pp * bf2f(vv.x >> 16);
                o[d8 * 8 + 2] = o[d8 * 8 + 2] * al + pp * bf2f(vv.y & 0xffffu); o[d8 * 8 + 3] = o[d8 * 8 + 3] * al + pp * bf2f(vv.y >> 16);
                o[d8 * 8 + 4] = o[d8 * 8 + 4] * al + pp * bf2f(vv.z & 0xffffu); o[d8 * 8 + 5] = o[d8 * 8 + 5] * al + pp * bf2f(vv.z >> 16);
                o[d8 * 8 + 6] = o[d8 * 8 + 6] * al + pp * bf2f(vv.w & 0xffffu); o[d8 * 8 + 7] = o[d8 * 8 + 7] * al + pp * bf2f(vv.w >> 16); }
        }
        const float rl = 1.0f / l;
#pragma unroll
        for (int d = 0; d < 64; d += 2) *(unsigned*)(O + row * 1024 + g * 64 + d) = pk2(o[d] * rl, o[d + 1] * rl);
    }
}
constexpr float SB_EXIT_BITS = 48.0f;
__device__ __forceinline__ void naive_sb_attn(const Params& p, size_t gtid, size_t gsize) {
    const bf16_t* Q = (const bf16_t*)(p.ws + WS_SBQ); const bf16_t* Kb = (const bf16_t*)(p.ws + WS_SBK); const bf16_t* Vb = (const bf16_t*)(p.ws + WS_SBV);
    bf16_t* O = (bf16_t*)(p.ws + WS_OSB);
    for (size_t idx = gtid; idx < (size_t)8 * M; idx += gsize) {
        const int t = (int)(idx % SEQ); const int bh = (int)(idx / SEQ); const int hh = bh % 8, b = bh / 8;
        const int col = hh * 64;
        const size_t row = (size_t)b * SEQ + t;
        float q[64], o[64];
#pragma unroll
        for (int d = 0; d < 64; ++d) { q[d] = bf2f(Q[row * 512 + col + d]); o[d] = 0.f; }
        float R = 0.f;
        const int tmax = __shfl(t, 63);
        for (int s = tmax - 1; s >= 0; --s) {
            const bf16_t* kr = Kb + ((size_t)b * SEQ + s) * 512 + col;
            float y = 0.f;
#pragma unroll
            for (int d8 = 0; d8 < 8; ++d8) { const u32x4 kk = *(const u32x4*)(kr + d8 * 8);
                y += q[d8 * 8 + 0] * bf2f(kk.x & 0xffffu) + q[d8 * 8 + 1] * bf2f(kk.x >> 16) + q[d8 * 8 + 2] * bf2f(kk.y & 0xffffu) + q[d8 * 8 + 3] * bf2f(kk.y >> 16)
                   + q[d8 * 8 + 4] * bf2f(kk.z & 0xffffu) + q[d8 * 8 + 5] * bf2f(kk.z >> 16) + q[d8 * 8 + 6] * bf2f(kk.w & 0xffffu) + q[d8 * 8 + 7] * bf2f(kk.w >> 16); }
            const bool act = s < t;
            const float sp = fmaxf(y, 0.f) + log2f(1.0f + exp2f(-fabsf(y)));
            float a = 0.f;
            if (act) { R += sp; a = exp2f(y - R); }
            const bf16_t* vr = Vb + ((size_t)b * SEQ + s) * 512 + col;
#pragma unroll
            for (int d8 = 0; d8 < 8; ++d8) { const u32x4 vv = *(const u32x4*)(vr + d8 * 8);
                o[d8 * 8 + 0] += a * bf2f(vv.x & 0xffffu); o[d8 * 8 + 1] += a * bf2f(vv.x >> 16);
                o[d8 * 8 + 2] += a * bf2f(vv.y & 0xffffu); o[d8 * 8 + 3] += a * bf2f(vv.y >> 16);
                o[d8 * 8 + 4] += a * bf2f(vv.z & 0xffffu); o[d8 * 8 + 5] += a * bf2f(vv.z >> 16);
                o[d8 * 8 + 6] += a * bf2f(vv.w & 0xffffu); o[d8 * 8 + 7] += a * bf2f(vv.w >> 16); }
            if (__all(R > SB_EXIT_BITS)) break;
        }
#pragma unroll
        for (int d = 0; d < 64; d += 2) *(unsigned*)(O + row * 512 + col + d) = pk2(o[d], o[d + 1]);
    }
}
__device__ __forceinline__ void naive_mx_attn(const Params& p, size_t gtid, size_t gsize) {
    const bf16_t* Q = (const bf16_t*)(p.ws + WS_MXQ); const bf16_t* KV = (const bf16_t*)(p.ws + WS_MEMKV);
    bf16_t* O = (bf16_t*)(p.ws + WS_OMX);
    for (size_t idx = gtid; idx < (size_t)8 * M; idx += gsize) {
        const int t = (int)(idx % SEQ); const int bq = (int)(idx / SEQ); const int vh = bq & 1, hh = (bq >> 1) & 3, b = bq >> 3;
        const size_t row = (size_t)b * SEQ + t;
        unsigned qp[64]; float o[64];
#pragma unroll
        for (int d = 0; d < 64; ++d) { qp[d] = *(const unsigned*)(Q + row * 512 + hh * 128 + 2 * d); o[d] = 0.f; }
        float mx = -1e30f, l = 0.f;
        for (int m = 0; m < MEMLEN; ++m) {
            const bf16_t* kr = KV + ((size_t)b * MEMLEN + m) * 1024 + hh * 128;
            float y = 0.f;
#pragma unroll
            for (int d8 = 0; d8 < 16; ++d8) { const u32x4 kk = *(const u32x4*)(kr + d8 * 8);
                y += bf2f(qp[d8 * 4 + 0] & 0xffffu) * bf2f(kk.x & 0xffffu) + bf2f(qp[d8 * 4 + 0] >> 16) * bf2f(kk.x >> 16)
                   + bf2f(qp[d8 * 4 + 1] & 0xffffu) * bf2f(kk.y & 0xffffu) + bf2f(qp[d8 * 4 + 1] >> 16) * bf2f(kk.y >> 16)
                   + bf2f(qp[d8 * 4 + 2] & 0xffffu) * bf2f(kk.z & 0xffffu) + bf2f(qp[d8 * 4 + 2] >> 16) * bf2f(kk.z >> 16)
                   + bf2f(qp[d8 * 4 + 3] & 0xffffu) * bf2f(kk.w & 0xffffu) + bf2f(qp[d8 * 4 + 3] >> 16) * bf2f(kk.w >> 16); }
            const float mn = fmaxf(mx, y), al = exp2f(mx - mn), pp = exp2f(y - mn);
            mx = mn; l = l * al + pp;
            const bf16_t* vr = KV + ((size_t)b * MEMLEN + m) * 1024 + 512 + hh * 128 + vh * 64;
#pragma unroll
            for (int d8 = 0; d8 < 8; ++d8) { const u32x4 vv = *(const u32x4*)(vr + d8 * 8);
                o[d8 * 8 + 0] = o[d8 * 8 + 0] * al + pp * bf2f(vv.x & 0xffffu); o[d8 * 8 + 1] = o[d8 * 8 + 1] * al + pp * bf2f(vv.x >> 16);
                o[d8 * 8 + 2] = o[d8 * 8 + 2] * al + pp * bf2f(vv.y & 0xffffu); o[d8 * 8 + 3] = o[d8 * 8 + 3] * al + pp * bf2f(vv.y >> 16);
                o[d8 * 8 + 4] = o[d8 * 8 + 4] * al + pp * bf2f(vv.z & 0xffffu); o[d8 * 8 + 5] = o[d8 * 8 + 5] * al + pp * bf2f(vv.z >> 16);
                o[d8 * 8 + 6] = o[d8 * 8 + 6] * al + pp * bf2f(vv.w & 0xffffu); o[d8 * 8 + 7] = o[d8 * 8 + 7] * al + pp * bf2f(vv.w >> 16); }
        }
        const float rl = 1.0f / l;
#pragma unroll
        for (int d = 0; d < 64; d += 2) *(unsigned*)(O + row * 512 + hh * 128 + vh * 64 + d) = pk2(o[d] * rl, o[d + 1] * rl);
    }
}
__device__ __forceinline__ void stage_df_combine(const Params& p, int gw, int ngw, int lane) {
    const bf16_t* O16 = (const bf16_t*)(p.ws + WS_ODF16); bf16_t* O = (bf16_t*)(p.ws + WS_ODF);
    const float s01 = wave_sum(p.df_lambda[lane] * p.df_lambda[64 + lane]), s23 = wave_sum(p.df_lambda[128 + lane] * p.df_lambda[192 + lane]);
    const float lam = __expf(s01) - __expf(s23) + LAMBDA_INIT;
    const int hh = lane >> 4, dv = (lane & 15) * 8, vh = dv >> 6, d = dv & 63;
    float gn[8];
#pragma unroll
    for (int j = 0; j < 8; ++j) gn[j] = p.df_norm_g[dv + j] * (1.0f - LAMBDA_INIT);
    for (int row = gw; row < M; row += ngw) {
        const u32x4 a = *(const u32x4*)(O16 + (size_t)row * 1024 + (hh * 4 + vh) * 64 + d);
        const u32x4 b = *(const u32x4*)(O16 + (size_t)row * 1024 + (hh * 4 + 2 + vh) * 64 + d);
        float v[8];
        v[0] = bf2f(a.x & 0xffffu) - lam * bf2f(b.x & 0xffffu); v[1] = bf2f(a.x >> 16) - lam * bf2f(b.x >> 16);
        v[2] = bf2f(a.y & 0xffffu) - lam * bf2f(b.y & 0xffffu); v[3] = bf2f(a.y >> 16) - lam * bf2f(b.y >> 16);
        v[4] = bf2f(a.z & 0xffffu) - lam * bf2f(b.z & 0xffffu); v[5] = bf2f(a.z >> 16) - lam * bf2f(b.z >> 16);
        v[6] = bf2f(a.w & 0xffffu) - lam * bf2f(b.w & 0xffffu); v[7] = bf2f(a.w >> 16) - lam * bf2f(b.w >> 16);
        float ss = 0.f;
#pragma unroll
        for (int j = 0; j < 8; ++j) ss += v[j] * v[j];
        ss += __shfl_xor(ss, 1); ss += __shfl_xor(ss, 2); ss += __shfl_xor(ss, 4); ss += __shfl_xor(ss, 8);
        const float rs = 1.0f / sqrtf(ss * (1.0f / 128.0f) + RMS_EPS);
        u32x4 o; o.x = pk2(v[0] * rs * gn[0], v[1] * rs * gn[1]); o.y = pk2(v[2] * rs * gn[2], v[3] * rs * gn[3]);
        o.z = pk2(v[4] * rs * gn[4], v[5] * rs * gn[5]); o.w = pk2(v[6] * rs * gn[6], v[7] * rs * gn[7]);
        *(u32x4*)(O + (size_t)row * 512 + hh * 128 + dv) = o;
    }
}
__device__ __forceinline__ void stage_ln1(const Params& p, int gw, int ngw, int lane) {
    bf16_t* X1B = (bf16_t*)(p.ws + WS_X1B);
    for (int row = gw; row < M; row += ngw) {
        f32x4* yr = (f32x4*)(p.out + (size_t)row * 1024) + lane;
        f32x4 v[4]; float s = 0.f;
#pragma unroll
        for (int j = 0; j < 4; ++j) { v[j] = yr[64 * j]; s += (v[j].x + v[j].y) + (v[j].z + v[j].w); }
        const float mean = wave_sum(s) * (1.f / 1024.f); float s2 = 0.f;
#pragma unroll
        for (int j = 0; j < 4; ++j) { v[j] = v[j] - mean; s2 += (v[j].x * v[j].x + v[j].y * v[j].y) + (v[j].z * v[j].z + v[j].w * v[j].w); }
        const float rstd = 1.f / sqrtf(wave_sum(s2) * (1.f / 1024.f) + LN_EPS);
#pragma unroll
        for (int j = 0; j < 4; ++j) { const f32x4 g = ((const f32x4*)p.ln1_g)[lane + 64 * j], bb = ((const f32x4*)p.ln1_b)[lane + 64 * j];
            const f32x4 o = v[j] * rstd * g + bb; yr[64 * j] = o;
            u32x2 w; w.x = pk2(o.x, o.y); w.y = pk2(o.z, o.w); ((u32x2*)(X1B + (size_t)row * 1024))[lane + 64 * j] = w; }
    }
}
#define TOPK_INSERT(tv, ti, val, id) do { float v_ = (val); int vi_ = (id); \
    _Pragma("unroll") for (int j_ = 0; j_ < 16; ++j_) { const bool gt_ = v_ > tv[j_]; const float t1_ = gt_ ? tv[j_] : v_; const int t2_ = gt_ ? ti[j_] : vi_; \
        tv[j_] = gt_ ? v_ : tv[j_]; ti[j_] = gt_ ? vi_ : ti[j_]; v_ = t1_; vi_ = t2_; } } while (0)
__device__ __forceinline__ void naive_routing(const Params& p, size_t gtid, size_t gsize) {
    const bf16_t* QP = (const bf16_t*)(p.ws + WS_QP); const bf16_t* SK = (const bf16_t*)(p.ws + WS_SUBK);
    int* IDS = (int*)(p.ws + WS_IDS); float* G = (float*)(p.ws + WS_G);
    for (size_t idx = gtid; idx < (size_t)8 * M; idx += gsize) {
        const int row = (int)(idx % M), hh = (int)(idx / M);
        float tv0[16], tv1[16]; int ti0[16], ti1[16];
#pragma unroll
        for (int j = 0; j < 16; ++j) { tv0[j] = -INFINITY; tv1[j] = -INFINITY; ti0[j] = 0; ti1[j] = 0; }
#pragma unroll
        for (int pp = 0; pp < 2; ++pp) {
            unsigned qp[64];
#pragma unroll
            for (int d = 0; d < 64; ++d) qp[d] = *(const unsigned*)(QP + (size_t)row * 2048 + (hh * 2 + pp) * 128 + 2 * d);
            for (int n = 0; n < 128; ++n) {
                const bf16_t* kr = SK + ((size_t)(hh * 2 + pp) * 128 + n) * 128;
                float y = 0.f;
#pragma unroll
                for (int d8 = 0; d8 < 16; ++d8) { const u32x4 kk = *(const u32x4*)(kr + d8 * 8);
                    y += bf2f(qp[d8 * 4 + 0] & 0xffffu) * bf2f(kk.x & 0xffffu) + bf2f(qp[d8 * 4 + 0] >> 16) * bf2f(kk.x >> 16)
                       + bf2f(qp[d8 * 4 + 1] & 0xffffu) * bf2f(kk.y & 0xffffu) + bf2f(qp[d8 * 4 + 1] >> 16) * bf2f(kk.y >> 16)
                       + bf2f(qp[d8 * 4 + 2] & 0xffffu) * bf2f(kk.z & 0xffffu) + bf2f(qp[d8 * 4 + 2] >> 16) * bf2f(kk.z >> 16)
                       + bf2f(qp[d8 * 4 + 3] & 0xffffu) * bf2f(kk.w & 0xffffu) + bf2f(qp[d8 * 4 + 3] >> 16) * bf2f(kk.w >> 16); }
                if (pp == 0) TOPK_INSERT(tv0, ti0, y, n); else TOPK_INSERT(tv1, ti1, y, n);
            }
        }
        float bv[16]; int bi[16];
#pragma unroll
        for (int j = 0; j < 16; ++j) { bv[j] = -INFINITY; bi[j] = 0; }
#pragma unroll
        for (int k0 = 0; k0 < 16; ++k0)
#pragma unroll
            for (int k1 = 0; k1 < 16; ++k1)
                if ((k0 + 1) * (k1 + 1) <= 16) TOPK_INSERT(bv, bi, tv0[k0] + tv1[k1], ti0[k0] * 128 + ti1[k1]);
        float e[16], sum = 0.f;
#pragma unroll
        for (int j = 0; j < 16; ++j) { e[j] = __expf(bv[j] - bv[0]); sum += e[j]; }
        const float rs = 1.0f / sum;
#pragma unroll
        for (int j = 0; j < 16; ++j) { IDS[(size_t)row * 128 + hh * 16 + j] = bi[j]; G[(size_t)row * 128 + hh * 16 + j] = e[j] * rs; }
    }
}
__device__ __forceinline__ void naive_peer(const Params& p, int gw, int ngw, int lane) {
    const bf16_t* UT = (const bf16_t*)(p.ws + WS_UTB); const bf16_t* VT = (const bf16_t*)(p.ws + WS_VTB);
    const int* IDS = (const int*)(p.ws + WS_IDS); const float* G = (const float*)(p.ws + WS_G);
    for (int row = gw; row < M; row += ngw) {
        f32x4* xr = (f32x4*)(p.out + (size_t)row * 1024) + lane;
        f32x4 xv[4], acc[4];
#pragma unroll
        for (int j = 0; j < 4; ++j) { xv[j] = xr[64 * j]; acc[j] = (f32x4){0.f, 0.f, 0.f, 0.f}; }
        for (int e = 0; e < 128; ++e) {
            const int id = IDS[(size_t)row * 128 + e]; const float gg = G[(size_t)row * 128 + e];
            const u32x2* ur = (const u32x2*)(UT + (size_t)id * 1024) + lane;
            float part = 0.f;
#pragma unroll
            for (int j = 0; j < 4; ++j) { const u32x2 u = ur[64 * j];
                part += xv[j].x * bf2f(u.x & 0xffffu) + xv[j].y * bf2f(u.x >> 16) + xv[j].z * bf2f(u.y & 0xffffu) + xv[j].w * bf2f(u.y >> 16); }
            const float hsum = wave_sum(part);
            const float a = gelu_exact(hsum) * gg;
            const u32x2* vr = (const u32x2*)(VT + (size_t)id * 1024) + lane;
#pragma unroll
            for (int j = 0; j < 4; ++j) { const u32x2 u = vr[64 * j];
                acc[j].x += a * bf2f(u.x & 0xffffu); acc[j].y += a * bf2f(u.x >> 16); acc[j].z += a * bf2f(u.y & 0xffffu); acc[j].w += a * bf2f(u.y >> 16); }
        }
        float s = 0.f;
#pragma unroll
        for (int j = 0; j < 4; ++j) { acc[j] = ALPHA * xv[j] + acc[j]; s += (acc[j].x + acc[j].y) + (acc[j].z + acc[j].w); }
        const float mean = wave_sum(s) * (1.f / 1024.f); float s2 = 0.f;
#pragma unroll
        for (int j = 0; j < 4; ++j) { acc[j] = acc[j] - mean; s2 += (acc[j].x * acc[j].x + acc[j].y * acc[j].y) + (acc[j].z * acc[j].z + acc[j].w * acc[j].w); }
        const float rstd = 1.f / sqrtf(wave_sum(s2) * (1.f / 1024.f) + LN_EPS);
#pragma unroll
        for (int j = 0; j < 4; ++j) { const f32x4 g = ((const f32x4*)p.ln2_g)[lane + 64 * j], bb = ((const f32x4*)p.ln2_b)[lane + 64 * j];
            xr[64 * j] = acc[j] * rstd * g + bb; }
    }
}

namespace pg8 {
#define PG8_LAS __attribute__((address_space(3)))
typedef unsigned short bf16_t;
typedef short bf16x8 __attribute__((ext_vector_type(8)));
typedef float f32x4 __attribute__((ext_vector_type(4)));
typedef unsigned u32x4 __attribute__((ext_vector_type(4)));
constexpr int BM = 256, BK = 64, HALF = 128, HTB = HALF * BK * 2  , STAGE_BYTES = 8 * HTB, NXCD = 8, WGM = 8;

__host__ __device__ __forceinline__ int lds_byte(int r, int c) { const int st = (r >> 4) * 2 + (c >> 5), rr = r & 15, cc = c & 31, ob = rr * 64 + cc * 2; return st * 1024 + (ob ^ (((ob >> 9) & 1) << 5)); }
__host__ __device__ __forceinline__ void stage_rc(int b, int& R, int& C) { const int st = b / 1024, sb = b % 1024, swz = sb ^ (((sb >> 9) & 1) << 5); R = (st >> 1) * 16 + swz / 64; C = (st & 1) * 32 + (swz % 64) / 2; }
__host__ __device__ __forceinline__ int perm32(int rho) { const int n = rho >> 4, i = rho & 15; return 8 * (i >> 2) + 4 * n + (i & 3); }

struct Unit { int pm, pn; };
struct Gemm { const bf16_t* A; const bf16_t* Bt; int M, N, K; };

struct StaticOrder {
    int nM, nN, nwg, G, c;
    __host__ __device__ void init(int M, int N, int G_, int c_) { nM = M / BM; nN = N / BM; nwg = nM * nN; G = G_; c = c_; }
    __host__ __device__ bool next(int i, Unit& u) const {
        const long L = (long)i * G + c; if (L >= nwg) return false;
        int wgid = (int)L; { const int q = nwg / NXCD, r = nwg % NXCD, xcd = wgid % NXCD, off = wgid / NXCD; wgid = (xcd < r ? xcd * (q + 1) : r * (q + 1) + (xcd - r) * q) + off; }
        const int nig = WGM * nN, gid = wgid / nig, fm = gid * WGM, gsz = (nM - fm) < WGM ? (nM - fm) : WGM;
        u.pm = fm + ((wgid % nig) % gsz); u.pn = (wgid % nig) / gsz; return true;
    }
    __device__ __forceinline__ void a_ready(const Unit&) const {}
    __device__ __forceinline__ void done(const Unit&) const {}
};

typedef float f32x2c_t __attribute__((ext_vector_type(2))); typedef __bf16 bf16x2c_t __attribute__((ext_vector_type(2)));
__device__ __forceinline__ unsigned cvt_pk_bf16(float lo, float hi) { f32x2c_t v = {lo, hi}; bf16x2c_t b = __builtin_convertvector(v, bf16x2c_t); return __builtin_bit_cast(unsigned, b); }
typedef float f32x2 __attribute__((ext_vector_type(2)));
__device__ __forceinline__ f32x2 gelu_pk(f32x2 v) {
    const f32x2 av = __builtin_elementwise_abs(v), d = av * 0.2316418882f + 1.0f;
    f32x2 t; t.x = __builtin_amdgcn_rcpf(d.x); t.y = __builtin_amdgcn_rcpf(d.y);
    f32x2 q = t * 0.5307027145f + (-0.7265760135f); q = q * t + 0.7107068705f; q = q * t + (-0.142248368f); q = q * t + 0.127414796f; q = q * t;
    const f32x2 s = (v * v) * (-0.72134752044f);
    f32x2 e; e.x = __builtin_amdgcn_exp2f(s.x); e.y = __builtin_amdgcn_exp2f(s.y);
    const f32x2 m = v * (q * e), r = v - m;
    f32x2 o; o.x = v.x < 0.f ? m.x : r.x; o.y = v.y < 0.f ? m.y : r.y; return o;
}

template <int ACT  > struct EpiBf16 {
    static constexpr bool PERM = true, AFTER_DRAIN = false; static_assert(ACT == 0 || ACT == 1, "EpiBf16: ACT is 0 (none) or 1 (gelu_pk)");
    bf16_t* O; int ldc; const float* bias; int split_cols; size_t split_stride; float scale0;
    __device__ __forceinline__ void operator()(const f32x4 (&acc)[2][2][4][2], const Unit& u, int wr, int wc, int fr, int fq) const {
        const int row0 = u.pm * BM + wr * 64 + fr; int colt = u.pn * BM; bf16_t* base = O;
        float sc = 1.f; if (split_cols) { const int t = colt / split_cols; base += (size_t)t * split_stride; colt -= t * split_cols; if (t == 0) sc = scale0; }
        const int col0 = colt + wc * 32 + 8 * fq, bcol0 = u.pn * BM + wc * 32 + 8 * fq;
        f32x4 bv[2][2];
#pragma unroll
        for (int bj = 0; bj < 2; ++bj)
#pragma unroll
            for (int n = 0; n < 2; ++n) bv[bj][n] = bias ? *(const f32x4*)(bias + bcol0 + bj * HALF + 4 * n) : (f32x4){0.f, 0.f, 0.f, 0.f};
#pragma unroll
        for (int ai = 0; ai < 2; ++ai)
#pragma unroll
            for (int m = 0; m < 4; ++m) { bf16_t* rowp = base + (size_t)(row0 + ai * HALF + m * 16) * ldc + col0;
#pragma unroll
                for (int bj = 0; bj < 2; ++bj) { f32x4 v0 = acc[ai][bj][m][0] + bv[bj][0], v1 = acc[ai][bj][m][1] + bv[bj][1];
                    if (ACT == 1) { f32x2 a = gelu_pk((f32x2){v0[0], v0[1]}), b = gelu_pk((f32x2){v0[2], v0[3]}), c = gelu_pk((f32x2){v1[0], v1[1]}), d = gelu_pk((f32x2){v1[2], v1[3]});
                        v0 = (f32x4){a.x, a.y, b.x, b.y}; v1 = (f32x4){c.x, c.y, d.x, d.y}; }
                    v0 = v0 * sc; v1 = v1 * sc; u32x4 w; w.x = cvt_pk_bf16(v0[0], v0[1]); w.y = cvt_pk_bf16(v0[2], v0[3]); w.z = cvt_pk_bf16(v1[0], v1[1]); w.w = cvt_pk_bf16(v1[2], v1[3]);
                    *(u32x4*)(rowp + bj * HALF) = w; } }
    }
};


__device__ __forceinline__ float fast_sigmoid(float z) { return __builtin_amdgcn_rcpf(1.0f + __builtin_amdgcn_exp2f(-1.4426950408889634f * z)); }
#define PG8_EPI_LOOP(row0) _Pragma("unroll") for (int ai = 0; ai < 2; ++ai) _Pragma("unroll") for (int m = 0; m < 4; ++m) { const int row = (row0) + ai * HALF + m * 16; _Pragma("unroll") for (int bj = 0; bj < 2; ++bj) { f32x4 v0 = acc[ai][bj][m][0], v1 = acc[ai][bj][m][1];
#define PG8_EPI_END } asm volatile("" ::: "memory"); }
struct EpiProjF {
    static constexpr bool PERM = true, AFTER_DRAIN = false;
    unsigned char* ws;
    __device__ __forceinline__ void operator()(const f32x4 (&acc)[2][2][4][2], const Unit& u, int wr, int wc, int fr, int fq) const {
        const int region = u.pn >> 1;
        const size_t offs[7] = {WS_SBQ, WS_SBK, WS_SBV, WS_DFQ, WS_DFK, WS_DFV, WS_MXQ};
        size_t off = offs[0];
#pragma unroll
        for (int q = 1; q < 7; ++q) off = (region == q) ? offs[q] : off;
        bf16_t* dst = (bf16_t*)(ws + off);
        const float sc = (region == 0 || region == 3) ? C2_64 : (region == 6 ? C2_128 : 1.0f);
        const bool rot = (region == 3 || region == 4) && ((wc & 1) == 0);
        const float sgn = (fq == 0) ? -1.0f : 1.0f;
        const int row0 = u.pm * BM + wr * 64 + fr, colt = (u.pn & 1) * BM + wc * 32 + 8 * fq;
        const f32x4* rope = (const f32x4*)(ws + WS_ROPE);
        PG8_EPI_LOOP(row0)
            if (rot) {
                f32x4 p0, p1;
#pragma unroll
                for (int j = 0; j < 4; ++j) { p0[j] = __shfl_xor(v0[j], 16); p1[j] = __shfl_xor(v1[j], 16); }
                if (fq < 2) {
                    const f32x4 c01 = rope[(size_t)row * 4 + 0], c23 = rope[(size_t)row * 4 + 1], c45 = rope[(size_t)row * 4 + 2], c67 = rope[(size_t)row * 4 + 3];
                    v0[0] = v0[0] * c01[0] + sgn * p0[0] * c01[1]; v0[1] = v0[1] * c01[2] + sgn * p0[1] * c01[3];
                    v0[2] = v0[2] * c23[0] + sgn * p0[2] * c23[1]; v0[3] = v0[3] * c23[2] + sgn * p0[3] * c23[3];
                    v1[0] = v1[0] * c45[0] + sgn * p1[0] * c45[1]; v1[1] = v1[1] * c45[2] + sgn * p1[1] * c45[3];
                    v1[2] = v1[2] * c67[0] + sgn * p1[2] * c67[1]; v1[3] = v1[3] * c67[2] + sgn * p1[3] * c67[3];
                }
            }
            v0 = v0 * sc; v1 = v1 * sc;
            u32x4 w; w.x = cvt_pk_bf16(v0[0], v0[1]); w.y = cvt_pk_bf16(v0[2], v0[3]); w.z = cvt_pk_bf16(v1[0], v1[1]); w.w = cvt_pk_bf16(v1[2], v1[3]);
            *(u32x4*)(dst + (size_t)row * 512 + colt + bj * HALF) = w;
        PG8_EPI_END
    }
};
struct EpiGateF {
    static constexpr bool PERM = true, AFTER_DRAIN = false;
    bf16_t* dst; const float* bias;
    __device__ __forceinline__ void operator()(const f32x4 (&acc)[2][2][4][2], const Unit& u, int wr, int wc, int fr, int fq) const {
        const int row0 = u.pm * BM + wr * 64 + fr, col0 = u.pn * BM + wc * 32 + 8 * fq;
        f32x4 bv[2][2];
#pragma unroll
        for (int bj = 0; bj < 2; ++bj)
#pragma unroll
            for (int n = 0; n < 2; ++n) bv[bj][n] = *(const f32x4*)(bias + col0 + bj * HALF + 4 * n);
        PG8_EPI_LOOP(row0)
            v0 = v0 + bv[bj][0]; v1 = v1 + bv[bj][1];
#pragma unroll
            for (int j = 0; j < 4; ++j) { v0[j] = fast_sigmoid(v0[j]); v1[j] = fast_sigmoid(v1[j]); }
            u32x4 w; w.x = cvt_pk_bf16(v0[0], v0[1]); w.y = cvt_pk_bf16(v0[2], v0[3]); w.z = cvt_pk_bf16(v1[0], v1[1]); w.w = cvt_pk_bf16(v1[2], v1[3]);
            *(u32x4*)(dst + (size_t)row * 3072 + col0 + bj * HALF) = w;
        PG8_EPI_END
    }
};
template <int MODE> struct EpiBranchF {
    static constexpr bool PERM = true, AFTER_DRAIN = false;
    const bf16_t* gates; int gcol; float* m32; bf16_t* mb;
    __device__ __forceinline__ void operator()(const f32x4 (&acc)[2][2][4][2], const Unit& u, int wr, int wc, int fr, int fq) const {
        const int row0 = u.pm * BM + wr * 64 + fr, col0 = u.pn * BM + wc * 32 + 8 * fq;
        PG8_EPI_LOOP(row0)
            const int c = col0 + bj * HALF;
            const u32x4 g = *(const u32x4*)(gates + (size_t)row * 3072 + gcol + c);
            v0[0] *= __uint_as_float(g.x << 16); v0[1] *= __uint_as_float(g.x & 0xffff0000u); v0[2] *= __uint_as_float(g.y << 16); v0[3] *= __uint_as_float(g.y & 0xffff0000u);
            v1[0] *= __uint_as_float(g.z << 16); v1[1] *= __uint_as_float(g.z & 0xffff0000u); v1[2] *= __uint_as_float(g.w << 16); v1[3] *= __uint_as_float(g.w & 0xffff0000u);
            float* mp = m32 + (size_t)row * 1024 + c;
            if (MODE > 0) { v0 = v0 + *(const f32x4*)mp; v1 = v1 + *(const f32x4*)(mp + 4); }
            if (MODE < 2) { *(f32x4*)mp = v0; *(f32x4*)(mp + 4) = v1; }
            else { u32x4 w; w.x = cvt_pk_bf16(v0[0], v0[1]); w.y = cvt_pk_bf16(v0[2], v0[3]); w.z = cvt_pk_bf16(v1[0], v1[1]); w.w = cvt_pk_bf16(v1[2], v1[3]);
                   *(u32x4*)(mb + (size_t)row * 1024 + c) = w; }
        PG8_EPI_END
    }
};
struct EpiOutF {
    static constexpr bool PERM = true, AFTER_DRAIN = false;
    const float* x; float* y;
    __device__ __forceinline__ void operator()(const f32x4 (&acc)[2][2][4][2], const Unit& u, int wr, int wc, int fr, int fq) const {
        const int row0 = u.pm * BM + wr * 64 + fr, col0 = u.pn * BM + wc * 32 + 8 * fq;
        PG8_EPI_LOOP(row0)
            const size_t o = (size_t)row * 1024 + col0 + bj * HALF;
            v0 = v0 + ALPHA * *(const f32x4*)(x + o); v1 = v1 + ALPHA * *(const f32x4*)(x + o + 4);
            *(f32x4*)(y + o) = v0; *(f32x4*)(y + o + 4) = v1;
        PG8_EPI_END
    }
};
struct GateOrder { Unit base;
    __device__ bool next(int i, Unit& u) const { if (i >= 3) return false; u.pm = base.pm; u.pn = 4 * i + base.pn; return true; }
    __device__ __forceinline__ void a_ready(const Unit&) const {} __device__ __forceinline__ void done(const Unit&) const {} };
struct OneOrder { int pm, pn;
    __device__ __forceinline__ bool next(int i, Unit& u) const { if (i >= 1) return false; u.pm = pm; u.pn = pn; return true; }
    __device__ __forceinline__ void a_ready(const Unit&) const {} __device__ __forceinline__ void done(const Unit&) const {} };
struct MemOrder { int c;
    __device__ bool next(int i, Unit& u) const { if (i >= 1 || c < 128 || c >= 136) return false; u.pm = (c - 128) >> 2; u.pn = (c - 128) & 3; return true; }
    __device__ __forceinline__ void a_ready(const Unit&) const {} __device__ __forceinline__ void done(const Unit&) const {} };

template <class Epi, class Sched, bool ALIGN_EPI = false, bool SP2 = false>
__device__ __forceinline__ void gemm_phase(PG8_LAS unsigned char* lds, const Gemm g, const Sched& S, const Epi& E) {
    int tid = threadIdx.x; asm volatile("" : "+v"(tid));
    const int wid = __builtin_amdgcn_readfirstlane(tid >> 6), lane = tid & 63, wr = wid >> 2, wc = wid & 3, fr = lane & 15, fq = lane >> 4;
    const int K = g.K, nt = K / BK;
    unsigned voffA[2], voffB[2];
#pragma unroll
    for (int i = 0; i < 2; ++i) { int R, C; stage_rc(tid * 16 + i * 8192, R, C); const int Rb = Epi::PERM ? ((R & ~31) + perm32(R & 31)) : R;
        voffA[i] = (unsigned)(R * K + C) * 2u; voffB[i] = (unsigned)(Rb * K + C) * 2u; }
    const size_t kstep = (size_t)(BK * 2);
    const size_t hstep = (size_t)HALF * K * 2;
    const size_t tstep = 2 * hstep;
    const unsigned ldsw = (unsigned)wid * 1024u;
    const int aoff = lds_byte(wr * 64 + fr, fq * 8), boff = lds_byte(wc * 32 + fr, fq * 8);
#define PG8_SA(b, h) (((b) * 2 + (h)) * HTB)
#define PG8_SB(b, h) ((4 + (b) * 2 + (h)) * HTB)
#define PG8_STAGE(bufoff, gbase, voff) do { _Pragma("unroll") for (int _i = 0; _i < 2; ++_i) \
        __builtin_amdgcn_global_load_lds((const unsigned*)((const char*)(gbase) + (voff)[_i]), (PG8_LAS unsigned*)(lds + (bufoff) + ldsw + _i * 8192), 16, 0, 0); } while (0)
#define PG8_LDA(dst, b, h) do { _Pragma("unroll") for (int m = 0; m < 4; ++m) _Pragma("unroll") for (int k = 0; k < 2; ++k) dst[m][k] = *(const PG8_LAS bf16x8*)(lds + PG8_SA(b, h) + aoff + m * 2048 + k * 1024); } while (0)
#define PG8_LDB(dst, b, h) do { _Pragma("unroll") for (int n = 0; n < 2; ++n) _Pragma("unroll") for (int k = 0; k < 2; ++k) dst[n][k] = *(const PG8_LAS bf16x8*)(lds + PG8_SB(b, h) + boff + n * 2048 + k * 1024); } while (0)
#define PG8_MMA(ai, bj, At, Bt) do { __builtin_amdgcn_s_setprio(1); _Pragma("unroll") for (int m = 0; m < 4; ++m) _Pragma("unroll") for (int n = 0; n < 2; ++n) _Pragma("unroll") for (int k = 0; k < 2; ++k) \
        acc[ai][bj][m][n] = __builtin_amdgcn_mfma_f32_16x16x32_bf16(Bt[n][k], At[m][k], acc[ai][bj][m][n], 0, 0, 0); __builtin_amdgcn_s_setprio(0); } while (0)
#define PG8_WAIT_V(n) asm volatile("s_waitcnt vmcnt(" #n ")" ::: "memory")
#define PG8_WAIT_L(n) asm volatile("s_waitcnt lgkmcnt(" #n ")" ::: "memory")
#define PG8_BAR __builtin_amdgcn_s_barrier()
#define PG8_SCHED __builtin_amdgcn_sched_barrier(0)
    Unit cur, nxt; int ui = 0;
    if (!S.next(0, cur)) return;
    f32x4 acc[2][2][4][2];
#pragma unroll
    for (int a = 0; a < 2; ++a)
#pragma unroll
        for (int b = 0; b < 2; ++b)
#pragma unroll
            for (int m = 0; m < 4; ++m)
#pragma unroll
                for (int n = 0; n < 2; ++n) acc[a][b][m][n] = (f32x4){0.f, 0.f, 0.f, 0.f};
    bf16x8 At[4][2], B0[2][2], B1[2][2];
    const char* cA = (const char*)g.A + (size_t)cur.pm * tstep; const char* cB = (const char*)g.Bt + (size_t)cur.pn * tstep;
    S.a_ready(cur);
    if constexpr (SP2) {
        PG8_STAGE(PG8_SB(0, 0), cB, voffB); PG8_STAGE(PG8_SB(0, 1), cB + hstep, voffB); PG8_STAGE(PG8_SA(0, 0), cA, voffA); PG8_STAGE(PG8_SA(0, 1), cA + hstep, voffA);
        if (wr == 1) PG8_BAR;
        PG8_WAIT_V(2); PG8_BAR;
        PG8_STAGE(PG8_SB(1, 0), cB + kstep, voffB); PG8_STAGE(PG8_SA(1, 0), cA + kstep, voffA); PG8_STAGE(PG8_SB(1, 1), cB + hstep + kstep, voffB);
        PG8_WAIT_V(6); PG8_BAR;
    } else {
        PG8_STAGE(PG8_SB(0, 0), cB, voffB); PG8_STAGE(PG8_SA(0, 0), cA, voffA); PG8_STAGE(PG8_SB(0, 1), cB + hstep, voffB); PG8_STAGE(PG8_SA(0, 1), cA + hstep, voffA);
        if (wr == 1) PG8_BAR;
        PG8_WAIT_V(4); PG8_BAR;
        PG8_STAGE(PG8_SB(1, 0), cB + kstep, voffB); PG8_STAGE(PG8_SA(1, 0), cA + kstep, voffA); PG8_STAGE(PG8_SB(1, 1), cB + hstep + kstep, voffB);
        PG8_WAIT_V(6); PG8_BAR;
    }
    for (;;) {
        const bool has_next = S.next(ui + 1, nxt);
        const char* nA = has_next ? (const char*)g.A + (size_t)nxt.pm * tstep : cA; const char* nB = has_next ? (const char*)g.Bt + (size_t)nxt.pn * tstep : cB;
        for (int t = 0; t < nt; t += 2) {
            const bool last = (t == nt - 2);
            const char* a1 = cA + (size_t)(t + 1) * kstep;
            const char* a2 = last ? nA : cA + (size_t)(t + 2) * kstep; const char* b2 = last ? nB : cB + (size_t)(t + 2) * kstep;
            const char* a3 = a2 + kstep; const char* b3 = b2 + kstep;
            if (last && has_next) S.a_ready(nxt);
            if constexpr (SP2) {
            PG8_LDB(B0, 0, 0); PG8_LDB(B1, 0, 1); PG8_SCHED; PG8_LDA(At, 0, 0); PG8_STAGE(PG8_SA(1, 1), a1 + hstep, voffA);
            PG8_WAIT_V(8); PG8_WAIT_L(0); PG8_BAR; PG8_MMA(0, 0, At, B0); PG8_MMA(0, 1, At, B1); PG8_BAR; PG8_SCHED;
            PG8_LDA(At, 0, 1); PG8_STAGE(PG8_SB(0, 0), b2, voffB); PG8_STAGE(PG8_SB(0, 1), b2 + hstep, voffB); PG8_STAGE(PG8_SA(0, 0), a2, voffA);
            PG8_WAIT_V(8); PG8_WAIT_L(0); PG8_BAR; PG8_MMA(1, 0, At, B0); PG8_MMA(1, 1, At, B1); PG8_BAR; PG8_SCHED;
            PG8_LDB(B0, 1, 0); PG8_LDB(B1, 1, 1); PG8_SCHED; PG8_LDA(At, 1, 0); PG8_STAGE(PG8_SA(0, 1), a2 + hstep, voffA);
            PG8_WAIT_V(8); PG8_WAIT_L(0); PG8_BAR; PG8_MMA(0, 0, At, B0); PG8_MMA(0, 1, At, B1); PG8_BAR; PG8_SCHED;
            PG8_LDA(At, 1, 1); PG8_STAGE(PG8_SB(1, 0), b3, voffB); PG8_STAGE(PG8_SB(1, 1), b3 + hstep, voffB); PG8_STAGE(PG8_SA(1, 0), a3, voffA);
            PG8_WAIT_V(8); PG8_WAIT_L(0); PG8_BAR; PG8_MMA(1, 0, At, B0); PG8_MMA(1, 1, At, B1); PG8_BAR; PG8_SCHED;
            } else {
            PG8_LDB(B0, 0, 0); PG8_SCHED; PG8_LDA(At, 0, 0); PG8_STAGE(PG8_SA(1, 1), a1 + hstep, voffA);
            PG8_WAIT_L(8); PG8_BAR; PG8_WAIT_L(0); PG8_MMA(0, 0, At, B0); PG8_BAR; PG8_SCHED;
            PG8_LDB(B1, 0, 1); PG8_STAGE(PG8_SB(0, 0), b2, voffB);
            PG8_BAR; PG8_WAIT_L(0); PG8_MMA(0, 1, At, B1); PG8_BAR;
            PG8_LDA(At, 0, 1); PG8_STAGE(PG8_SA(0, 0), a2, voffA);
            PG8_BAR; PG8_WAIT_L(0); PG8_MMA(1, 0, At, B0); PG8_BAR; PG8_SCHED;
            PG8_STAGE(PG8_SB(0, 1), b2 + hstep, voffB);
            PG8_WAIT_V(6); PG8_BAR; PG8_MMA(1, 1, At, B1); PG8_BAR;
            PG8_LDB(B0, 1, 0); PG8_SCHED; PG8_LDA(At, 1, 0); PG8_STAGE(PG8_SA(0, 1), a2 + hstep, voffA);
            PG8_WAIT_L(8); PG8_BAR; PG8_WAIT_L(0); PG8_MMA(0, 0, At, B0); PG8_BAR; PG8_SCHED;
            PG8_LDB(B1, 1, 1); PG8_STAGE(PG8_SB(1, 0), b3, voffB);
            PG8_BAR; PG8_WAIT_L(0); PG8_MMA(0, 1, At, B1); PG8_BAR;
            PG8_LDA(At, 1, 1); PG8_STAGE(PG8_SA(1, 0), a3, voffA);
            PG8_BAR; PG8_WAIT_L(0); PG8_MMA(1, 0, At, B0); PG8_BAR; PG8_SCHED;
            PG8_STAGE(PG8_SB(1, 1), b3 + hstep, voffB);
            PG8_WAIT_V(6); PG8_BAR; PG8_MMA(1, 1, At, B1); PG8_BAR;
            }
        }
        if constexpr (ALIGN_EPI) { if (wr == 0) PG8_BAR; }
        if constexpr (!Epi::AFTER_DRAIN) { E(acc, cur, wr, wc, fr, fq); S.done(cur); }
        if (!has_next) break;
#pragma unroll
        for (int a = 0; a < 2; ++a)
#pragma unroll
            for (int b = 0; b < 2; ++b)
#pragma unroll
                for (int m = 0; m < 4; ++m)
#pragma unroll
                    for (int n = 0; n < 2; ++n) acc[a][b][m][n] = (f32x4){0.f, 0.f, 0.f, 0.f};
        cur = nxt; cA = nA; cB = nB; ++ui;
        if constexpr (ALIGN_EPI) { if (wr == 1) PG8_BAR; }
    }
    PG8_WAIT_V(0);
    if constexpr (!ALIGN_EPI) { if (wr == 0) PG8_BAR; }
    PG8_BAR;
    if constexpr (Epi::AFTER_DRAIN) { E.fused(acc, cur, wr, wc, fr, fq, lds, wid, lane); S.done(cur); }
#undef PG8_SA
#undef PG8_SB
#undef PG8_STAGE
#undef PG8_LDA
#undef PG8_LDB
#undef PG8_MMA
#undef PG8_WAIT_V
#undef PG8_WAIT_L
#undef PG8_BAR
#undef PG8_SCHED
}
}

#ifndef PG8_SP2
#define PG8_SP2 true
#endif
#ifndef PG8_ALIGN
#define PG8_ALIGN true
#endif

#include <hip/hip_bf16.h>
#include <cmath>
namespace attn_body {
using bf16=__hip_bfloat16;
using bf16x8=__attribute__((ext_vector_type(8)))short;
using s16x4=__attribute__((ext_vector_type(4)))short;
using f32x16=__attribute__((ext_vector_type(16)))float;
using u32x4=__attribute__((ext_vector_type(4)))unsigned;
constexpr int BATCH=2,NHEAD=16,SEQ=8192,D=64,DM=NHEAD*D,PQ=512,PO=1024;
constexpr int NW=8,QBLK=32,QB=QBLK*NW,KVBLK=64,NQB=SEQ/QB;
constexpr int ATTN_PITCH=DM, ATTN_UNIT_ROWS=QB;
__device__ __forceinline__ int crow(int r,int hi){return (r&3)+8*(r>>2)+4*hi;}
#define SBAR() __builtin_amdgcn_sched_barrier(0)
__device__ __forceinline__ void cmask(f32x16&p0,f32x16&p1,int jb,int qrel,int hi){
  const float NEG=-INFINITY; int kb=64*jb+4*hi;
  #pragma unroll
  for(int r=0;r<16;++r){int kv=kb+(r&3)+8*(r>>2); if(kv>qrel)p0[r]=NEG; if(kv+32>qrel)p1[r]=NEG;}
}

constexpr int NSLOT=3, SLOTB=8192;
constexpr int LDS_K=0, LDS_V=NSLOT*SLOTB, LDS_WS=2*NSLOT*SLOTB, LDS_OST=LDS_WS+NW*64*4, LDS_BYTES=LDS_OST+NW*4096;
constexpr float C2=0.125f*1.4426950408889634f;
__device__ __forceinline__ void glds16(const void*gsrc,unsigned lds_dst){unsigned keep;
  asm volatile("s_mov_b32 %0, m0\n\ts_mov_b32 m0, %2\n\ts_nop 0\n\tglobal_load_lds_dwordx4 %1, off\n\ts_mov_b32 m0, %0":"=&s"(keep):"v"(gsrc),"s"(lds_dst):"memory");}
__device__ __forceinline__ float max3f(float a,float b,float c){float r;asm("v_max3_f32 %0, %1, %2, %3":"=v"(r):"v"(a),"v"(b),"v"(c));return r;}
__device__ __forceinline__ float max2f(float a,float b){float r;asm("v_max_f32_e32 %0, %1, %2":"=v"(r):"v"(a),"v"(b));return r;}
__device__ __forceinline__ float fadd_s(float a,float b){float r;asm("v_add_f32_e32 %0, %1, %2":"=v"(r):"v"(a),"v"(b));return r;}
__device__ __forceinline__ float fsub_s(float a,float b){float r;asm("v_sub_f32_e32 %0, %1, %2":"=v"(r):"v"(a),"v"(b));return r;}
typedef float f32x2_t __attribute__((ext_vector_type(2))); typedef __bf16 bf16x2_t __attribute__((ext_vector_type(2)));
__device__ __forceinline__ unsigned cvtpk_s(float lo,float hi){f32x2_t v={lo,hi};bf16x2_t b=__builtin_convertvector(v,bf16x2_t);return __builtin_bit_cast(unsigned,b);}
#define WAIT_BAR(N) asm volatile("s_waitcnt vmcnt(" #N ") lgkmcnt(0)\n\ts_barrier":::"memory")

__device__ __forceinline__ void qkt(f32x16&p0,f32x16&p1,const char*Kslot,const bf16x8*qr,const f32x16&negm,int r32,int hi){
  const char*kb=Kslot+hi*1024+r32*16;
  #pragma unroll
  for(int d0=0;d0<4;++d0){
    const bf16x8 b0=*reinterpret_cast<const bf16x8*>(kb+d0*2048);
    const bf16x8 b1=*reinterpret_cast<const bf16x8*>(kb+d0*2048+512);
    if(d0==0){p0=__builtin_amdgcn_mfma_f32_32x32x16_bf16(b0,qr[0],negm,0,0,0);p1=__builtin_amdgcn_mfma_f32_32x32x16_bf16(b1,qr[0],negm,0,0,0);}
    else{p0=__builtin_amdgcn_mfma_f32_32x32x16_bf16(b0,qr[d0],p0,0,0,0);p1=__builtin_amdgcn_mfma_f32_32x32x16_bf16(b1,qr[d0],p1,0,0,0);}}
}
typedef __attribute__((address_space(3))) const char* lds_cptr;
typedef short v4i16_t __attribute__((ext_vector_type(4)));
__device__ __forceinline__ void kload8(bf16x8*kf,lds_cptr kp){
  kf[0]=*(const __attribute__((address_space(3))) bf16x8*)(kp);      kf[1]=*(const __attribute__((address_space(3))) bf16x8*)(kp+512);
  kf[2]=*(const __attribute__((address_space(3))) bf16x8*)(kp+2048); kf[3]=*(const __attribute__((address_space(3))) bf16x8*)(kp+2560);
  kf[4]=*(const __attribute__((address_space(3))) bf16x8*)(kp+4096); kf[5]=*(const __attribute__((address_space(3))) bf16x8*)(kp+4608);
  kf[6]=*(const __attribute__((address_space(3))) bf16x8*)(kp+6144); kf[7]=*(const __attribute__((address_space(3))) bf16x8*)(kp+6656);
}
__device__ __forceinline__ void kload2(bf16x8*kf,lds_cptr kp,int j){ kf[2*j]=*(const __attribute__((address_space(3))) bf16x8*)(kp+j*2048); kf[2*j+1]=*(const __attribute__((address_space(3))) bf16x8*)(kp+j*2048+512); }
__device__ __forceinline__ s16x4 vtr(lds_cptr p){ return __builtin_bit_cast(s16x4,__builtin_amdgcn_ds_read_tr16_b64_v4i16((__attribute__((address_space(3))) v4i16_t*)p)); }
__device__ __forceinline__ float rowmax(const f32x16&p0,const f32x16&p1){
  float a=max3f(p0[0],p0[1],p1[0]),b=max3f(p0[2],p0[3],p1[1]);a=max3f(a,p1[2],p1[3]);
  #pragma unroll
  for(int r=4;r<16;r+=4){a=max3f(a,p0[r],p0[r+1]);b=max3f(b,p0[r+2],p0[r+3]);a=max3f(a,p1[r],p1[r+1]);b=max3f(b,p1[r+2],p1[r+3]);}
  const float m=max2f(a,b);
  auto rr=__builtin_amdgcn_permlane32_swap(__float_as_uint(m),__float_as_uint(m),false,false);
  return max2f(__uint_as_float(rr[0]),__uint_as_float(rr[1]));
}
__device__ __forceinline__ void pv(f32x16*o,int vb,bf16x8 pa0,bf16x8 pa1,bf16x8 pa2,bf16x8 pa3){
  #pragma unroll
  for(int d0=0;d0<2;++d0){s16x4 lo[4],hi[4];
    #pragma unroll
    for(int ks=0;ks<4;++ks){
      asm volatile("ds_read_b64_tr_b16 %0,%1 offset:%c2":"=&v"(lo[ks]):"v"(vb),"i"(d0*4096+ks*1024):"memory");
      asm volatile("ds_read_b64_tr_b16 %0,%1 offset:%c2":"=&v"(hi[ks]):"v"(vb),"i"(d0*4096+ks*1024+512):"memory");}
    asm volatile("s_waitcnt lgkmcnt(0)":::"memory");SBAR();
    #define PK(k) (bf16x8){lo[k][0],lo[k][1],lo[k][2],lo[k][3],hi[k][0],hi[k][1],hi[k][2],hi[k][3]}
    o[d0]=__builtin_amdgcn_mfma_f32_32x32x16_bf16(pa0,PK(0),o[d0],0,0,0);
    o[d0]=__builtin_amdgcn_mfma_f32_32x32x16_bf16(pa1,PK(1),o[d0],0,0,0);
    o[d0]=__builtin_amdgcn_mfma_f32_32x32x16_bf16(pa2,PK(2),o[d0],0,0,0);
    o[d0]=__builtin_amdgcn_mfma_f32_32x32x16_bf16(pa3,PK(3),o[d0],0,0,0);
    #undef PK
  }
}

#ifndef ATTN_STORE16
#define ATTN_STORE16(p,v) (*(u32x4*)(p)=(v))
#endif
template<int THRL> __device__ __forceinline__ void attn_unit(int b,int h,int qb,const bf16*Q,const bf16*__restrict__ K,const bf16*__restrict__ V,bf16*O,char*shm){
  int tid=threadIdx.x; asm volatile("":"+v"(tid)); const int lane=tid&63,r32=lane&31,hi=lane>>5; const int wid=__builtin_amdgcn_readfirstlane(tid>>6);
  const long rowbase=(long)b*SEQ; const int q0=qb*QB;
  const bf16*Qw=Q+(rowbase+q0+wid*QBLK)*PQ;
  const bf16*Kh=K+rowbase*PQ,*Vh=V+rowbase*PQ;
  const unsigned lds0=(unsigned)(uintptr_t)shm;
  float*wsf=(float*)(shm+LDS_WS)+wid*64;
  const bf16*ksrc=Kh+(long)lane*PQ+wid*8;
  const bf16*vsrc=Vh+(long)(16*(wid&3)+(lane>>2))*PQ+(wid>>2)*32+(lane&3)*8;
  const unsigned kdst=lds0+LDS_K+wid*1024, vdst=lds0+LDS_V+wid*1024;
  #define DMA_K(t,slot) glds16(ksrc+(long)(t)*KVBLK*PQ,(unsigned)__builtin_amdgcn_readfirstlane(kdst+(slot)))
  #define DMA_V(t,slot) glds16(vsrc+(long)(t)*KVBLK*PQ,(unsigned)__builtin_amdgcn_readfirstlane(vdst+(slot)))
  const int vb0=(int)(lds0+LDS_V)+((lane>>4)&1)*32+(lane&3)*8+(4*hi+((lane&15)>>2))*64;
  const char*Kbase=shm+LDS_K; bf16x8 kf[8];
  const lds_cptr shm3=(lds_cptr)shm; const lds_cptr kp0=shm3+LDS_K+hi*1024+r32*16; const lds_cptr vp0=shm3+LDS_V+((lane>>4)&1)*32+(lane&3)*8+(4*hi+((lane&15)>>2))*64;
  const int NT=(q0+QB)/KVBLK;
  DMA_K(0,0);DMA_V(0,0);DMA_K(1,SLOTB);
  bf16x8 qr[4];
  #pragma unroll
  for(int d0=0;d0<4;++d0)qr[d0]=*reinterpret_cast<const bf16x8*>(&Qw[(long)r32*PQ+d0*16+hi*8]);
  float mhat=0.f,l_reg=0.f;f32x16 o[2];o[0]=f32x16{};o[1]=f32x16{};f32x16 negm=f32x16{};asm volatile("":"+v"(negm));
  const int qrel=wid*QBLK+r32;
  #define CMASK(P0,P1,t) do{int jb_=(t)-(NT-4); if(jb_>=0)cmask(P0,P1,jb_,qrel,hi);}while(0)
  bool resc=false;
  #define START(P0,P1) do{ const float rm=rowmax(P0,P1); resc=false; \
    { const float dl=rm; mhat=fadd_s(mhat,dl); \
      _Pragma("unroll") for(int r=0;r<16;++r){P0[r]=fsub_s(P0[r],dl);P1[r]=fsub_s(P1[r],dl);} \
      _Pragma("unroll") for(int r=0;r<16;++r)negm[r]=-mhat; asm volatile("":"+v"(negm)); } \
    _Pragma("unroll") for(int r=0;r<16;++r)P0[r]=__builtin_amdgcn_exp2f(P0[r]); }while(0)
  #define RESC() do{ if(resc){ asm volatile("s_waitcnt lgkmcnt(0)":::"memory"); \
      _Pragma("unroll") for(int d_=0;d_<2;++d_) _Pragma("unroll") for(int r=0;r<16;++r)o[d_][r]*=wsf[crow(r,hi)]; } }while(0)
  f32x16 pA0,pA1,pB0,pB1;
  int sl_prev=0,sl_cur=0,sl_next=SLOTB;
  #define ROT() do{sl_prev=sl_cur;sl_cur=sl_next;sl_next=(sl_next==(NSLOT-1)*SLOTB)?0:sl_next+SLOTB;}while(0)
  DMA_K(2,2*SLOTB);
  WAIT_BAR(3);
  qkt(pA0,pA1,Kbase,qr,negm,r32,hi);asm volatile("s_nop 15\n\ts_nop 7":"+v"(pA0),"+v"(pA1));CMASK(pA0,pA1,0);
  START(pA0,pA1);
  _Pragma("unroll") for(int r=0;r<16;++r)pA1[r]=__builtin_amdgcn_exp2f(pA1[r]);
  WAIT_BAR(0);
  DMA_K(3,0);DMA_V(1,SLOTB);
  ROT();
  kload8(kf,kp0+sl_cur);
  WAIT_BAR(2);
  s16x4 vlo[8],vhi[8]; u32x4 pw0,pw1,pw2,pw3;
  #define PKW(P,B) cvtpk_s(P[B],P[B+1])
  #define PAF(k) __builtin_bit_cast(bf16x8,pw##k)
  #define VFR(i) (bf16x8){vlo[i][0],vlo[i][1],vlo[i][2],vlo[i][3],vhi[i][0],vhi[i][1],vhi[i][2],vhi[i][3]}
  #define PIN(x) asm volatile("":"+v"(x))
  #define MX3(a,b,c) __builtin_fmaxf(__builtin_fmaxf((a),(b)),(c))
  #define GAPA(MF,A0,A1,A2,A3,W0,W1,PW) do{ MF; sacc+=A0; sacc+=A1; sacc+=A2; sacc+=A3; PIN(sacc); W0; W1; PIN(PW); SBAR(); }while(0)
  #define EX(v) __builtin_amdgcn_exp2f(v)
  #define GAPB(MF,X,B) do{ MF; X[B]=EX(X[B]); X[B+1]=EX(X[B+1]); X[B+2]=EX(X[B+2]); X[B+3]=EX(X[B+3]); PIN(X); SBAR(); }while(0)
  #define VRD(i) do{ vlo[i]=vtr(vp_+(((i)>>2)*4096+((i)&3)*1024)); vhi[i]=vtr(vp_+(((i)>>2)*4096+((i)&3)*1024+512)); }while(0)
  #define KRD(G,j) do{ if(G){ kload2(kf,kp0+sl_next,j); SBAR(); } }while(0)
  #define STEP(C0,C1,P0,P1,t,GK,GV,GL) do{ SBAR(); \
    const lds_cptr vp_=vp0+sl_prev; \
    VRD(0); SBAR(); float sacc=(P0[0]+P0[1]); \
    GAPA(C0=__builtin_amdgcn_mfma_f32_32x32x16_bf16(kf[0],qr[0],negm,0,0,0), P0[2],P0[3],P0[4],P0[5],     pw0[0]=PKW(P0,0), pw0[1]=PKW(P0,2), pw0); \
    VRD(4); SBAR(); GAPA(C1=__builtin_amdgcn_mfma_f32_32x32x16_bf16(kf[1],qr[0],negm,0,0,0), P0[6],P0[7],P0[8],P0[9],     pw0[2]=PKW(P0,4), pw0[3]=PKW(P0,6), pw0); \
    VRD(1); SBAR(); GAPA(C0=__builtin_amdgcn_mfma_f32_32x32x16_bf16(kf[2],qr[1],C0,0,0,0),   P0[10],P0[11],P0[12],P0[13], pw1[0]=PKW(P0,8), pw1[1]=PKW(P0,10), pw1); \
    VRD(5); SBAR(); GAPA(C1=__builtin_amdgcn_mfma_f32_32x32x16_bf16(kf[3],qr[1],C1,0,0,0),   P0[14],P0[15],P1[0],P1[1],   pw1[2]=PKW(P0,12),pw1[3]=PKW(P0,14), pw1); \
    VRD(2); SBAR(); GAPA(C0=__builtin_amdgcn_mfma_f32_32x32x16_bf16(kf[4],qr[2],C0,0,0,0),   P1[2],P1[3],P1[4],P1[5],     pw2[0]=PKW(P1,0), pw2[1]=PKW(P1,2), pw2); \
    VRD(6); SBAR(); GAPA(C1=__builtin_amdgcn_mfma_f32_32x32x16_bf16(kf[5],qr[2],C1,0,0,0),   P1[6],P1[7],P1[8],P1[9],     pw2[2]=PKW(P1,4), pw2[3]=PKW(P1,6), pw2); \
    VRD(3); SBAR(); GAPA(C0=__builtin_amdgcn_mfma_f32_32x32x16_bf16(kf[6],qr[3],C0,0,0,0),   P1[10],P1[11],P1[12],P1[13], pw3[0]=PKW(P1,8), pw3[1]=PKW(P1,10), pw3); \
    VRD(7); SBAR(); GAPA(C1=__builtin_amdgcn_mfma_f32_32x32x16_bf16(kf[7],qr[3],C1,0,0,0),   P1[14],P1[15],0.f,0.f,       pw3[2]=PKW(P1,12),pw3[3]=PKW(P1,14), pw3); \
    l_reg+=sacc; \
    if(GK){DMA_K((t)+3,sl_cur);} if(GV){DMA_V((t)+1,sl_next);} \
    CMASK(C0,C1,t); \
    { float a=MX3(C0[0],C0[1],C1[0]),b=MX3(C0[2],C0[3],C1[1]); a=MX3(a,C1[2],C1[3]); \
      _Pragma("unroll") for(int r=4;r<16;r+=4){a=MX3(a,C0[r],C0[r+1]);b=MX3(b,C0[r+2],C0[r+3]);a=MX3(a,C1[r],C1[r+1]);b=MX3(b,C1[r+2],C1[r+3]);} \
      float rm=__builtin_fmaxf(a,b); { auto rr=__builtin_amdgcn_permlane32_swap(__float_as_uint(rm),__float_as_uint(rm),false,false); rm=__builtin_fmaxf(__uint_as_float(rr[0]),__uint_as_float(rr[1])); } \
      resc=false; \
      if(__builtin_expect(__any(rm>(float)THRL),0)){ const float dl=__builtin_fmaxf(rm,0.f); mhat+=dl; \
        _Pragma("unroll") for(int r=0;r<16;++r){C0[r]-=dl;C1[r]-=dl;} \
        _Pragma("unroll") for(int r=0;r<16;++r)negm[r]=-mhat; asm volatile("":"+v"(negm)); \
        const float f=__builtin_amdgcn_exp2f(-dl); l_reg*=f; if(hi==0)wsf[r32]=f; resc=true; } } \
    SBAR(); \
    GAPB(o[0]=__builtin_amdgcn_mfma_f32_32x32x16_bf16(PAF(0),VFR(0),o[0],0,0,0), C0,0); \
    GAPB(o[1]=__builtin_amdgcn_mfma_f32_32x32x16_bf16(PAF(0),VFR(4),o[1],0,0,0), C0,4); \
    KRD(GL,0); GAPB(o[0]=__builtin_amdgcn_mfma_f32_32x32x16_bf16(PAF(1),VFR(1),o[0],0,0,0), C0,8); \
    KRD(GL,1); GAPB(o[1]=__builtin_amdgcn_mfma_f32_32x32x16_bf16(PAF(1),VFR(5),o[1],0,0,0), C0,12); \
    KRD(GL,2); GAPB(o[0]=__builtin_amdgcn_mfma_f32_32x32x16_bf16(PAF(2),VFR(2),o[0],0,0,0), C1,0); \
    KRD(GL,3); GAPB(o[1]=__builtin_amdgcn_mfma_f32_32x32x16_bf16(PAF(2),VFR(6),o[1],0,0,0), C1,4); \
    GAPB(o[0]=__builtin_amdgcn_mfma_f32_32x32x16_bf16(PAF(3),VFR(3),o[0],0,0,0), C1,8); \
    GAPB(o[1]=__builtin_amdgcn_mfma_f32_32x32x16_bf16(PAF(3),VFR(7),o[1],0,0,0), C1,12); \
    }while(0)
  int t=1;
  #undef CMASK
  #define CMASK(P0,P1,t) do{}while(0)
  for(;t+5<NT;t+=2){
    STEP(pB0,pB1,pA0,pA1,t,true,true,true);     WAIT_BAR(2); RESC(); ROT();
    STEP(pA0,pA1,pB0,pB1,t+1,true,true,true);   WAIT_BAR(2); RESC(); ROT();
  }
  #undef CMASK
  #define CMASK(P0,P1,t) do{int jb_=(t)-(NT-4); if(jb_>=0)cmask(P0,P1,jb_,qrel,hi);}while(0)
  #define ENDW(tt) do{ if((tt)+3<NT){WAIT_BAR(2);} else if((tt)+2<NT){WAIT_BAR(1);} else {WAIT_BAR(0);} }while(0)
  for(;t+1<NT;t+=2){
    STEP(pB0,pB1,pA0,pA1,t,(t+3<NT),(t+1<NT),(t+1<NT));       ENDW(t);   RESC(); ROT();
    STEP(pA0,pA1,pB0,pB1,t+1,(t+4<NT),(t+2<NT),(t+2<NT));     ENDW(t+1); RESC(); ROT();
  }
  STEP(pB0,pB1,pA0,pA1,NT-1,false,false,false); RESC();
  { float sacc=pB0[0]+pB0[1]; _Pragma("unroll") for(int r=2;r<16;++r)sacc+=pB0[r]; _Pragma("unroll") for(int r=0;r<16;++r)sacc+=pB1[r]; l_reg+=sacc;
    pw0=(u32x4){PKW(pB0,0),PKW(pB0,2),PKW(pB0,4),PKW(pB0,6)};pw1=(u32x4){PKW(pB0,8),PKW(pB0,10),PKW(pB0,12),PKW(pB0,14)};pw2=(u32x4){PKW(pB1,0),PKW(pB1,2),PKW(pB1,4),PKW(pB1,6)};pw3=(u32x4){PKW(pB1,8),PKW(pB1,10),PKW(pB1,12),PKW(pB1,14)};
    SBAR(); pv(o,vb0+sl_cur,PAF(0),PAF(1),PAF(2),PAF(3)); }
  #undef PKW
  #undef PAF
  #undef VFR
  #undef PIN
  #undef MX3
  #undef GAPA
  #undef GAPB
  #undef EX
  #undef VRD
  #undef KRD
  #undef STEP
  #undef ENDW
  {auto rr=__builtin_amdgcn_permlane32_swap(__float_as_uint(l_reg),__float_as_uint(l_reg),false,false);l_reg=__uint_as_float(rr[0])+__uint_as_float(rr[1]);}
  if(hi==0)wsf[32+r32]=l_reg;asm volatile("s_waitcnt lgkmcnt(0)":::"memory");
  float rli[16];
  #pragma unroll
  for(int r=0;r<16;++r)rli[r]=__builtin_amdgcn_rcpf(wsf[32+crow(r,hi)]);
  bf16*Ow=O+(rowbase+q0+wid*QBLK)*PO;
  { bf16*stg=(bf16*)(shm+LDS_OST)+wid*2048;
    #pragma unroll
    for(int r=0;r<16;++r){const int orow=crow(r,hi);
      #pragma unroll
      for(int d0=0;d0<2;++d0)stg[orow*64+d0*32+r32]=__float2bfloat16(o[d0][r]*rli[r]);}
    asm volatile("s_waitcnt lgkmcnt(0)":::"memory");
    #pragma unroll
    for(int i=0;i<4;++i){const int row=i*8+(lane>>3),ch=lane&7; const u32x4 v=*(const u32x4*)(stg+row*64+ch*8); ATTN_STORE16(Ow+(long)row*PO+ch*8,v);} }
  asm volatile("s_waitcnt lgkmcnt(0)\n\ts_barrier":::"memory");
  #undef DMA_K
  #undef DMA_V
  #undef CMASK
  #undef START
  #undef RESC
  #undef ROT
}
constexpr int ATTN_LDS_BYTES=LDS_BYTES;
struct AttnTensors { const bf16* Q; const bf16* K; const bf16* V; bf16* O; };
struct AttnUnit { int bh; int qb; };
struct StaticOrder {
  int vcu;
  __device__ __forceinline__ explicit StaticOrder(int grid,int block):vcu((block%8)*(grid/8)+block/8){}
  __device__ __forceinline__ bool next(int i,AttnUnit&u)const{ if(i>=4)return false; const int s=vcu&7; u.bh=vcu>>3; u.qb=(i==0)?s:(i==1)?15-s:(i==2)?16+s:31-s; return true; }
  __device__ __forceinline__ void a_ready(const AttnUnit&)const{}
  __device__ __forceinline__ void done(const AttnUnit&)const{}
};
template<class Sched,int THRL=8> __device__ __forceinline__ void attn_phase(char*lds,const AttnTensors&T,const Sched&S){
  AttnUnit u;
  for(int i=0;S.next(i,u);++i){ S.a_ready(u); const int b=u.bh/NHEAD,g=u.bh%NHEAD,hh=g>>2,mm=(g>>1)&1,vh=g&1;
    attn_unit<THRL>(b,0,u.qb,T.Q+(hh*2+mm)*64,T.K+(hh*2+mm)*64,T.V+(hh*2+vh)*64,T.O+g*64,lds); S.done(u); }
}
#undef SBAR
#undef WAIT_BAR
}


constexpr size_t WS_PART = 64 * MiB;
constexpr size_t WS_ACO = 144 * MiB;
constexpr size_t WS_FFN = 64 * MiB;
typedef __bf16 bf16x2v __attribute__((ext_vector_type(2)));
__device__ __forceinline__ float dot8_bf16(const u32x4& a, const u32x4& b) {
    float r = __uint_as_float(a.x << 16) * __uint_as_float(b.x << 16) + __uint_as_float(a.x & 0xffff0000u) * __uint_as_float(b.x & 0xffff0000u);
    r += __uint_as_float(a.y << 16) * __uint_as_float(b.y << 16) + __uint_as_float(a.y & 0xffff0000u) * __uint_as_float(b.y & 0xffff0000u);
    r += __uint_as_float(a.z << 16) * __uint_as_float(b.z << 16) + __uint_as_float(a.z & 0xffff0000u) * __uint_as_float(b.z & 0xffff0000u);
    r += __uint_as_float(a.w << 16) * __uint_as_float(b.w << 16) + __uint_as_float(a.w & 0xffff0000u) * __uint_as_float(b.w & 0xffff0000u);
    return r;
}
__device__ __forceinline__ void peer_sddmm(const Params& p, int bx, int wave, int lane) {
    const int x = bx & 7, j = bx >> 3, c = lane & 15, q = lane >> 4;
    const bf16_t* UT = (const bf16_t*)(p.ws + WS_UTB) + 128 * x + 8 * c;
    const bf16_t* XS = (const bf16_t*)(p.ws + WS_X1B) + 128 * x + 8 * c;
    const int* IDS = (const int*)(p.ws + WS_IDS);
    float* PART = (float*)(p.ws + WS_PART) + (size_t)x * M * 128;
    for (int tt = 0; tt < 64; ++tt) {
        const int t = 512 * j + 64 * wave + tt;
        const u32x4 xv = *(const u32x4*)(XS + (size_t)t * 1024);
        const int* idp = IDS + (size_t)t * 128 + 32 * q;
        float s[32];
#pragma unroll
        for (int g = 0; g < 8; ++g) {
            const int4 id4 = *(const int4*)(idp + 4 * g);
            const u32x4 u0 = *(const u32x4*)(UT + (size_t)id4.x * 1024), u1 = *(const u32x4*)(UT + (size_t)id4.y * 1024);
            const u32x4 u2 = *(const u32x4*)(UT + (size_t)id4.z * 1024), u3 = *(const u32x4*)(UT + (size_t)id4.w * 1024);
            s[4 * g + 0] = dot8_bf16(xv, u0); s[4 * g + 1] = dot8_bf16(xv, u1); s[4 * g + 2] = dot8_bf16(xv, u2); s[4 * g + 3] = dot8_bf16(xv, u3);
        }
        float r16[16], r8[8], r4[4], r2[2];
        { const bool up = (c & 8) != 0;
#pragma unroll
          for (int i = 0; i < 16; ++i) { const float snd = up ? s[i] : s[i + 16], kp = up ? s[i + 16] : s[i]; r16[i] = kp + __shfl_xor(snd, 8); } }
        { const bool up = (c & 4) != 0;
#pragma unroll
          for (int i = 0; i < 8; ++i) { const float snd = up ? r16[i] : r16[i + 8], kp = up ? r16[i + 8] : r16[i]; r8[i] = kp + __shfl_xor(snd, 4); } }
        { const bool up = (c & 2) != 0;
#pragma unroll
          for (int i = 0; i < 4; ++i) { const float snd = up ? r8[i] : r8[i + 4], kp = up ? r8[i + 4] : r8[i]; r4[i] = kp + __shfl_xor(snd, 2); } }
        { const bool up = (c & 1) != 0;
#pragma unroll
          for (int i = 0; i < 2; ++i) { const float snd = up ? r4[i] : r4[i + 2], kp = up ? r4[i + 2] : r4[i]; r2[i] = kp + __shfl_xor(snd, 1); } }
        *(float2*)(PART + (size_t)t * 128 + 2 * lane) = make_float2(r2[0], r2[1]);
    }
}
__device__ __forceinline__ void peer_act(const Params& p, size_t gt, size_t gs) {
    const f32x4* PART = (const f32x4*)(p.ws + WS_PART); const f32x4* G = (const f32x4*)(p.ws + WS_G); f32x4* A = (f32x4*)(p.ws + WS_ACO);
    const size_t n4 = (size_t)M * 128 / 4;
    for (size_t i = gt; i < n4; i += gs) {
        f32x4 h = PART[i];
#pragma unroll
        for (int x = 1; x < 8; ++x) h = h + PART[i + (size_t)x * n4];
#if !defined(PEER_BF16)
        h = h * (1.0f / PEER_SU);
#endif
        const f32x4 g = G[i];
        f32x4 a; a.x = gelu_exact(h.x) * g.x; a.y = gelu_exact(h.y) * g.y; a.z = gelu_exact(h.z) * g.z; a.w = gelu_exact(h.w) * g.w;
        A[i] = a;
    }
}
__device__ __forceinline__ void peer_spmm(const Params& p, int bx, int wave, int lane) {
    const int x = bx & 7, j = bx >> 3, c = lane & 15, q = lane >> 4;
    const bf16_t* VT = (const bf16_t*)(p.ws + WS_VTB) + 128 * x + 8 * c;
    const int* IDS = (const int*)(p.ws + WS_IDS); const float* A = (const float*)(p.ws + WS_ACO);
    float* FFN = (float*)(p.ws + WS_FFN) + 128 * x + 8 * c;
    for (int tt = 0; tt < 64; ++tt) {
        const int t = 512 * j + 64 * wave + tt;
        const int* idp = IDS + (size_t)t * 128 + 32 * q; const float* ap = A + (size_t)t * 128 + 32 * q;
        float acc[8];
#pragma unroll
        for (int i = 0; i < 8; ++i) acc[i] = 0.f;
#pragma unroll
        for (int g = 0; g < 8; ++g) {
            const int4 id4 = *(const int4*)(idp + 4 * g); const f32x4 a4 = *(const f32x4*)(ap + 4 * g);
            const u32x4 v0 = *(const u32x4*)(VT + (size_t)id4.x * 1024), v1 = *(const u32x4*)(VT + (size_t)id4.y * 1024);
            const u32x4 v2 = *(const u32x4*)(VT + (size_t)id4.z * 1024), v3 = *(const u32x4*)(VT + (size_t)id4.w * 1024);
#define PEER_ACC(v, a) do { acc[0] += (a) * __uint_as_float((v).x << 16); acc[1] += (a) * __uint_as_float((v).x & 0xffff0000u); acc[2] += (a) * __uint_as_float((v).y << 16); acc[3] += (a) * __uint_as_float((v).y & 0xffff0000u); \
            acc[4] += (a) * __uint_as_float((v).z << 16); acc[5] += (a) * __uint_as_float((v).z & 0xffff0000u); acc[6] += (a) * __uint_as_float((v).w << 16); acc[7] += (a) * __uint_as_float((v).w & 0xffff0000u); } while (0)
            PEER_ACC(v0, a4.x); PEER_ACC(v1, a4.y); PEER_ACC(v2, a4.z); PEER_ACC(v3, a4.w);
#undef PEER_ACC
        }
#pragma unroll
        for (int i = 0; i < 8; ++i) { acc[i] += __shfl_xor(acc[i], 16); acc[i] += __shfl_xor(acc[i], 32); }
        if (q == 0) { float* o = FFN + (size_t)t * 1024; *(f32x4*)o = (f32x4){acc[0], acc[1], acc[2], acc[3]}; *(f32x4*)(o + 4) = (f32x4){acc[4], acc[5], acc[6], acc[7]}; }
    }
}
__device__ __forceinline__ void stage_ln2(const Params& p, int gw, int ngw, int lane) {
    const float* FFN = (const float*)(p.ws + WS_FFN);
    for (int row = gw; row < M; row += ngw) {
        f32x4* xr = (f32x4*)(p.out + (size_t)row * 1024) + lane; const f32x4* fr = (const f32x4*)(FFN + (size_t)row * 1024) + lane;
        f32x4 v[4]; float s = 0.f;
#pragma unroll
        for (int jj = 0; jj < 4; ++jj) { v[jj] = ALPHA * xr[64 * jj] + fr[64 * jj]; s += (v[jj].x + v[jj].y) + (v[jj].z + v[jj].w); }
        const float mean = wave_sum(s) * (1.f / 1024.f); float s2 = 0.f;
#pragma unroll
        for (int jj = 0; jj < 4; ++jj) { v[jj] = v[jj] - mean; s2 += (v[jj].x * v[jj].x + v[jj].y * v[jj].y) + (v[jj].z * v[jj].z + v[jj].w * v[jj].w); }
        const float rstd = 1.f / sqrtf(wave_sum(s2) * (1.f / 1024.f) + LN_EPS);
#pragma unroll
        for (int jj = 0; jj < 4; ++jj) { const f32x4 g = ((const f32x4*)p.ln2_g)[lane + 64 * jj], bb = ((const f32x4*)p.ln2_b)[lane + 64 * jj];
            xr[64 * jj] = v[jj] * rstd * g + bb; }
    }
}

__device__ __forceinline__ void naive_peer_from_a(const Params& p, int gw, int ngw, int lane) {
    const bf16_t* VT = (const bf16_t*)(p.ws + WS_VTB);
    const int* IDS = (const int*)(p.ws + WS_IDS); const float* A = (const float*)(p.ws + WS_ACO);
    for (int row = gw; row < M; row += ngw) {
        f32x4* xr = (f32x4*)(p.out + (size_t)row * 1024) + lane;
        f32x4 xv[4], acc[4];
#pragma unroll
        for (int j = 0; j < 4; ++j) { xv[j] = xr[64 * j]; acc[j] = (f32x4){0.f, 0.f, 0.f, 0.f}; }
        for (int e = 0; e < 128; ++e) {
            const int id = IDS[(size_t)row * 128 + e]; const float a = A[(size_t)row * 128 + e];
            const u32x2* vr = (const u32x2*)(VT + (size_t)id * 1024) + lane;
#pragma unroll
            for (int j = 0; j < 4; ++j) { const u32x2 u = vr[64 * j];
                acc[j].x += a * bf2f(u.x & 0xffffu); acc[j].y += a * bf2f(u.x >> 16); acc[j].z += a * bf2f(u.y & 0xffffu); acc[j].w += a * bf2f(u.y >> 16); }
        }
        float s = 0.f;
#pragma unroll
        for (int j = 0; j < 4; ++j) { acc[j] = ALPHA * xv[j] + acc[j]; s += (acc[j].x + acc[j].y) + (acc[j].z + acc[j].w); }
        const float mean = wave_sum(s) * (1.f / 1024.f); float s2 = 0.f;
#pragma unroll
        for (int j = 0; j < 4; ++j) { acc[j] = acc[j] - mean; s2 += (acc[j].x * acc[j].x + acc[j].y * acc[j].y) + (acc[j].z * acc[j].z + acc[j].w * acc[j].w); }
        const float rstd = 1.f / sqrtf(wave_sum(s2) * (1.f / 1024.f) + LN_EPS);
#pragma unroll
        for (int j = 0; j < 4; ++j) { const f32x4 g = ((const f32x4*)p.ln2_g)[lane + 64 * j], bb = ((const f32x4*)p.ln2_b)[lane + 64 * j];
            xr[64 * j] = acc[j] * rstd * g + bb; }
    }
}

constexpr size_t WS_U8 = 160 * MiB, WS_V8 = 176 * MiB;
typedef float f32x2p __attribute__((ext_vector_type(2)));
__device__ __forceinline__ void convert_fp8(const float* src, unsigned char* dst, size_t n, float scale, size_t gtid, size_t gsize) {
    const size_t n4 = n / 4;
    for (size_t i = gtid; i < n4; i += gsize) { const f32x4 v = ((const f32x4*)src)[i] * scale;
        int pk = __builtin_amdgcn_cvt_pk_fp8_f32(v.x, v.y, 0, false); pk = __builtin_amdgcn_cvt_pk_fp8_f32(v.z, v.w, pk, true);
        ((int*)dst)[i] = pk; }
}
#define FP8_DOT4(acc, w, x0, x1, x2, x3) do { const f32x2p lo_ = __builtin_amdgcn_cvt_pk_f32_fp8((int)(w), false), hi_ = __builtin_amdgcn_cvt_pk_f32_fp8((int)(w), true); \
    acc += (x0) * lo_.x; acc += (x1) * lo_.y; acc += (x2) * hi_.x; acc += (x3) * hi_.y; } while (0)
#define SB0() __builtin_amdgcn_sched_barrier(0)
#define PEER_ROWS8(R, I0, I1) do { R[0] = __builtin_amdgcn_raw_buffer_load_b128(rs, (I0).x * 1024 + loff, 0, 0); R[1] = __builtin_amdgcn_raw_buffer_load_b128(rs, (I0).y * 1024 + loff, 0, 0); \
        R[2] = __builtin_amdgcn_raw_buffer_load_b128(rs, (I0).z * 1024 + loff, 0, 0); R[3] = __builtin_amdgcn_raw_buffer_load_b128(rs, (I0).w * 1024 + loff, 0, 0); \
        R[4] = __builtin_amdgcn_raw_buffer_load_b128(rs, (I1).x * 1024 + loff, 0, 0); R[5] = __builtin_amdgcn_raw_buffer_load_b128(rs, (I1).y * 1024 + loff, 0, 0); \
        R[6] = __builtin_amdgcn_raw_buffer_load_b128(rs, (I1).z * 1024 + loff, 0, 0); R[7] = __builtin_amdgcn_raw_buffer_load_b128(rs, (I1).w * 1024 + loff, 0, 0); } while (0)
#define PEER_IDS(ID, tt) do { const int* ip_ = IDS + (size_t)(t0 + ((tt) < 63 ? (tt) : 63)) * 128; ID[0] = *(const int4*)ip_; ID[1] = *(const int4*)(ip_ + 4); ID[2] = *(const int4*)(ip_ + 8); ID[3] = *(const int4*)(ip_ + 12); } while (0)
__device__ __forceinline__ void peer_sddmm8(const Params& p, int bx, int wave, int lane) {
    const int x = bx & 7, j = bx >> 3, c = lane & 7, q = lane >> 3;
    const __amdgpu_buffer_rsrc_t rs = __builtin_amdgcn_make_buffer_rsrc((void*)(p.ws + WS_U8), 0, 16 << 20, 0x00020000);
    const int loff = 128 * x + 16 * c;
    const float* XS = p.out + 128 * x + 16 * c;
    const int* IDS = (const int*)(p.ws + WS_IDS) + 16 * q;
    float* PART = (float*)(p.ws + WS_PART) + (size_t)x * M * 128 + 2 * lane;
    const int t0 = 512 * j + 64 * wave;
#define SD_X(X, tt) do { const float* xp_ = XS + (size_t)(t0 + ((tt) < 63 ? (tt) : 63)) * 1024; X[0] = *(const f32x4*)xp_; X[1] = *(const f32x4*)(xp_ + 4); X[2] = *(const f32x4*)(xp_ + 8); X[3] = *(const f32x4*)(xp_ + 12); } while (0)
#define SD_HALF(R, X, S, o) do { _Pragma("unroll") for (int k_ = 0; k_ < 8; ++k_) { float a_ = 0.f; \
            FP8_DOT4(a_, R[k_].x, X[0].x, X[0].y, X[0].z, X[0].w); FP8_DOT4(a_, R[k_].y, X[1].x, X[1].y, X[1].z, X[1].w); FP8_DOT4(a_, R[k_].z, X[2].x, X[2].y, X[2].z, X[2].w); FP8_DOT4(a_, R[k_].w, X[3].x, X[3].y, X[3].z, X[3].w); S[(o) + k_] = a_; if (k_ & 1) SB0(); } } while (0)
#define SD_STORE(S, tt) do { float r8[8], r4[4], r2[2]; \
        { const bool up = (c & 4) != 0; _Pragma("unroll") for (int i = 0; i < 8; ++i) { const float snd = up ? S[i] : S[i + 8], kp = up ? S[i + 8] : S[i]; r8[i] = kp + __shfl_xor(snd, 4); } } \
        { const bool up = (c & 2) != 0; _Pragma("unroll") for (int i = 0; i < 4; ++i) { const float snd = up ? r8[i] : r8[i + 4], kp = up ? r8[i + 4] : r8[i]; r4[i] = kp + __shfl_xor(snd, 2); } } \
        { const bool up = (c & 1) != 0; _Pragma("unroll") for (int i = 0; i < 2; ++i) { const float snd = up ? r4[i] : r4[i + 2], kp = up ? r4[i + 2] : r4[i]; r2[i] = kp + __shfl_xor(snd, 1); } } \
        *(float2*)(PART + (size_t)(t0 + (tt)) * 128) = make_float2(r2[0], r2[1]); } while (0)
    int4 idA[4], idB[4]; f32x4 xA[4], xB[4]; u32x4 rP[8], rQ[8]; float s[16];
    PEER_IDS(idA, 0); SD_X(xA, 0); SB0(); PEER_ROWS8(rP, idA[0], idA[1]); SB0();
#pragma unroll 1
    for (int tt = 0; tt < 64; tt += 2) {
        PEER_ROWS8(rQ, idA[2], idA[3]); SB0();
        PEER_IDS(idB, tt + 1); SD_X(xB, tt + 1); SB0();
        SD_HALF(rP, xA, s, 0); SB0();
        PEER_ROWS8(rP, idB[0], idB[1]); SB0();
        SD_HALF(rQ, xA, s, 8); SD_STORE(s, tt); SB0();
        PEER_ROWS8(rQ, idB[2], idB[3]); SB0();
        PEER_IDS(idA, tt + 2); SD_X(xA, tt + 2); SB0();
        SD_HALF(rP, xB, s, 0); SB0();
        PEER_ROWS8(rP, idA[0], idA[1]); SB0();
        SD_HALF(rQ, xB, s, 8); SD_STORE(s, tt + 1); SB0();
    }
#undef SD_X
#undef SD_HALF
#undef SD_STORE
}
__device__ __forceinline__ void peer_spmm8(const Params& p, int bx, int wave, int lane) {
    const int x = bx & 7, j = bx >> 3, c = lane & 7, q = lane >> 3;
    const __amdgpu_buffer_rsrc_t rs = __builtin_amdgcn_make_buffer_rsrc((void*)(p.ws + WS_V8), 0, 16 << 20, 0x00020000);
    const int loff = 128 * x + 16 * c;
    const int* IDS = (const int*)(p.ws + WS_IDS) + 16 * q; const float* A = (const float*)(p.ws + WS_ACO) + 16 * q;
    float* FFN = (float*)(p.ws + WS_FFN) + 128 * x + 16 * c + 2 * q;
    const int t0 = 512 * j + 64 * wave;
#define SP_A(AV, tt) do { const float* ap_ = A + (size_t)(t0 + ((tt) < 63 ? (tt) : 63)) * 128; \
        AV[0] = *(const f32x4*)ap_; AV[1] = *(const f32x4*)(ap_ + 4); AV[2] = *(const f32x4*)(ap_ + 8); AV[3] = *(const f32x4*)(ap_ + 12); } while (0)
#define SP_ROW(Rk, a) do { u32x4 w_ = (Rk); asm volatile("" : "+v"(w_) : "v"(acc[0]), "v"(acc[7])); const f32x2p a2_ = {(a), (a)}; \
        acc[0] = __builtin_elementwise_fma(a2_, __builtin_amdgcn_cvt_pk_f32_fp8((int)w_.x, false), acc[0]); acc[1] = __builtin_elementwise_fma(a2_, __builtin_amdgcn_cvt_pk_f32_fp8((int)w_.x, true), acc[1]); \
        acc[2] = __builtin_elementwise_fma(a2_, __builtin_amdgcn_cvt_pk_f32_fp8((int)w_.y, false), acc[2]); acc[3] = __builtin_elementwise_fma(a2_, __builtin_amdgcn_cvt_pk_f32_fp8((int)w_.y, true), acc[3]); \
        acc[4] = __builtin_elementwise_fma(a2_, __builtin_amdgcn_cvt_pk_f32_fp8((int)w_.z, false), acc[4]); acc[5] = __builtin_elementwise_fma(a2_, __builtin_amdgcn_cvt_pk_f32_fp8((int)w_.z, true), acc[5]); \
        acc[6] = __builtin_elementwise_fma(a2_, __builtin_amdgcn_cvt_pk_f32_fp8((int)w_.w, false), acc[6]); acc[7] = __builtin_elementwise_fma(a2_, __builtin_amdgcn_cvt_pk_f32_fp8((int)w_.w, true), acc[7]); } while (0)
#define SP_HALF(R, A0, A1) do { SP_ROW(R[0], (A0).x); SP_ROW(R[1], (A0).y); SP_ROW(R[2], (A0).z); SP_ROW(R[3], (A0).w); SP_ROW(R[4], (A1).x); SP_ROW(R[5], (A1).y); SP_ROW(R[6], (A1).z); SP_ROW(R[7], (A1).w); } while (0)
#define SP_STORE(tt) do { f32x2p r4_[4], r2_[2], r1_; \
        { const bool up = (q & 4) != 0; _Pragma("unroll") for (int i = 0; i < 4; ++i) { const f32x2p snd = up ? acc[i] : acc[i + 4], kp = up ? acc[i + 4] : acc[i]; r4_[i].x = kp.x + __shfl_xor(snd.x, 32); r4_[i].y = kp.y + __shfl_xor(snd.y, 32); } } \
        { const bool up = (q & 2) != 0; _Pragma("unroll") for (int i = 0; i < 2; ++i) { const f32x2p snd = up ? r4_[i] : r4_[i + 2], kp = up ? r4_[i + 2] : r4_[i]; r2_[i].x = kp.x + __shfl_xor(snd.x, 16); r2_[i].y = kp.y + __shfl_xor(snd.y, 16); } } \
        { const bool up = (q & 1) != 0; const f32x2p snd = up ? r2_[0] : r2_[1], kp = up ? r2_[1] : r2_[0]; r1_.x = kp.x + __shfl_xor(snd.x, 8); r1_.y = kp.y + __shfl_xor(snd.y, 8); } \
        *(float2*)(FFN + (size_t)(t0 + (tt)) * 1024) = make_float2(r1_.x * (1.0f / PEER_SV), r1_.y * (1.0f / PEER_SV)); \
        _Pragma("unroll") for (int i = 0; i < 8; ++i) acc[i] = (f32x2p){0.f, 0.f}; } while (0)
    int4 idA[4], idB[4]; f32x4 aA[4], aB[4]; u32x4 rP[8], rQ[8]; f32x2p acc[8];
#pragma unroll
    for (int i = 0; i < 8; ++i) acc[i] = (f32x2p){0.f, 0.f};
    PEER_IDS(idA, 0); SP_A(aA, 0); SB0(); PEER_ROWS8(rP, idA[0], idA[1]); SB0();
#pragma unroll 1
    for (int tt = 0; tt < 64; tt += 2) {
        PEER_ROWS8(rQ, idA[2], idA[3]); SB0();
        PEER_IDS(idB, tt + 1); SP_A(aB, tt + 1); SB0();
        SP_HALF(rP, aA[0], aA[1]); SB0();
        PEER_ROWS8(rP, idB[0], idB[1]); SB0();
        SP_HALF(rQ, aA[2], aA[3]); SP_STORE(tt); SB0();
        PEER_ROWS8(rQ, idB[2], idB[3]); SB0();
        PEER_IDS(idA, tt + 2); SP_A(aA, tt + 2); SB0();
        SP_HALF(rP, aB[0], aB[1]); SB0();
        PEER_ROWS8(rP, idA[0], idA[1]); SB0();
        SP_HALF(rQ, aB[2], aB[3]); SP_STORE(tt + 1); SB0();
    }
#undef SP_A
#undef SP_ROW
#undef SP_HALF
#undef SP_STORE
}

__device__ __forceinline__ int crow16(int r, int hi) { return (r & 3) + 8 * (r >> 2) + 4 * hi; }
__device__ __forceinline__ bf16x8 acc_frag(const f32x16& a, int s8) {
    u32x4 w; w.x = pg8::cvt_pk_bf16(a[s8 + 0], a[s8 + 1]); w.y = pg8::cvt_pk_bf16(a[s8 + 2], a[s8 + 3]); w.z = pg8::cvt_pk_bf16(a[s8 + 4], a[s8 + 5]); w.w = pg8::cvt_pk_bf16(a[s8 + 6], a[s8 + 7]);
    return __builtin_bit_cast(bf16x8, w);
}
constexpr int MX_KS = 272, MX_VS = 528, MX_VT_OFF = 256 * MX_KS;
__device__ __forceinline__ void mx_attn_phase(const Params& p, unsigned char* lds, int bx) {
    int tid = threadIdx.x; asm volatile("" : "+v"(tid));
    const int lane = tid & 63, wave = __builtin_amdgcn_readfirstlane(tid >> 6), r32 = lane & 31, h2 = lane >> 5;
    const int b = bx >> 7, hh = (bx >> 5) & 3, qb = bx & 31;
    const bf16_t* KV = (const bf16_t*)(p.ws + WS_MEMKV) + (size_t)b * MEMLEN * 1024 + hh * 128;
#pragma unroll
    for (int i = 0; i < 8; ++i) {
        const int idx = tid + 512 * i, row = idx >> 4, ch = idx & 15;
        const u32x4 kk = *(const u32x4*)(KV + (size_t)row * 1024 + ch * 8);
        *(u32x4*)(lds + row * MX_KS + ch * 16) = kk;
        const u32x4 vv = *(const u32x4*)(KV + (size_t)row * 1024 + 512 + ch * 8);
        bf16_t* vt = (bf16_t*)(lds + MX_VT_OFF) + (ch * 8) * (MX_VS / 2) + row;
        vt[0 * (MX_VS / 2)] = (bf16_t)(vv.x & 0xffffu); vt[1 * (MX_VS / 2)] = (bf16_t)(vv.x >> 16); vt[2 * (MX_VS / 2)] = (bf16_t)(vv.y & 0xffffu); vt[3 * (MX_VS / 2)] = (bf16_t)(vv.y >> 16);
        vt[4 * (MX_VS / 2)] = (bf16_t)(vv.z & 0xffffu); vt[5 * (MX_VS / 2)] = (bf16_t)(vv.z >> 16); vt[6 * (MX_VS / 2)] = (bf16_t)(vv.w & 0xffffu); vt[7 * (MX_VS / 2)] = (bf16_t)(vv.w >> 16);
    }
    __syncthreads();
    const size_t qrow = (size_t)b * SEQ + qb * 256 + wave * 32;
    const bf16_t* Qp = (const bf16_t*)(p.ws + WS_MXQ) + (qrow + r32) * 512 + hh * 128 + 8 * h2;
    bf16x8 qr[8];
#pragma unroll
    for (int ks = 0; ks < 8; ++ks) qr[ks] = *(const bf16x8*)(Qp + 16 * ks);
    f32x16 o[4];
#pragma unroll
    for (int dt = 0; dt < 4; ++dt)
#pragma unroll
        for (int r = 0; r < 16; ++r) o[dt][r] = 0.f;
    float m = -1e30f, l = 0.f;
#pragma unroll 1
    for (int half = 0; half < 2; ++half) {
        f32x16 st[4];
#pragma unroll
        for (int kt = 0; kt < 4; ++kt) {
#pragma unroll
            for (int r = 0; r < 16; ++r) st[kt][r] = 0.f;
            const unsigned char* kp = lds + (half * 128 + kt * 32 + r32) * MX_KS + 16 * h2;
#pragma unroll
            for (int ks = 0; ks < 8; ++ks) st[kt] = __builtin_amdgcn_mfma_f32_32x32x16_bf16(*(const bf16x8*)(kp + 32 * ks), qr[ks], st[kt], 0, 0, 0);
        }
        float mx = st[0][0];
#pragma unroll
        for (int kt = 0; kt < 4; ++kt)
#pragma unroll
            for (int r = 0; r < 16; ++r) mx = fmaxf(mx, st[kt][r]);
        mx = fmaxf(mx, __shfl_xor(mx, 32));
        const float mn = fmaxf(m, mx), alpha = exp2f(m - mn);
        m = mn;
        float ls = 0.f;
#pragma unroll
        for (int kt = 0; kt < 4; ++kt)
#pragma unroll
            for (int r = 0; r < 16; ++r) { st[kt][r] = exp2f(st[kt][r] - mn); ls += st[kt][r]; }
        l = l * alpha + ls;
#pragma unroll
        for (int dt = 0; dt < 4; ++dt)
#pragma unroll
            for (int r = 0; r < 16; ++r) o[dt][r] *= alpha;
#pragma unroll
        for (int kt = 0; kt < 4; ++kt)
#pragma unroll
            for (int s2 = 0; s2 < 2; ++s2) {
                const bf16x8 bfrag = acc_frag(st[kt], 8 * s2);
                const int kbase = half * 128 + kt * 32 + 16 * s2 + 4 * h2;
#pragma unroll
                for (int dt = 0; dt < 4; ++dt) {
                    const unsigned char* vp = lds + MX_VT_OFF + (dt * 32 + r32) * MX_VS + kbase * 2;
                    const u32x2 lo = *(const u32x2*)vp, hi = *(const u32x2*)(vp + 16);
                    const u32x4 av = {lo.x, lo.y, hi.x, hi.y};
                    o[dt] = __builtin_amdgcn_mfma_f32_32x32x16_bf16(__builtin_bit_cast(bf16x8, av), bfrag, o[dt], 0, 0, 0);
                }
            }
    }
    l += __shfl_xor(l, 32);
    const float inv = 1.0f / l;
    __syncthreads();
    unsigned char* stg = lds + wave * (32 * MX_KS);
#pragma unroll
    for (int dt = 0; dt < 4; ++dt)
#pragma unroll
        for (int r4 = 0; r4 < 4; ++r4) {
            u32x2 w; w.x = pg8::cvt_pk_bf16(o[dt][4 * r4 + 0] * inv, o[dt][4 * r4 + 1] * inv); w.y = pg8::cvt_pk_bf16(o[dt][4 * r4 + 2] * inv, o[dt][4 * r4 + 3] * inv);
            *(u32x2*)(stg + r32 * MX_KS + (dt * 32 + 8 * r4 + 4 * h2) * 2) = w;
        }
    asm volatile("s_waitcnt lgkmcnt(0)" ::: "memory");
    bf16_t* Op = (bf16_t*)(p.ws + WS_OMX) + qrow * 512 + hh * 128;
#pragma unroll
    for (int i = 0; i < 8; ++i) { const int row = i * 4 + (lane >> 4), ch = lane & 15;
        *(u32x4*)(Op + (size_t)row * 512 + ch * 8) = *(const u32x4*)(stg + row * MX_KS + ch * 16); }
    __syncthreads();
}
constexpr int SB_VS = 80;
__device__ __forceinline__ void sb_attn_unit(const Params& p, unsigned char* lds, int unit) {
    int tid = threadIdx.x; asm volatile("" : "+v"(tid));
    const int lane = tid & 63, wave = __builtin_amdgcn_readfirstlane(tid >> 6), r32 = lane & 31, h2 = lane >> 5;
    const int b = unit >> 8, hh = (unit >> 5) & 7, qb = unit & 31;
    const int q0 = qb * 256 + wave * 32;
    const bf16_t* Kb = (const bf16_t*)(p.ws + WS_SBK) + (size_t)b * SEQ * 512 + hh * 64;
    const bf16_t* Vb = (const bf16_t*)(p.ws + WS_SBV) + (size_t)b * SEQ * 512 + hh * 64;
    const bf16_t* Qp = (const bf16_t*)(p.ws + WS_SBQ) + ((size_t)b * SEQ + q0 + r32) * 512 + hh * 64 + 8 * h2;
    unsigned char* vt = lds + wave * 5120;
    bf16x8 qr[4];
#pragma unroll
    for (int ks = 0; ks < 4; ++ks) qr[ks] = *(const bf16x8*)(Qp + 16 * ks);
    f32x16 o[2];
#pragma unroll
    for (int dt = 0; dt < 2; ++dt)
#pragma unroll
        for (int r = 0; r < 16; ++r) o[dt][r] = 0.f;
    float R = 0.f;
    const int t = q0 + r32;
    for (int kb = q0; kb >= 0; kb -= 32) {
        f32x16 st;
#pragma unroll
        for (int r = 0; r < 16; ++r) st[r] = 0.f;
        const bf16_t* kp = Kb + (size_t)(kb + r32) * 512 + 8 * h2;
#pragma unroll
        for (int ks = 0; ks < 4; ++ks) st = __builtin_amdgcn_mfma_f32_32x32x16_bf16(*(const bf16x8*)(kp + 16 * ks), qr[ks], st, 0, 0, 0);
#pragma unroll
        for (int i = 0; i < 4; ++i) { const int idx = lane + 64 * i, key = idx >> 3, ch = idx & 7;
            const u32x4 vv = *(const u32x4*)(Vb + (size_t)(kb + key) * 512 + ch * 8);
            bf16_t* d = (bf16_t*)vt + (ch * 8) * (SB_VS / 2) + key;
            d[0 * (SB_VS / 2)] = (bf16_t)(vv.x & 0xffffu); d[1 * (SB_VS / 2)] = (bf16_t)(vv.x >> 16); d[2 * (SB_VS / 2)] = (bf16_t)(vv.y & 0xffffu); d[3 * (SB_VS / 2)] = (bf16_t)(vv.y >> 16);
            d[4 * (SB_VS / 2)] = (bf16_t)(vv.z & 0xffffu); d[5 * (SB_VS / 2)] = (bf16_t)(vv.z >> 16); d[6 * (SB_VS / 2)] = (bf16_t)(vv.w & 0xffffu); d[7 * (SB_VS / 2)] = (bf16_t)(vv.w >> 16); }
        float sp[16];
#pragma unroll
        for (int r = 0; r < 16; ++r) { const float y = st[r]; const bool act = (kb + crow16(r, h2)) < t;
            sp[r] = act ? (fmaxf(y, 0.f) + __builtin_amdgcn_logf(1.0f + __builtin_amdgcn_exp2f(-fabsf(y)))) : 0.f; }
        float suf[16], gs[4], pg[4];
#pragma unroll
        for (int g = 0; g < 4; ++g) { suf[4 * g + 3] = sp[4 * g + 3]; suf[4 * g + 2] = suf[4 * g + 3] + sp[4 * g + 2]; suf[4 * g + 1] = suf[4 * g + 2] + sp[4 * g + 1]; suf[4 * g + 0] = suf[4 * g + 1] + sp[4 * g + 0]; gs[g] = suf[4 * g]; }
#pragma unroll
        for (int g = 0; g < 4; ++g) pg[g] = __shfl_xor(gs[g], 32);
        float off[4];
        {
          const float pe3 = pg[3], pe2 = pe3 + pg[2], pe1 = pe2 + pg[1], pe0 = pe1 + pg[0];
          const float me3 = 0.f, me2 = gs[3], me1 = me2 + gs[2], me0 = me1 + gs[1];
          off[3] = me3 + (h2 ? 0.f : pe3); off[2] = me2 + (h2 ? pe3 : pe2); off[1] = me1 + (h2 ? pe2 : pe1); off[0] = me0 + (h2 ? pe1 : pe0);
          const float T = pe0 + me0 + gs[0];
#pragma unroll
          for (int r = 0; r < 16; ++r) { const bool act = (kb + crow16(r, h2)) < t; const float c = R + off[r >> 2] + suf[r];
              st[r] = act ? __builtin_amdgcn_exp2f(st[r] - c) : 0.f; }
          R += T; }
        asm volatile("s_waitcnt lgkmcnt(0)" ::: "memory");
#pragma unroll
        for (int s2 = 0; s2 < 2; ++s2) {
            const bf16x8 bfrag = acc_frag(st, 8 * s2);
#pragma unroll
            for (int dt = 0; dt < 2; ++dt) {
                const unsigned char* vp = vt + (dt * 32 + r32) * SB_VS + (16 * s2 + 4 * h2) * 2;
                const u32x2 lo = *(const u32x2*)vp, hi = *(const u32x2*)(vp + 16);
                const u32x4 av = {lo.x, lo.y, hi.x, hi.y};
                o[dt] = __builtin_amdgcn_mfma_f32_32x32x16_bf16(__builtin_bit_cast(bf16x8, av), bfrag, o[dt], 0, 0, 0);
            }
        }
        asm volatile("s_waitcnt lgkmcnt(0)" ::: "memory");
        if (__all(R > SB_EXIT_BITS)) break;
    }
#pragma unroll
    for (int dt = 0; dt < 2; ++dt)
#pragma unroll
        for (int r4 = 0; r4 < 4; ++r4) {
            u32x2 w; w.x = pg8::cvt_pk_bf16(o[dt][4 * r4 + 0], o[dt][4 * r4 + 1]); w.y = pg8::cvt_pk_bf16(o[dt][4 * r4 + 2], o[dt][4 * r4 + 3]);
            *(u32x2*)(vt + r32 * 144 + (dt * 32 + 8 * r4 + 4 * h2) * 2) = w;
        }
    asm volatile("s_waitcnt lgkmcnt(0)" ::: "memory");
    bf16_t* Op = (bf16_t*)(p.ws + WS_OSB) + ((size_t)b * SEQ + q0) * 512 + hh * 64;
#pragma unroll
    for (int i = 0; i < 4; ++i) { const int row = i * 8 + (lane >> 3), ch = lane & 7;
        *(u32x4*)(Op + (size_t)row * 512 + ch * 8) = *(const u32x4*)(vt + row * 144 + ch * 16); }
    asm volatile("s_waitcnt lgkmcnt(0)" ::: "memory");
}

__device__ __forceinline__ unsigned mono_u32(float f) { const unsigned u = __float_as_uint(f); return (u & 0x80000000u) ? ~u : (u | 0x80000000u); }
__device__ __forceinline__ float mono_f32(unsigned k) { return __uint_as_float((k & 0x80000000u) ? (k ^ 0x80000000u) : ~k); }
#define RT_INSERT(t, key) do { unsigned x_ = (key); _Pragma("unroll") for (int j_ = 0; j_ < 16; ++j_) { const unsigned hi_ = max(t[j_], x_); x_ = min(t[j_], x_); t[j_] = hi_; } } while (0)
__device__ __forceinline__ void route_unit(const Params& p, unsigned char* lds, int unit) {
    int tid = threadIdx.x; asm volatile("" : "+v"(tid));
    const int lane = tid & 63, wave = __builtin_amdgcn_readfirstlane(tid >> 6), r32 = lane & 31, h2 = lane >> 5;
    const int hh = unit & 7, tok0 = (unit >> 3) * 256 + wave * 32;
    unsigned* L = (unsigned*)(lds + wave * 8192) + lane;
    const unsigned char* PT = lds + 65536;
    unsigned tk[2][16];
#pragma unroll
    for (int pp = 0; pp < 2; ++pp) {
        const bf16_t* Qp = (const bf16_t*)(p.ws + WS_QP) + (size_t)(tok0 + r32) * 2048 + (hh * 2 + pp) * 128 + 8 * h2;
        const bf16_t* Kp = (const bf16_t*)(p.ws + WS_SUBK) + ((size_t)(hh * 2 + pp) * 128 + r32) * 128 + 8 * h2;
        bf16x8 qr[8];
#pragma unroll
        for (int ks = 0; ks < 8; ++ks) qr[ks] = *(const bf16x8*)(Qp + 16 * ks);
        unsigned t[16];
#pragma unroll
        for (int j = 0; j < 16; ++j) t[j] = 0u;
#pragma unroll
        for (int kt = 0; kt < 4; ++kt) {
            f32x16 st;
#pragma unroll
            for (int r = 0; r < 16; ++r) st[r] = 0.f;
#pragma unroll
            for (int ks = 0; ks < 8; ++ks) st = __builtin_amdgcn_mfma_f32_32x32x16_bf16(*(const bf16x8*)(Kp + kt * 4096 + 16 * ks), qr[ks], st, 0, 0, 0);
#pragma unroll
            for (int r = 0; r < 16; ++r) { const unsigned key = (mono_u32(st[r]) & ~127u) | (unsigned)(127 - (32 * kt + (r & 3) + 8 * (r >> 2)) - 4 * h2); RT_INSERT(t, key); }
        }
        unsigned m[16];
#pragma unroll
        for (int j = 0; j < 16; ++j) m[j] = __shfl_xor(t[j], 32);
#pragma unroll
        for (int j = 0; j < 16; ++j) tk[pp][j] = max(t[j], m[15 - j]);
#pragma unroll
        for (int d = 8; d >= 1; d >>= 1)
#pragma unroll
            for (int i = 0; i < 16; ++i) if ((i & d) == 0) { const unsigned hi = max(tk[pp][i], tk[pp][i + d]), lo = min(tk[pp][i], tk[pp][i + d]); tk[pp][i] = hi; tk[pp][i + d] = lo; }
    }
    float tv0[16], tv1[16];
#pragma unroll
    for (int j = 0; j < 16; ++j) { tv0[j] = mono_f32(tk[0][j] & ~127u); tv1[j] = mono_f32(tk[1][j] & ~127u);
        L[j * 64] = 127u - (tk[0][j] & 127u); L[(16 + j) * 64] = 127u - (tk[1][j] & 127u); }
    unsigned bk[16];
#pragma unroll
    for (int j = 0; j < 16; ++j) bk[j] = 0u;
    { int c = 0;
#pragma unroll
      for (int k0 = 0; k0 < 16; ++k0)
#pragma unroll
        for (int k1 = 0; k1 < 16; ++k1)
            if ((k0 + 1) * (k1 + 1) <= 16) { const unsigned key = (mono_u32(tv0[k0] + tv1[k1]) & ~63u) | (unsigned)(63 - c); RT_INSERT(bk, key); ++c; } }
    asm volatile("s_waitcnt lgkmcnt(0)" ::: "memory");
    float e[16]; int ids[16]; float sum = 0.f;
    const float top = mono_f32(bk[0] & ~63u);
#pragma unroll
    for (int j = 0; j < 16; ++j) {
        const unsigned kk = PT[63u - (bk[j] & 63u)];
        ids[j] = (int)(L[(kk >> 4) * 64] * 128u + L[(16u + (kk & 15u)) * 64]);
        e[j] = __expf(mono_f32(bk[j] & ~63u) - top); sum += e[j];
    }
    const float rs = 1.0f / sum;
    const size_t ob = (size_t)(tok0 + r32) * 128 + hh * 16;
    if (h2 == 0) { int4* o = (int4*)((int*)(p.ws + WS_IDS) + ob);
        o[0] = make_int4(ids[0], ids[1], ids[2], ids[3]); o[1] = make_int4(ids[4], ids[5], ids[6], ids[7]); o[2] = make_int4(ids[8], ids[9], ids[10], ids[11]); o[3] = make_int4(ids[12], ids[13], ids[14], ids[15]); }
    else { f32x4* o = (f32x4*)((float*)(p.ws + WS_G) + ob);
        o[0] = (f32x4){e[0] * rs, e[1] * rs, e[2] * rs, e[3] * rs}; o[1] = (f32x4){e[4] * rs, e[5] * rs, e[6] * rs, e[7] * rs};
        o[2] = (f32x4){e[8] * rs, e[9] * rs, e[10] * rs, e[11] * rs}; o[3] = (f32x4){e[12] * rs, e[13] * rs, e[14] * rs, e[15] * rs}; }
    asm volatile("s_waitcnt lgkmcnt(0)" ::: "memory");
}
__device__ __forceinline__ void route_phase(const Params& p, unsigned char* lds, int bx, int G) {
    if (threadIdx.x < 50) {
        const unsigned char tab[50] = {0,1,2,3,4,5,6,7,8,9,10,11,12,13,14,15,16,17,18,19,20,21,22,23,32,33,34,35,36,48,49,50,51,64,65,66,80,81,96,97,112,113,128,144,160,176,192,208,224,240};
        unsigned v = 0;
#pragma unroll
        for (int i = 0; i < 50; ++i) v = ((int)threadIdx.x == i) ? tab[i] : v;
        lds[65536 + threadIdx.x] = (unsigned char)v;
    }
    __syncthreads();
    for (int u = bx; u < 512; u += G) route_unit(p, lds, u);
    __syncthreads();
}

#define LAS __attribute__((address_space(3)))
#define XB_TMO      128
#define XB_XCNT(j)  (256  + 64 * (j))
#define XB_XSUB(j)  (1280 + 64 * (j))
#define XB_XGEN(j)  (2304 + 64 * (j))
#define XB_TOP      3328
#define XB_TOPGEN   3392
#define XCD_BAR_WORDS 3456
#define XB_SPIN_CAP (1u << 18)

__device__ __forceinline__ unsigned xb_ld(unsigned* p)              { return __hip_atomic_load(p, __ATOMIC_RELAXED, __HIP_MEMORY_SCOPE_AGENT); }
__device__ __forceinline__ unsigned xb_add(unsigned* p, unsigned v) { return __hip_atomic_fetch_add(p, v, __ATOMIC_RELAXED, __HIP_MEMORY_SCOPE_AGENT); }
__device__ __forceinline__ unsigned xb_xcc_id() { return (unsigned)__builtin_amdgcn_s_getreg((3 << 11) | 20) & 0xFu; }
#define XB_SPIN(cond, bar) do { unsigned _sp = 0; while (cond) { __builtin_amdgcn_s_sleep(1); \
    if ((++_sp & 255u) == 0u) { if (xb_ld(&(bar)[XB_TMO])) break; if (_sp > XB_SPIN_CAP) { atomicAdd(&(bar)[XB_TMO], 1u); break; } } } } while (0)

struct XcdBarrier {
    unsigned* bar; unsigned x;
    volatile LAS unsigned* st;
};

__device__ __forceinline__ XcdBarrier xcd_barrier_post(unsigned* bar, volatile LAS unsigned* st) {
    XcdBarrier b; b.bar = bar; b.x = xb_xcc_id(); b.st = st;
    if (threadIdx.x == 0) (void)xb_add(&bar[XB_XCNT(b.x)], 1u);
    return b;
}
__device__ __forceinline__ void xcd_barrier_complete(unsigned* bar, unsigned x, unsigned& nloc, unsigned& nx) {
    const unsigned G = gridDim.x * gridDim.y * gridDim.z;
    unsigned sum, cnt, mine, sp = 0u;
    for (;;) {
        sum = 0u; cnt = 0u; mine = 0u;
#pragma unroll
        for (unsigned j = 0; j < 16; ++j) { const unsigned c = xb_ld(&bar[XB_XCNT(j)]); sum += c; cnt += (c > 0u) ? 1u : 0u; mine = (j == x) ? c : mine; }
        if (sum == G) break;
        __builtin_amdgcn_s_sleep(1);
        if ((++sp & 255u) == 0u) { if (xb_ld(&bar[XB_TMO])) break; if (sp > XB_SPIN_CAP) { atomicAdd(&bar[XB_TMO], 1u); break; } }
    }
    nloc = mine > 0u ? mine : 1u; nx = cnt > 0u ? cnt : 1u;
}

__device__ __forceinline__ void xcd_barrier(const XcdBarrier& b) {
    asm volatile("s_waitcnt vmcnt(0)" ::: "memory");
    __syncthreads();
    if (threadIdx.x == 0) {
        unsigned* bar = b.bar;
        __builtin_amdgcn_s_waitcnt(0);
        unsigned nloc = b.st[0], nx = b.st[1];
        if (nloc == 0u) { xcd_barrier_complete(bar, b.x, nloc, nx); b.st[0] = nloc; b.st[1] = nx; }
        const unsigned old = xb_add(&bar[XB_XSUB(b.x)], 1u);
        const unsigned gen = old / nloc;
        if (old + 1u == (gen + 1u) * nloc) {
            __builtin_amdgcn_fence(__ATOMIC_RELEASE, "agent");
            asm volatile("s_waitcnt vmcnt(0)" ::: "memory");
            const unsigned og = xb_add(&bar[XB_TOP], 1u);
            const unsigned tg = og / nx;
            if (og + 1u == (tg + 1u) * nx) xb_add(&bar[XB_TOPGEN], 1u);
            else XB_SPIN(xb_ld(&bar[XB_TOPGEN]) == tg, bar);
            __builtin_amdgcn_fence(__ATOMIC_ACQUIRE, "agent");
            xb_add(&bar[XB_XGEN(b.x)], 1u);
            asm volatile("s_waitcnt vmcnt(0)" ::: "memory");
        } else {
            XB_SPIN(xb_ld(&bar[XB_XGEN(b.x)]) == gen, bar);
            __builtin_amdgcn_fence(__ATOMIC_ACQUIRE, "agent");
            asm volatile("s_waitcnt vmcnt(0)" ::: "memory");
        }
    }
    __syncthreads();
}

constexpr int NTHREADS = 512, NWAVES = 8;
constexpr int LDS_BYTES = 147456;

__global__ void __launch_bounds__(NTHREADS, 2) mega(Params p) {
    extern __shared__ __attribute__((aligned(16))) unsigned char lds[];
    cg::grid_group grid = cg::this_grid();
    typedef pg8::bf16_t pbf;
    volatile LAS unsigned* MISC = (volatile LAS unsigned*)((LAS unsigned char*)lds + 147200);
    if (threadIdx.x < 32) MISC[threadIdx.x] = 0u;
    __syncthreads();
    XcdBarrier xbar = xcd_barrier_post((unsigned*)(p.ws + WS_CTL) + 4096, MISC + 8);
#define GSYNC() xcd_barrier(xbar)
#define PHASE_IDS() int tid = threadIdx.x; asm volatile("" : "+v"(tid)); const int lane = tid & 63, wave = __builtin_amdgcn_readfirstlane(tid >> 6); \
    const int G = gridDim.x, bx = blockIdx.x; const size_t gt = (size_t)bx * NTHREADS + tid, gs = (size_t)G * NTHREADS; const int gw = bx * NWAVES + wave, ngw = G * NWAVES; \
    PG8_LAS unsigned char* ldsl = (PG8_LAS unsigned char*)lds; (void)lane; (void)gt; (void)gs; (void)gw; (void)ngw; (void)ldsl;

#if !defined(SKIP_P0)
#ifndef REP_P0
#define REP_P0 1
#endif
    for (int rep_ = 0; rep_ < REP_P0; ++rep_) { PHASE_IDS()
    stage_transposes(p, (float*)(lds + wave * 8448), gw, ngw, lane);
    convert_bf16(p.x, (bf16_t*)(p.ws + WS_XB), (size_t)M * 1024, gt, gs);
    convert_bf16(p.mem, (bf16_t*)(p.ws + WS_MEMB), (size_t)512 * 1024, gt, gs);
    convert_bf16(p.sub_keys, (bf16_t*)(p.ws + WS_SUBK), (size_t)16 * 128 * 128, gt, gs);
    stage_rope(p, gt, gs);
    }
#endif
    grid.sync();
#if !defined(SKIP_P1)
#ifndef REP_P1
#define REP_P1 1
#endif
    for (int rep_ = 0; rep_ < REP_P1; ++rep_) { PHASE_IDS()
#if defined(NAIVE_P1)
    { EpiProj e{p.ws};
      naive_gemm((const bf16_t*)(p.ws + WS_XB), 1024, (const bf16_t*)(p.ws + WS_WIN), 1024, M, INW, 1024, e, gw, ngw, lane);
      EpiPlain e2{(bf16_t*)(p.ws + WS_MEMKV), 1024};
      naive_gemm((const bf16_t*)(p.ws + WS_MEMB), 1024, (const bf16_t*)(p.ws + WS_WMEMKV), 1024, 512, 1024, 1024, e2, gw, ngw, lane); }
#else
    { pg8::Gemm g{(const pbf*)(p.ws + WS_XB), (const pbf*)(p.ws + WS_WIN), M, INW, 1024}; pg8::StaticOrder S; S.init(M, INW, G, bx);
      pg8::EpiProjF E{p.ws};
      pg8::gemm_phase<pg8::EpiProjF, pg8::StaticOrder, PG8_ALIGN, PG8_SP2>(ldsl, g, S, E);
      pg8::Gemm g2{(const pbf*)(p.ws + WS_MEMB), (const pbf*)(p.ws + WS_WMEMKV), 512, 1024, 1024}; pg8::MemOrder S2{bx};
      pg8::EpiBf16<0> E2{(pbf*)(p.ws + WS_MEMKV), 1024, nullptr, 0, 0, 1.f};
      pg8::gemm_phase<pg8::EpiBf16<0>, pg8::MemOrder, PG8_ALIGN, PG8_SP2>(ldsl, g2, S2, E2); }
#endif
    }
#endif
    GSYNC();
#if !defined(SKIP_P2)
#ifndef REP_P2
#define REP_P2 1
#endif
    for (int rep_ = 0; rep_ < REP_P2; ++rep_) { PHASE_IDS()
    { const attn_body::AttnTensors AT{(const attn_body::bf16*)(p.ws + WS_DFQ), (const attn_body::bf16*)(p.ws + WS_DFK), (const attn_body::bf16*)(p.ws + WS_DFV), (attn_body::bf16*)(p.ws + WS_ODF16)};
      const attn_body::StaticOrder S(G, bx);
#if defined(NAIVE_DF)
      (void)AT; (void)S; naive_df_attn(p, gt, gs);
#else
      attn_body::attn_phase<attn_body::StaticOrder>((char*)lds, AT, S);
#endif
    }
    }
#endif
    GSYNC();
#if !defined(SKIP_P3)
#ifndef REP_P3
#define REP_P3 1
#endif
    for (int rep_ = 0; rep_ < REP_P3; ++rep_) { PHASE_IDS()
    stage_df_combine(p, gw, ngw, lane);
#if defined(NAIVE_SB)
    naive_sb_attn(p, gt, gs);
#else
    for (int u = bx; u < 512; u += G) sb_attn_unit(p, lds, u);
    __syncthreads();
#endif
#if defined(NAIVE_MX)
    naive_mx_attn(p, gt, gs);
#else
    if (G == 256) mx_attn_phase(p, lds, bx); else naive_mx_attn(p, gt, gs);
#endif
    }
#endif
    GSYNC();
#if !defined(SKIP_P4)
#ifndef REP_P4
#define REP_P4 1
#endif
    for (int rep_ = 0; rep_ < REP_P4; ++rep_) { PHASE_IDS()
#if defined(NAIVE_P4)
    { EpiGate e{(bf16_t*)(p.ws + WS_GATES), p.b_gate};
      naive_gemm((const bf16_t*)(p.ws + WS_XB), 1024, (const bf16_t*)(p.ws + WS_WGATE), 1024, M, 3072, 1024, e, gw, ngw, lane); }
    GSYNC();
    for (int b = 0; b < 3; ++b) {
        const size_t osrc = (b == 0) ? WS_OSB : (b == 1 ? WS_ODF : WS_OMX);
        EpiBranch e{(const bf16_t*)(p.ws + WS_GATES), b * 1024, p.out, (bf16_t*)(p.ws + WS_MERGEDB), b};
        naive_gemm((const bf16_t*)(p.ws + osrc), 512, (const bf16_t*)(p.ws + WS_WBR + (size_t)b * MiB), 512, M, 1024, 512, e, gw, ngw, lane);
    }
#else
    { pg8::StaticOrder S1; S1.init(M, 1024, G, bx); pg8::Unit base; const bool has = S1.next(0, base);
      if (has) {
#if defined(NAIVE_GATES)
        { EpiGate e{(bf16_t*)(p.ws + WS_GATES), p.b_gate};
          naive_gemm((const bf16_t*)(p.ws + WS_XB), 1024, (const bf16_t*)(p.ws + WS_WGATE), 1024, M, 3072, 1024, e, gw, ngw, lane); }
        GSYNC();
#else
        pg8::Gemm gg{(const pbf*)(p.ws + WS_XB), (const pbf*)(p.ws + WS_WGATE), M, 3072, 1024}; pg8::GateOrder SG{base};
        pg8::EpiGateF EG{(pbf*)(p.ws + WS_GATES), p.b_gate};
        pg8::gemm_phase<pg8::EpiGateF, pg8::GateOrder, PG8_ALIGN, PG8_SP2>(ldsl, gg, SG, EG);
#endif
#define P4_SEAM() do { asm volatile("s_waitcnt vmcnt(0)" ::: "memory"); __syncthreads(); if (tid < 64) { __builtin_amdgcn_fence(__ATOMIC_ACQUIRE, "agent"); asm volatile("s_waitcnt vmcnt(0)" ::: "memory"); } __syncthreads(); } while (0)
        P4_SEAM();
#if defined(NAIVE_BR)
    for (int b = 0; b < 3; ++b) {
        const size_t osrc = (b == 0) ? WS_OSB : (b == 1 ? WS_ODF : WS_OMX);
        EpiBranch e{(const bf16_t*)(p.ws + WS_GATES), b * 1024, p.out, (bf16_t*)(p.ws + WS_MERGEDB), b};
        naive_gemm((const bf16_t*)(p.ws + osrc), 512, (const bf16_t*)(p.ws + WS_WBR + (size_t)b * MiB), 512, M, 1024, 512, e, gw, ngw, lane);
    }
#else
        const pbf* GT_ = (const pbf*)(p.ws + WS_GATES); pbf* MB = (pbf*)(p.ws + WS_MERGEDB);
        { pg8::Gemm g{(const pbf*)(p.ws + WS_OSB), (const pbf*)(p.ws + WS_WBR), M, 1024, 512}; pg8::EpiBranchF<0> E{GT_, 0, p.out, MB};
          pg8::gemm_phase<pg8::EpiBranchF<0>, pg8::StaticOrder, PG8_ALIGN, PG8_SP2>(ldsl, g, S1, E); }
        P4_SEAM();
        { pg8::Gemm g{(const pbf*)(p.ws + WS_ODF), (const pbf*)(p.ws + WS_WBR + 1 * MiB), M, 1024, 512}; pg8::EpiBranchF<1> E{GT_, 1024, p.out, MB};
          pg8::gemm_phase<pg8::EpiBranchF<1>, pg8::StaticOrder, PG8_ALIGN, PG8_SP2>(ldsl, g, S1, E); }
        P4_SEAM();
        { pg8::Gemm g{(const pbf*)(p.ws + WS_OMX), (const pbf*)(p.ws + WS_WBR + 2 * MiB), M, 1024, 512}; pg8::EpiBranchF<2> E{GT_, 2048, p.out, MB};
          pg8::gemm_phase<pg8::EpiBranchF<2>, pg8::StaticOrder, PG8_ALIGN, PG8_SP2>(ldsl, g, S1, E); }
#endif
      } }
#endif
    }
#endif
    GSYNC();
#if !defined(SKIP_P5)
#ifndef REP_P5
#define REP_P5 1
#endif
    for (int rep_ = 0; rep_ < REP_P5; ++rep_) { PHASE_IDS()
#if defined(NAIVE_P5)
    { EpiOut e{p.x, p.out};
      naive_gemm((const bf16_t*)(p.ws + WS_MERGEDB), 1024, (const bf16_t*)(p.ws + WS_WOUT), 1024, M, 1024, 1024, e, gw, ngw, lane); }
#else
    { pg8::Gemm g{(const pbf*)(p.ws + WS_MERGEDB), (const pbf*)(p.ws + WS_WOUT), M, 1024, 1024}; pg8::StaticOrder S; S.init(M, 1024, G, bx);
      pg8::EpiOutF E{p.x, p.out};
      pg8::gemm_phase<pg8::EpiOutF, pg8::StaticOrder, PG8_ALIGN, PG8_SP2>(ldsl, g, S, E); }
#endif
    }
#endif
    GSYNC();
#if !defined(SKIP_P6)
#ifndef REP_P6
#define REP_P6 1
#endif
    for (int rep_ = 0; rep_ < REP_P6; ++rep_) { PHASE_IDS()
    stage_ln1(p, gw, ngw, lane);
#if defined(PEER_BF16)
    convert_bf16(p.u_tab, (bf16_t*)(p.ws + WS_UTB), (size_t)NEXP * 1024, gt, gs);
    convert_bf16(p.v_tab, (bf16_t*)(p.ws + WS_VTB), (size_t)NEXP * 1024, gt, gs);
#else
    convert_fp8(p.u_tab, p.ws + WS_U8, (size_t)NEXP * 1024, PEER_SU, gt, gs);
    convert_fp8(p.v_tab, p.ws + WS_V8, (size_t)NEXP * 1024, PEER_SV, gt, gs);
#endif
    }
#endif
    GSYNC();
#if !defined(SKIP_P7)
#ifndef REP_P7
#define REP_P7 1
#endif
    for (int rep_ = 0; rep_ < REP_P7; ++rep_) { PHASE_IDS()
#if defined(NAIVE_P7)
    { EpiPlain e{(bf16_t*)(p.ws + WS_QP), 2048};
      naive_gemm((const bf16_t*)(p.ws + WS_X1B), 1024, (const bf16_t*)(p.ws + WS_WQUERY), 1024, M, 2048, 1024, e, gw, ngw, lane); }
#else
    { pg8::Gemm g{(const pbf*)(p.ws + WS_X1B), (const pbf*)(p.ws + WS_WQUERY), M, 2048, 1024}; pg8::StaticOrder S; S.init(M, 2048, G, bx);
      pg8::EpiBf16<0> E{(pbf*)(p.ws + WS_QP), 2048, nullptr, 0, 0, 1.f};
      pg8::gemm_phase<pg8::EpiBf16<0>, pg8::StaticOrder, PG8_ALIGN, PG8_SP2>(ldsl, g, S, E); }
#endif
    }
#endif
    GSYNC();
#if !defined(SKIP_P8)
#ifndef REP_P8
#define REP_P8 1
#endif
    for (int rep_ = 0; rep_ < REP_P8; ++rep_) { PHASE_IDS()
#if defined(NAIVE_ROUTE)
    naive_routing(p, gt, gs);
#else
    route_phase(p, lds, bx, G);
#endif
    }
#endif
    GSYNC();
#if !defined(SKIP_P9)
#ifndef REP_P9
#define REP_P9 1
#endif
    for (int rep_ = 0; rep_ < REP_P9; ++rep_) { PHASE_IDS()
#if defined(NAIVE_PEER)
    naive_peer(p, gw, ngw, lane);
#else
    if (G == 256) {
#ifndef REP_SDDMM
#define REP_SDDMM 1
#endif
#ifndef REP_SPMM
#define REP_SPMM 1
#endif
        #if defined(PEER_BF16)
        for (int r2_ = 0; r2_ < REP_SDDMM; ++r2_) peer_sddmm(p, bx, wave, lane);
#else
        for (int r2_ = 0; r2_ < REP_SDDMM; ++r2_) peer_sddmm8(p, bx, wave, lane);
#endif
        GSYNC();
        peer_act(p, gt, gs);
        GSYNC();
#if defined(DBG_SPMM_NAIVE)
        naive_peer_from_a(p, gw, ngw, lane);
#else
        #if defined(PEER_BF16)
        for (int r2_ = 0; r2_ < REP_SPMM; ++r2_) peer_spmm(p, bx, wave, lane);
#else
        for (int r2_ = 0; r2_ < REP_SPMM; ++r2_) peer_spmm8(p, bx, wave, lane);
#endif
        GSYNC();
        stage_ln2(p, gw, ngw, lane);
#endif
    } else naive_peer(p, gw, ngw, lane);
#endif
    }
#endif
}

extern "C" void kernel_launch(void* const* d_in, const int* in_sizes, int n_in, void* d_out, int out_size, void* d_ws, size_t ws_size, hipStream_t stream) {
    static int grid_blocks = 0;
    if (!grid_blocks) {
        int dev = 0, cus = 0, per_cu = 0;
        hipGetDevice(&dev);
        hipDeviceGetAttribute(&cus, hipDeviceAttributeMultiprocessorCount, dev);
        hipFuncSetAttribute((const void*)mega, hipFuncAttributeMaxDynamicSharedMemorySize, LDS_BYTES);
        hipOccupancyMaxActiveBlocksPerMultiprocessor(&per_cu, (const void*)mega, NTHREADS, LDS_BYTES);
        if (per_cu < 1) per_cu = 1;
        grid_blocks = cus * per_cu;
    }
    Params p{};
    p.x = (const float*)d_in[0]; p.mem = (const float*)d_in[1]; p.pos = (const int*)d_in[2];
    p.w_in = (const float*)d_in[3]; p.w_memkv = (const float*)d_in[4]; p.df_lambda = (const float*)d_in[5]; p.df_norm_g = (const float*)d_in[6];
    p.w_gate = (const float*)d_in[7]; p.b_gate = (const float*)d_in[8]; p.w_br_sb = (const float*)d_in[9]; p.w_br_df = (const float*)d_in[10]; p.w_br_mx = (const float*)d_in[11];
    p.w_out = (const float*)d_in[12]; p.ln1_g = (const float*)d_in[13]; p.ln1_b = (const float*)d_in[14]; p.w_query = (const float*)d_in[15]; p.sub_keys = (const float*)d_in[16];
    p.u_tab = (const float*)d_in[17]; p.v_tab = (const float*)d_in[18]; p.ln2_g = (const float*)d_in[19]; p.ln2_b = (const float*)d_in[20];
    p.out = (float*)d_out; p.ws = (unsigned char*)d_ws;
    hipMemsetAsync((char*)d_ws + WS_CTL, 0, 65536, stream);
    void* args[] = {&p};
    hipError_t e = hipLaunchCooperativeKernel((const void*)mega, dim3(grid_blocks), dim3(NTHREADS), args, LDS_BYTES, stream);
    if (e != hipSuccess) fprintf(stderr, "cooperative launch failed: %s (grid %d)\n", hipGetErrorString(e), grid_blocks);
}
#ifdef REGTEST
__global__ void __launch_bounds__(512, 2) rt_sddmm(Params p) { peer_sddmm8(p, blockIdx.x, threadIdx.x >> 6, threadIdx.x & 63); }
__global__ void __launch_bounds__(512, 2) rt_spmm(Params p) { peer_spmm8(p, blockIdx.x, threadIdx.x >> 6, threadIdx.x & 63); }
#endif
```
